# Optimizing an MI355X kernel written in HIP

```python
import math
import jax, jax.numpy as jnp
from jax import lax
import numpy as np

D_MODEL = 1024
BATCH = 16
SEQ = 2048
DEPTH = 2

N_MIXERS = 2
MEM_LEN = 256
MEM_HEADS = 4
MEM_HEAD_DIM = D_MODEL // 16
MEM_WIDTH = MEM_HEADS * MEM_HEAD_DIM
RET_HEAD_DIM = D_MODEL // 8
RET_HEADS = (D_MODEL - MEM_WIDTH) // RET_HEAD_DIM
RET_WIDTH = RET_HEADS * RET_HEAD_DIM
RET_CHUNK = 128
ROPE_BASE = 10000.0
FOX_HEAD_DIM = D_MODEL // 16
FOX_HEADS = (D_MODEL - MEM_WIDTH) // FOX_HEAD_DIM
FOX_WIDTH = FOX_HEADS * FOX_HEAD_DIM
FOX_BLOCK = 128
D_FF = 4 * D_MODEL
EPS = 1e-6
N_RET = (DEPTH + N_MIXERS - 1) // N_MIXERS
N_FOX = DEPTH // N_MIXERS
RET_IN = 4 * RET_WIDTH + MEM_WIDTH
FOX_IN = 3 * FOX_WIDTH + FOX_HEADS + MEM_WIDTH

kernel_name = "hybrid_retention_fox_memory_block"


def rmsnorm(x, g):
    xf = x.astype(jnp.float32)
    y = xf * lax.rsqrt(jnp.mean(xf * xf, axis=-1, keepdims=True) + EPS)
    return (y * g.astype(jnp.float32)).astype(x.dtype)


def rotary(x, positions):
    d = x.shape[-1]
    inv_freq = ROPE_BASE ** (-jnp.arange(0, d, 2, dtype=jnp.float32) / d)
    ang = positions.astype(jnp.float32)[..., None] * inv_freq
    cos = jnp.cos(ang)[:, :, None, :]
    sin = jnp.sin(ang)[:, :, None, :]
    xf = x.astype(jnp.float32)
    x1, x2 = xf[..., : d // 2], xf[..., d // 2:]
    return jnp.concatenate([x1 * cos - x2 * sin, x1 * sin + x2 * cos], axis=-1)


def retention_chunkwise(q, k, v):
    B, S, H, d = q.shape
    C = RET_CHUNK
    n = S // C
    log_gamma = jnp.log(1.0 - 2.0 ** (-5.0 - jnp.arange(H, dtype=jnp.float32)))
    idx = jnp.arange(C, dtype=jnp.float32)
    rel = idx[:, None] - idx[None, :]
    decay_mask = jnp.where(rel[None] >= 0, jnp.exp(jnp.maximum(rel, 0.0)[None] * log_gamma[:, None, None]), 0.0)
    q_decay = jnp.exp((idx[None, :] + 1.0) * log_gamma[:, None])
    k_decay = jnp.exp((C - 1.0 - idx[None, :]) * log_gamma[:, None])
    chunk_decay = jnp.exp(C * log_gamma)
    k = k * (d ** -0.5)

    def to_chunks(t):
        return t.reshape(B, n, C, H, t.shape[-1]).transpose(1, 0, 3, 2, 4)

    def step(state, inp):
        qc, kc, vc = inp
        inner = jnp.einsum('bhid,bhjd->bhij', qc, kc) * decay_mask[None]
        o_inner = jnp.einsum('bhij,bhje->bhie', inner, vc)
        o_cross = jnp.einsum('bhid,bhde->bhie', qc * q_decay[None, :, :, None], state)
        state = state * chunk_decay[None, :, None, None] + jnp.einsum('bhjd,bhje->bhde', kc * k_decay[None, :, :, None], vc)
        return state, o_inner + o_cross

    state0 = jnp.zeros((B, H, d, v.shape[-1]), jnp.float32)
    _, out = lax.scan(step, state0, (to_chunks(q), to_chunks(k), to_chunks(v)))
    return out.transpose(1, 0, 3, 2, 4).reshape(B, S, H, v.shape[-1])


def forgetting_attention(q, k, v, log_f):
    B, S, H, d = q.shape
    nb = S // FOX_BLOCK
    c = jnp.cumsum(log_f, axis=1).transpose(0, 2, 1)
    qh = q.transpose(0, 2, 1, 3)
    kh = k.transpose(0, 2, 1, 3)
    vh = v.transpose(0, 2, 1, 3)
    q_blocks = qh.reshape(B, H, nb, FOX_BLOCK, d).transpose(2, 0, 1, 3, 4)
    c_blocks = c.reshape(B, H, nb, FOX_BLOCK).transpose(2, 0, 1, 3)
    starts = jnp.arange(nb, dtype=jnp.int32) * FOX_BLOCK
    key_pos = jnp.arange(S, dtype=jnp.int32)
    scale = d ** -0.5

    def one_block(inp):
        qb, cb, start = inp
        s = jnp.einsum('bhqd,bhkd->bhqk', qb, kh).astype(jnp.float32) * scale
        s = s + cb[..., None] - c[:, :, None, :]
        q_pos = start + jnp.arange(FOX_BLOCK, dtype=jnp.int32)
        causal = key_pos[None, :] <= q_pos[:, None]
        s = jnp.where(causal[None, None], s, -jnp.inf)
        p = jax.nn.softmax(s, axis=-1)
        return jnp.einsum('bhqk,bhkd->bhqd', p.astype(vh.dtype), vh)

    out = lax.map(one_block, (q_blocks, c_blocks, starts))
    return out.transpose(1, 0, 3, 2, 4).reshape(B, S, H, d)


def memory_attention(mq, mem, g_mem, w_mem_kv):
    B, M, _ = mem.shape
    kv = rmsnorm(mem, g_mem) @ w_mem_kv
    mk, mv = jnp.split(kv, 2, axis=-1)
    mk = mk.reshape(B, M, MEM_HEADS, MEM_HEAD_DIM)
    mv = mv.reshape(B, M, MEM_HEADS, MEM_HEAD_DIM)
    s = jnp.einsum('bshd,bmhd->bhsm', mq, mk).astype(jnp.float32) * (MEM_HEAD_DIM ** -0.5)
    p = jax.nn.softmax(s, axis=-1)
    return jnp.einsum('bhsm,bmhd->bshd', p.astype(mv.dtype), mv)


def setup_inputs(seed: int = 0) -> dict:
    key = jax.random.key(seed)
    ks = jax.random.split(key, 16)
    f32 = jnp.float32

    def w(k, shape, fan_in):
        return jax.random.normal(k, shape, f32) * (fan_in ** -0.5)

    def gain(k, shape):
        return 1.0 + 0.02 * jax.random.normal(k, shape, f32)

    x = jax.random.normal(ks[0], (BATCH, SEQ, D_MODEL), f32)
    mem = jax.random.normal(ks[1], (BATCH, MEM_LEN, D_MODEL), f32)
    positions = jnp.broadcast_to(jnp.arange(SEQ, dtype=jnp.int32)[None, :], (BATCH, SEQ)).astype(jnp.int32)
    return {
        "x": x,
        "mem": mem,
        "positions": positions,
        "w_in_ret": w(ks[2], (N_RET, D_MODEL, RET_IN), D_MODEL),
        "w_in_fox": w(ks[3], (N_FOX, D_MODEL, FOX_IN), D_MODEL),
        "b_forget": 0.02 * jax.random.normal(ks[4], (N_FOX, FOX_HEADS), f32),
        "w_mem_kv": w(ks[5], (DEPTH, D_MODEL, 2 * MEM_WIDTH), D_MODEL),
        "w_out": w(ks[6], (DEPTH, D_MODEL, D_MODEL), D_MODEL),
        "w_up": w(ks[7], (DEPTH, D_MODEL, D_FF), D_MODEL),
        "w_down": w(ks[8], (DEPTH, D_FF, D_MODEL), D_FF),
        "g_pre_mix": gain(ks[9], (DEPTH, D_MODEL)),
        "g_post_mix": gain(ks[10], (DEPTH, D_MODEL)),
        "g_pre_mlp": gain(ks[11], (DEPTH, D_MODEL)),
        "g_post_mlp": gain(ks[12], (DEPTH, D_MODEL)),
        "g_mem": gain(ks[13], (DEPTH, D_MODEL)),
    }


def reference(x, mem, positions, w_in_ret, w_in_fox, b_forget, w_mem_kv, w_out, w_up, w_down,
              g_pre_mix, g_post_mix, g_pre_mlp, g_post_mlp, g_mem):
    B, S, _ = x.shape
    for i in range(DEPTH):
        mixer = i % N_MIXERS
        j = i // N_MIXERS
        h = rmsnorm(x, g_pre_mix[i])
        if mixer == 0:
            proj = h @ w_in_ret[j]
            q, k, v, gate, mq = jnp.split(proj, [RET_WIDTH, 2 * RET_WIDTH, 3 * RET_WIDTH, 4 * RET_WIDTH], axis=-1)
            q = rotary(q.reshape(B, S, RET_HEADS, RET_HEAD_DIM), positions)
            k = rotary(k.reshape(B, S, RET_HEADS, RET_HEAD_DIM), positions)
            v = v.reshape(B, S, RET_HEADS, RET_HEAD_DIM).astype(jnp.float32)
            r = retention_chunkwise(q, k, v)
            r = r * lax.rsqrt(jnp.mean(r * r, axis=-1, keepdims=True) + EPS)
            self_out = (r.reshape(B, S, RET_WIDTH) * jax.nn.silu(gate.astype(jnp.float32))).astype(x.dtype)
        else:
            proj = h @ w_in_fox[j]
            q, k, v, f_logit, mq = jnp.split(proj, [FOX_WIDTH, 2 * FOX_WIDTH, 3 * FOX_WIDTH, 3 * FOX_WIDTH + FOX_HEADS], axis=-1)
            log_f = jax.nn.log_sigmoid(f_logit.astype(jnp.float32) + b_forget[j].astype(jnp.float32))
            self_out = forgetting_attention(q.reshape(B, S, FOX_HEADS, FOX_HEAD_DIM),
                                            k.reshape(B, S, FOX_HEADS, FOX_HEAD_DIM),
                                            v.reshape(B, S, FOX_HEADS, FOX_HEAD_DIM), log_f)
            self_out = self_out.reshape(B, S, FOX_WIDTH).astype(x.dtype)
        mem_out = memory_attention(mq.reshape(B, S, MEM_HEADS, MEM_HEAD_DIM), mem, g_mem[i], w_mem_kv[i])
        mixed = jnp.concatenate([self_out, mem_out.reshape(B, S, MEM_WIDTH).astype(x.dtype)], axis=-1)
        x = x + rmsnorm(mixed @ w_out[i], g_post_mix[i])
        h = rmsnorm(x, g_pre_mlp[i])
        u = jax.nn.relu(h @ w_up[i])
        x = x + rmsnorm((u * u) @ w_down[i], g_post_mlp[i])
    return x
```

```cpp
#include <hip/hip_runtime.h>
#include <cstdio>
#include <cstdint>

constexpr int BATCH = 16, SEQ = 2048, DM = 1024, MTOK = BATCH * SEQ, MEML = 256, MMEM = BATCH * MEML, FF = 4096;
constexpr int NP0 = 3328, NP1 = 2816;
constexpr int C_Q = 0, C_MQ = 768, C_K = 1024, C_V = 1792, C_G = 2560;
constexpr float EPS = 1e-6f;
constexpr float LOG2E = 1.4426950408889634f;
constexpr float QSCALE = 0.125f * LOG2E;

namespace pg8 {
#define PG8_LAS __attribute__((address_space(3)))
typedef unsigned short bf16_t;
typedef short bf16x8 __attribute__((ext_vector_type(8)));
typedef float f32x4 __attribute__((ext_vector_type(4)));
typedef unsigned u32x4 __attribute__((ext_vector_type(4)));
constexpr int BM = 256, BK = 64, HALF = 128, HTB = HALF * BK * 2  , STAGE_BYTES = 8 * HTB, NXCD = 8, WGM = 8;

__host__ __device__ __forceinline__ int lds_byte(int r, int c) { const int st = (r >> 4) * 2 + (c >> 5), rr = r & 15, cc = c & 31, ob = rr * 64 + cc * 2; return st * 1024 + (ob ^ (((ob >> 9) & 1) << 5)); }
__host__ __device__ __forceinline__ void stage_rc(int b, int& R, int& C) { const int st = b / 1024, sb = b % 1024, swz = sb ^ (((sb >> 9) & 1) << 5); R = (st >> 1) * 16 + swz / 64; C = (st & 1) * 32 + (swz % 64) / 2; }
__host__ __device__ __forceinline__ int perm32(int rho) { const int n = rho >> 4, i = rho & 15; return 8 * (i >> 2) + 4 * n + (i & 3); }

struct Unit { int pm, pn; };
struct Gemm { const bf16_t* A; const bf16_t* Bt; int M, N, K, lda; };

struct StaticOrder {
    int nM, nN, nwg, G, c;
    __host__ __device__ void init(int M, int N, int G_, int c_) { nM = M / BM; nN = N / BM; nwg = nM * nN; G = G_; c = c_; }
    __host__ __device__ bool next(int i, Unit& u) const {
        const long L = (long)i * G + c; if (L >= nwg) return false;
        int wgid = (int)L; { const int q = nwg / NXCD, r = nwg % NXCD, xcd = wgid % NXCD, off = wgid / NXCD; wgid = (xcd < r ? xcd * (q + 1) : r * (q + 1) + (xcd - r) * q) + off; }
        const int nig = WGM * nN, gid = wgid / nig, fm = gid * WGM, gsz = (nM - fm) < WGM ? (nM - fm) : WGM;
        u.pm = fm + ((wgid % nig) % gsz); u.pn = (wgid % nig) / gsz; return true;
    }
    __device__ __forceinline__ void a_ready(const Unit&) const {}
    __device__ __forceinline__ void done(const Unit&) const {}
};
struct OneUnit {
    Unit u0; bool has;
    __device__ __forceinline__ bool next(int i, Unit& u) const { if (i != 0 || !has) return false; u = u0; return true; }
    __device__ __forceinline__ void a_ready(const Unit&) const {}
    __device__ __forceinline__ void done(const Unit&) const {}
};

typedef float f32x2_t __attribute__((ext_vector_type(2))); typedef __bf16 bf16x2_t __attribute__((ext_vector_type(2)));
__device__ __forceinline__ unsigned cvt_pk_bf16(float lo, float hi) { f32x2_t v = {lo, hi}; bf16x2_t b = __builtin_convertvector(v, bf16x2_t); return __builtin_bit_cast(unsigned, b); }

template <int ACT> struct EpiBf16 {
    static constexpr bool PERM = true, AFTER_DRAIN = false;
    bf16_t* O; int ldc;
    __device__ __forceinline__ void operator()(const f32x4 (&acc)[2][2][4][2], const Unit& u, int wr, int wc, int fr, int fq) const {
        const int row0 = u.pm * BM + wr * 64 + fr, col0 = u.pn * BM + wc * 32 + 8 * fq;
#pragma unroll
        for (int ai = 0; ai < 2; ++ai)
#pragma unroll
            for (int m = 0; m < 4; ++m) { bf16_t* rowp = O + (size_t)(row0 + ai * HALF + m * 16) * ldc + col0;
#pragma unroll
                for (int bj = 0; bj < 2; ++bj) { f32x4 v0 = acc[ai][bj][m][0], v1 = acc[ai][bj][m][1];
                    if (ACT == 1) {
#pragma unroll
                        for (int e = 0; e < 4; ++e) { const float a = fmaxf(v0[e], 0.f), b = fmaxf(v1[e], 0.f); v0[e] = a * a; v1[e] = b * b; } }
                    u32x4 w; w.x = cvt_pk_bf16(v0[0], v0[1]); w.y = cvt_pk_bf16(v0[2], v0[3]); w.z = cvt_pk_bf16(v1[0], v1[1]); w.w = cvt_pk_bf16(v1[2], v1[3]);
                    *(u32x4*)(rowp + bj * HALF) = w; } }
    }
};
struct EpiF32 {
    static constexpr bool PERM = false, AFTER_DRAIN = false;
    float* O; int ldc;
    __device__ __forceinline__ void operator()(const f32x4 (&acc)[2][2][4][2], const Unit& u, int wr, int wc, int fr, int fq) const {
        const int row0 = u.pm * BM + wr * 64 + fr, col0 = u.pn * BM + wc * 32 + 4 * fq;
#pragma unroll
        for (int ai = 0; ai < 2; ++ai)
#pragma unroll
            for (int m = 0; m < 4; ++m) { float* rowp = O + (size_t)(row0 + ai * HALF + m * 16) * ldc + col0;
#pragma unroll
                for (int bj = 0; bj < 2; ++bj)
#pragma unroll
                    for (int n = 0; n < 2; ++n) *(f32x4*)(rowp + bj * HALF + n * 16) = acc[ai][bj][m][n]; }
    }
};
struct EpiProj {
    static constexpr bool PERM = true, AFTER_DRAIN = false;
    bf16_t* O; int ldc; int layer; const int* pos; float* logf; const float* bfg;
    __device__ __forceinline__ void operator()(const f32x4 (&acc)[2][2][4][2], const Unit& u, int wr, int wc, int fr, int fq) const {
        const int row0 = u.pm * BM + wr * 64 + fr, cw = wc * 32 + 8 * fq, col0 = u.pn * BM + cw;
        int mode; float sc = 1.f;
        if (layer == 0) { if (u.pn < 3) mode = 1; else if (u.pn == 3) { mode = 0; sc = QSCALE; } else if (u.pn < 7) { mode = 1; sc = 0.08838834764831845f; } else if (u.pn < 10) mode = 0; else mode = 4; }
        else { if (u.pn < 4) { mode = 0; sc = QSCALE; } else if (u.pn < 10) mode = 0; else mode = 5; }
        if (mode == 5) {
            if (wc == 0 && fq < 2) {
#pragma unroll
                for (int ai = 0; ai < 2; ++ai)
#pragma unroll
                    for (int m = 0; m < 4; ++m) { const int row = row0 + ai * HALF + m * 16;
#pragma unroll
                        for (int n = 0; n < 2; ++n)
#pragma unroll
                            for (int e = 0; e < 4; ++e) { const int c = 8 * fq + 4 * n + e;
                                if (c < 12) { const float z = acc[ai][0][m][n][e] + bfg[c]; const float az = fabsf(z);
                                    logf[(size_t)row * 16 + c] = fminf(z, 0.f) * LOG2E - __log2f(1.f + exp2f(-az * LOG2E)); } } }
            }
            return;
        }
        float invf[4];
        if (mode == 1) {
#pragma unroll
            for (int p = 0; p < 4; ++p) invf[p] = exp2f(-(float)((cw >> 1) + p) * (13.287712379549449f / 64.f)) * 0.15915494309189535f;
        }
#pragma unroll
        for (int ai = 0; ai < 2; ++ai)
#pragma unroll
            for (int m = 0; m < 4; ++m) { const int row = row0 + ai * HALF + m * 16; bf16_t* rowp = O + (size_t)row * ldc + col0;
                float cs[4], sn[4];
                if (mode == 1) { const float ps = (float)pos[row];
#pragma unroll
                    for (int p = 0; p < 4; ++p) { float rev = ps * invf[p]; rev = rev - floorf(rev); sn[p] = __builtin_amdgcn_sinf(rev); cs[p] = __builtin_amdgcn_cosf(rev); } }
#pragma unroll
                for (int bj = 0; bj < 2; ++bj) { f32x4 v0 = acc[ai][bj][m][0], v1 = acc[ai][bj][m][1];
                    if (mode == 1) {
                        const float a0 = v0[0] * cs[0] - v0[1] * sn[0], b0 = v0[0] * sn[0] + v0[1] * cs[0];
                        const float a1 = v0[2] * cs[1] - v0[3] * sn[1], b1 = v0[2] * sn[1] + v0[3] * cs[1];
                        const float a2 = v1[0] * cs[2] - v1[1] * sn[2], b2 = v1[0] * sn[2] + v1[1] * cs[2];
                        const float a3 = v1[2] * cs[3] - v1[3] * sn[3], b3 = v1[2] * sn[3] + v1[3] * cs[3];
                        v0 = (f32x4){a0, b0, a1, b1}; v1 = (f32x4){a2, b2, a3, b3};
                    } else if (mode == 4) {
#pragma unroll
                        for (int e = 0; e < 4; ++e) { v0[e] = v0[e] / (1.f + exp2f(-v0[e] * LOG2E)); v1[e] = v1[e] / (1.f + exp2f(-v1[e] * LOG2E)); }
                    }
                    v0 = v0 * sc; v1 = v1 * sc;
                    u32x4 w; w.x = cvt_pk_bf16(v0[0], v0[1]); w.y = cvt_pk_bf16(v0[2], v0[3]); w.z = cvt_pk_bf16(v1[0], v1[1]); w.w = cvt_pk_bf16(v1[2], v1[3]);
                    *(u32x4*)(rowp + bj * HALF) = w; } }
    }
};

template <class Epi, class Sched, bool ALIGN_EPI = false, bool SP2 = false>
__device__ __forceinline__ void gemm_phase(PG8_LAS unsigned char* lds, const Gemm g, const Sched& S, const Epi& E) {
    int tid_ = threadIdx.x; asm volatile("" : "+v"(tid_));
    const int tid = tid_, wid = __builtin_amdgcn_readfirstlane(tid >> 6), lane = tid & 63, wr = wid >> 2, wc = wid & 3, fr = lane & 15, fq = lane >> 4;
    const int K = g.K, nt = K / BK;
    unsigned voffA[2], voffB[2];
#pragma unroll
    for (int i = 0; i < 2; ++i) { int R, C; stage_rc(tid * 16 + i * 8192, R, C); const int Rb = Epi::PERM ? ((R & ~31) + perm32(R & 31)) : R;
        voffA[i] = (unsigned)(R * g.lda + C) * 2u; voffB[i] = (unsigned)(Rb * K + C) * 2u; }
    const size_t kstep = (size_t)(BK * 2);
    const size_t hstepA = (size_t)HALF * g.lda * 2, hstepB = (size_t)HALF * K * 2;
    const size_t tstepA = 2 * hstepA, tstepB = 2 * hstepB;
    const unsigned ldsw = (unsigned)wid * 1024u;
    const int aoff = lds_byte(wr * 64 + fr, fq * 8), boff = lds_byte(wc * 32 + fr, fq * 8);
#define PG8_SA(b, h) (((b) * 2 + (h)) * HTB)
#define PG8_SB(b, h) ((4 + (b) * 2 + (h)) * HTB)
#define PG8_STAGE(bufoff, gbase, voff) do { _Pragma("unroll") for (int _i = 0; _i < 2; ++_i) \
        __builtin_amdgcn_global_load_lds((const unsigned*)((const char*)(gbase) + (voff)[_i]), (PG8_LAS unsigned*)(lds + (bufoff) + ldsw + _i * 8192), 16, 0, 0); } while (0)
#define PG8_LDA(dst, b, h) do { _Pragma("unroll") for (int m = 0; m < 4; ++m) _Pragma("unroll") for (int k = 0; k < 2; ++k) dst[m][k] = *(const PG8_LAS bf16x8*)(lds + PG8_SA(b, h) + aoff + m * 2048 + k * 1024); } while (0)
#define PG8_LDB(dst, b, h) do { _Pragma("unroll") for (int n = 0; n < 2; ++n) _Pragma("unroll") for (int k = 0; k < 2; ++k) dst[n][k] = *(const PG8_LAS bf16x8*)(lds + PG8_SB(b, h) + boff + n * 2048 + k * 1024); } while (0)
#define PG8_MMA(ai, bj, At, Bt) do { __builtin_amdgcn_s_setprio(1); _Pragma("unroll") for (int m = 0; m < 4; ++m) _Pragma("unroll") for (int n = 0; n < 2; ++n) _Pragma("unroll") for (int k = 0; k < 2; ++k) \
        acc[ai][bj][m][n] = __builtin_amdgcn_mfma_f32_16x16x32_bf16(Bt[n][k], At[m][k], acc[ai][bj][m][n], 0, 0, 0); __builtin_amdgcn_s_setprio(0); } while (0)
#define PG8_WAIT_V(n) asm volatile("s_waitcnt vmcnt(" #n ")" ::: "memory")
#define PG8_WAIT_L(n) asm volatile("s_waitcnt lgkmcnt(" #n ")" ::: "memory")
#define PG8_BAR __builtin_amdgcn_s_barrier()
#define PG8_SCHED __builtin_amdgcn_sched_barrier(0)
    Unit cur, nxt; int ui = 0;
    if (!S.next(0, cur)) return;
    f32x4 acc[2][2][4][2];
#pragma unroll
    for (int a = 0; a < 2; ++a)
#pragma unroll
        for (int b = 0; b < 2; ++b)
#pragma unroll
            for (int m = 0; m < 4; ++m)
#pragma unroll
                for (int n = 0; n < 2; ++n) acc[a][b][m][n] = (f32x4){0.f, 0.f, 0.f, 0.f};
    bf16x8 At[4][2], B0[2][2], B1[2][2];
    const char* cA = (const char*)g.A + (size_t)cur.pm * tstepA; const char* cB = (const char*)g.Bt + (size_t)cur.pn * tstepB;
    S.a_ready(cur);
    if constexpr (SP2) {
        PG8_STAGE(PG8_SB(0, 0), cB, voffB); PG8_STAGE(PG8_SB(0, 1), cB + hstepB, voffB); PG8_STAGE(PG8_SA(0, 0), cA, voffA); PG8_STAGE(PG8_SA(0, 1), cA + hstepA, voffA);
        if (wr == 1) PG8_BAR;
        PG8_WAIT_V(2); PG8_BAR;
        PG8_STAGE(PG8_SB(1, 0), cB + kstep, voffB); PG8_STAGE(PG8_SA(1, 0), cA + kstep, voffA); PG8_STAGE(PG8_SB(1, 1), cB + hstepB + kstep, voffB);
        PG8_WAIT_V(6); PG8_BAR;
    } else {
        PG8_STAGE(PG8_SB(0, 0), cB, voffB); PG8_STAGE(PG8_SA(0, 0), cA, voffA); PG8_STAGE(PG8_SB(0, 1), cB + hstepB, voffB); PG8_STAGE(PG8_SA(0, 1), cA + hstepA, voffA);
        if (wr == 1) PG8_BAR;
        PG8_WAIT_V(4); PG8_BAR;
        PG8_STAGE(PG8_SB(1, 0), cB + kstep, voffB); PG8_STAGE(PG8_SA(1, 0), cA + kstep, voffA); PG8_STAGE(PG8_SB(1, 1), cB + hstepB + kstep, voffB);
        PG8_WAIT_V(6); PG8_BAR;
    }
    for (;;) {
        const bool has_next = S.next(ui + 1, nxt);
        const char* nA = has_next ? (const char*)g.A + (size_t)nxt.pm * tstepA : cA; const char* nB = has_next ? (const char*)g.Bt + (size_t)nxt.pn * tstepB : cB;
        for (int t = 0; t < nt; t += 2) {
            const bool last = (t == nt - 2);
            const char* a1 = cA + (size_t)(t + 1) * kstep;
            const char* a2 = last ? nA : cA + (size_t)(t + 2) * kstep; const char* b2 = last ? nB : cB + (size_t)(t + 2) * kstep;
            const char* a3 = a2 + kstep; const char* b3 = b2 + kstep;
            if (last && has_next) S.a_ready(nxt);
            if constexpr (SP2) {
            PG8_LDB(B0, 0, 0); PG8_LDB(B1, 0, 1); PG8_SCHED; PG8_LDA(At, 0, 0); PG8_STAGE(PG8_SA(1, 1), a1 + hstepA, voffA);
            PG8_WAIT_V(8); PG8_WAIT_L(0); PG8_BAR; PG8_MMA(0, 0, At, B0); PG8_MMA(0, 1, At, B1); PG8_BAR; PG8_SCHED;
            PG8_LDA(At, 0, 1); PG8_STAGE(PG8_SB(0, 0), b2, voffB); PG8_STAGE(PG8_SB(0, 1), b2 + hstepB, voffB); PG8_STAGE(PG8_SA(0, 0), a2, voffA);
            PG8_WAIT_V(8); PG8_WAIT_L(0); PG8_BAR; PG8_MMA(1, 0, At, B0); PG8_MMA(1, 1, At, B1); PG8_BAR; PG8_SCHED;
            PG8_LDB(B0, 1, 0); PG8_LDB(B1, 1, 1); PG8_SCHED; PG8_LDA(At, 1, 0); PG8_STAGE(PG8_SA(0, 1), a2 + hstepA, voffA);
            PG8_WAIT_V(8); PG8_WAIT_L(0); PG8_BAR; PG8_MMA(0, 0, At, B0); PG8_MMA(0, 1, At, B1); PG8_BAR; PG8_SCHED;
            PG8_LDA(At, 1, 1); PG8_STAGE(PG8_SB(1, 0), b3, voffB); PG8_STAGE(PG8_SB(1, 1), b3 + hstepB, voffB); PG8_STAGE(PG8_SA(1, 0), a3, voffA);
            PG8_WAIT_V(8); PG8_WAIT_L(0); PG8_BAR; PG8_MMA(1, 0, At, B0); PG8_MMA(1, 1, At, B1); PG8_BAR; PG8_SCHED;
            } else {
            PG8_LDB(B0, 0, 0); PG8_SCHED; PG8_LDA(At, 0, 0); PG8_STAGE(PG8_SA(1, 1), a1 + hstepA, voffA);
            PG8_WAIT_L(8); PG8_BAR; PG8_WAIT_L(0); PG8_MMA(0, 0, At, B0); PG8_BAR; PG8_SCHED;
            PG8_LDB(B1, 0, 1); PG8_STAGE(PG8_SB(0, 0), b2, voffB);
            PG8_BAR; PG8_WAIT_L(0); PG8_MMA(0, 1, At, B1); PG8_BAR;
            PG8_LDA(At, 0, 1); PG8_STAGE(PG8_SA(0, 0), a2, voffA);
            PG8_BAR; PG8_WAIT_L(0); PG8_MMA(1, 0, At, B0); PG8_BAR; PG8_SCHED;
            PG8_STAGE(PG8_SB(0, 1), b2 + hstepB, voffB);
            PG8_WAIT_V(6); PG8_BAR; PG8_MMA(1, 1, At, B1); PG8_BAR;
            PG8_LDB(B0, 1, 0); PG8_SCHED; PG8_LDA(At, 1, 0); PG8_STAGE(PG8_SA(0, 1), a2 + hstepA, voffA);
            PG8_WAIT_L(8); PG8_BAR; PG8_WAIT_L(0); PG8_MMA(0, 0, At, B0); PG8_BAR; PG8_SCHED;
            PG8_LDB(B1, 1, 1); PG8_STAGE(PG8_SB(1, 0), b3, voffB);
            PG8_BAR; PG8_WAIT_L(0); PG8_MMA(0, 1, At, B1); PG8_BAR;
            PG8_LDA(At, 1, 1); PG8_STAGE(PG8_SA(1, 0), a3, voffA);
            PG8_BAR; PG8_WAIT_L(0); PG8_MMA(1, 0, At, B0); PG8_BAR; PG8_SCHED;
            PG8_STAGE(PG8_SB(1, 1), b3 + hstepB, voffB);
            PG8_WAIT_V(6); PG8_BAR; PG8_MMA(1, 1, At, B1); PG8_BAR;
            }
        }
        if constexpr (ALIGN_EPI) { if (wr == 0) PG8_BAR; }
        if constexpr (!Epi::AFTER_DRAIN) { E(acc, cur, wr, wc, fr, fq); S.done(cur); }
        if (!has_next) break;
#pragma unroll
        for (int a = 0; a < 2; ++a)
#pragma unroll
            for (int b = 0; b < 2; ++b)
#pragma unroll
                for (int m = 0; m < 4; ++m)
#pragma unroll
                    for (int n = 0; n < 2; ++n) acc[a][b][m][n] = (f32x4){0.f, 0.f, 0.f, 0.f};
        cur = nxt; cA = nA; cB = nB; ++ui;
        if constexpr (ALIGN_EPI) { if (wr == 1) PG8_BAR; }
    }
    PG8_WAIT_V(0);
    if constexpr (!ALIGN_EPI) { if (wr == 0) PG8_BAR; }
    PG8_BAR;
    if constexpr (Epi::AFTER_DRAIN) { E.fused(acc, cur, wr, wc, fr, fq, lds, wid, lane); S.done(cur); }
#undef PG8_SA
#undef PG8_SB
#undef PG8_STAGE
#undef PG8_LDA
#undef PG8_LDB
#undef PG8_MMA
#undef PG8_WAIT_V
#undef PG8_WAIT_L
#undef PG8_BAR
#undef PG8_SCHED
}
}

constexpr size_t MiB = 1u << 20;
constexpr size_t WS_CTL = 0, CTL_ZERO_BYTES = 64 * 1024;
constexpr size_t WS_WIN0 = 1 * MiB;
constexpr size_t WS_WIN1 = WS_WIN0 + (size_t)NP0 * DM * 2;
constexpr size_t WS_WMEM = 13 * MiB;
constexpr size_t WS_WOUT = 15 * MiB;
constexpr size_t WS_WUP = 19 * MiB;
constexpr size_t WS_WDN = 35 * MiB;
constexpr size_t WS_MEMKV = 51 * MiB;
constexpr size_t WS_LOGF = 59 * MiB;
constexpr size_t WS_CS = 61 * MiB;
constexpr size_t WS_XN = 64 * MiB;
constexpr size_t WS_R1 = 128 * MiB;
constexpr size_t WS_H = 256 * MiB;
constexpr size_t WS_PROJ = 256 * MiB;
constexpr size_t WS_MEMN = 464 * MiB;
constexpr size_t WS_END = 512 * MiB;
static_assert(WS_WIN1 + (size_t)NP1 * DM * 2 <= WS_WMEM && WS_PROJ + (size_t)MTOK * NP0 * 2 <= WS_MEMN, "d_ws map");
constexpr int CW_BAR = 4096;

constexpr int RING_OFF = 0, RING_BYTES = 131072;
constexpr int LDSCTL_OFF = RING_BYTES, MISC_OFF = LDSCTL_OFF + 320;
constexpr int LDS_BYTES = 147456;
constexpr int NWAVES = 8;

#define GAS __attribute__((address_space(1)))
#define LAS __attribute__((address_space(3)))
typedef unsigned short bf16;
typedef unsigned v4u __attribute__((ext_vector_type(4)));
typedef float f32x4 __attribute__((ext_vector_type(4)));
typedef GAS unsigned gu32;
#define LDS_WAIT() asm volatile("s_waitcnt lgkmcnt(0)" ::: "memory")
#define VM_WAIT() asm volatile("s_waitcnt vmcnt(0)" ::: "memory")
__device__ __forceinline__ unsigned f2bf(float f) { unsigned u = __builtin_bit_cast(unsigned, f); return (u + 0x7fffu + ((u >> 16) & 1u)) >> 16; }
__device__ __forceinline__ unsigned pk2(float lo, float hi) { return f2bf(lo) | (f2bf(hi) << 16); }
__device__ __forceinline__ float bflo(unsigned u) { return __builtin_bit_cast(float, u << 16); }
__device__ __forceinline__ float bfhi(unsigned u) { return __builtin_bit_cast(float, u & 0xffff0000u); }

#define XB_TMO      128
#define XB_XCNT(j)  (256  + 64 * (j))
#define XB_XSUB(j)  (1280 + 64 * (j))
#define XB_XGEN(j)  (2304 + 64 * (j))
#define XB_TOP      3328
#define XB_TOPGEN   3392
#define XCD_BAR_WORDS 3456
#define XB_SPIN_CAP (1u << 18)

__device__ __forceinline__ unsigned xb_ld(unsigned* p)              { return __hip_atomic_load(p, __ATOMIC_RELAXED, __HIP_MEMORY_SCOPE_AGENT); }
__device__ __forceinline__ unsigned xb_add(unsigned* p, unsigned v) { return __hip_atomic_fetch_add(p, v, __ATOMIC_RELAXED, __HIP_MEMORY_SCOPE_AGENT); }
__device__ __forceinline__ unsigned xb_xcc_id() { return (unsigned)__builtin_amdgcn_s_getreg((3 << 11) | 20) & 0xFu; }
#define XB_SPIN(cond, bar) do { unsigned _sp = 0; while (cond) { __builtin_amdgcn_s_sleep(1); \
    if ((++_sp & 255u) == 0u) { if (xb_ld(&(bar)[XB_TMO])) break; if (_sp > XB_SPIN_CAP) { atomicAdd(&(bar)[XB_TMO], 1u); break; } } } } while (0)

struct XcdBarrier {
    unsigned* bar; unsigned x;
    volatile LAS unsigned* st;
};

__device__ __forceinline__ XcdBarrier xcd_barrier_post(unsigned* bar, volatile LAS unsigned* st) {
    XcdBarrier b; b.bar = bar; b.x = xb_xcc_id(); b.st = st;
    if (threadIdx.x == 0) (void)xb_add(&bar[XB_XCNT(b.x)], 1u);
    return b;
}
__device__ __forceinline__ void xcd_barrier_complete(unsigned* bar, unsigned x, unsigned& nloc, unsigned& nx) {
    const unsigned G = gridDim.x * gridDim.y * gridDim.z;
    unsigned sum, cnt, mine, sp = 0u;
    for (;;) {
        sum = 0u; cnt = 0u; mine = 0u;
#pragma unroll
        for (unsigned j = 0; j < 16; ++j) { const unsigned c = xb_ld(&bar[XB_XCNT(j)]); sum += c; cnt += (c > 0u) ? 1u : 0u; mine = (j == x) ? c : mine; }
        if (sum == G) break;
        __builtin_amdgcn_s_sleep(1);
        if ((++sp & 255u) == 0u) { if (xb_ld(&bar[XB_TMO])) break; if (sp > XB_SPIN_CAP) { atomicAdd(&bar[XB_TMO], 1u); break; } }
    }
    nloc = mine > 0u ? mine : 1u; nx = cnt > 0u ? cnt : 1u;
}

__device__ __forceinline__ void xcd_barrier(const XcdBarrier& b) {
    asm volatile("s_waitcnt vmcnt(0)" ::: "memory");
    __syncthreads();
    if (threadIdx.x == 0) {
        unsigned* bar = b.bar;
        __builtin_amdgcn_s_waitcnt(0);
        unsigned nloc = b.st[0], nx = b.st[1];
        if (nloc == 0u) { xcd_barrier_complete(bar, b.x, nloc, nx); b.st[0] = nloc; b.st[1] = nx; }
        const unsigned old = xb_add(&bar[XB_XSUB(b.x)], 1u);
        const unsigned gen = old / nloc;
        if (old + 1u == (gen + 1u) * nloc) {
            __builtin_amdgcn_fence(__ATOMIC_RELEASE, "agent");
            asm volatile("s_waitcnt vmcnt(0)" ::: "memory");
            const unsigned og = xb_add(&bar[XB_TOP], 1u);
            const unsigned tg = og / nx;
            if (og + 1u == (tg + 1u) * nx) xb_add(&bar[XB_TOPGEN], 1u);
            else XB_SPIN(xb_ld(&bar[XB_TOPGEN]) == tg, bar);
            __builtin_amdgcn_fence(__ATOMIC_ACQUIRE, "agent");
            xb_add(&bar[XB_XGEN(b.x)], 1u);
            asm volatile("s_waitcnt vmcnt(0)" ::: "memory");
        } else {
            XB_SPIN(xb_ld(&bar[XB_XGEN(b.x)]) == gen, bar);
            __builtin_amdgcn_fence(__ATOMIC_ACQUIRE, "agent");
            asm volatile("s_waitcnt vmcnt(0)" ::: "memory");
        }
    }
    __syncthreads();
}

struct Frame {
    LAS unsigned char* lds;
    int tid, lane, wave, gw;
    int G;
    const float* x; const float* mem; const int* pos;
    const float *w_in_ret, *w_in_fox, *b_forget, *w_mem_kv, *w_out, *w_up, *w_down, *g_pre_mix, *g_post_mix, *g_pre_mlp, *g_post_mlp, *g_mem;
    float* out;
    bf16 *Win0, *Win1, *Wmem, *Wout, *Wup, *Wdn, *MEMKV, *XN, *H, *PROJ, *MEMN;
    float *LOGF, *CS, *R1;
};
__device__ __forceinline__ float wave_sum(float v) {
#pragma unroll
    for (int o = 1; o < 64; o <<= 1) v += __shfl_xor(v, o);
    return v;
}

__device__ __forceinline__ int dst_row(int mode, int n) {
    if (mode == 0) return n;
    if (mode == 1) {
        if (n < 768) { const int h = n >> 7, d = n & 127; return C_Q + h * 128 + ((d & 63) << 1) + (d >> 6); }
        if (n < 1536) { const int m = n - 768, h = m >> 7, d = m & 127; return C_K + h * 128 + ((d & 63) << 1) + (d >> 6); }
        if (n < 2304) return C_V + (n - 1536);
        if (n < 3072) return C_G + (n - 2304);
        return C_MQ + (n - 3072);
    }
    if (n < 768) return C_Q + n;
    if (n < 1536) return C_K + (n - 768);
    if (n < 2304) return C_V + (n - 1536);
    if (n < 2316) return C_G + (n - 2304);
    return C_MQ + (n - 2316);
}
__device__ __forceinline__ void p0_transpose_item(const float* W, int K, int N, bf16* WT, int mode, int row_off, const float* gain, LAS float* scr, int item, int lane) {
    const int nblk = (N + 31) / 32, kb = item / nblk, nb = item % nblk, k0 = 64 * kb, n0 = 32 * nb;
    const int nn = n0 + (lane & 31);
#pragma unroll 8
    for (int i = 0; i < 32; ++i) { const int kk = 2 * i + (lane >> 5);
        float v = 0.f; if (nn < N) { v = W[(size_t)(k0 + kk) * N + nn]; if (gain) v *= gain[k0 + kk]; }
        scr[kk * 33 + (lane & 31)] = v; }
    LDS_WAIT(); asm volatile("" ::: "memory");
    const int c = lane & 7;
#pragma unroll
    for (int j = 0; j < 4; ++j) { const int nl = (lane >> 3) + 8 * j; const int n = n0 + nl;
        if (n < N) { const LAS float* s = scr + (8 * c) * 33 + nl;
            v4u o; o.x = pk2(s[0 * 33], s[1 * 33]); o.y = pk2(s[2 * 33], s[3 * 33]); o.z = pk2(s[4 * 33], s[5 * 33]); o.w = pk2(s[6 * 33], s[7 * 33]);
            *(GAS v4u*)(WT + (size_t)(row_off + dst_row(mode, n)) * K + k0 + 8 * c) = o; } }
    LDS_WAIT(); asm volatile("" ::: "memory");
}
__device__ __forceinline__ void rms_row_to_bf16(const float* xrow, bf16* orow, int lane) {
    const GAS f32x4* xr = (const GAS f32x4*)xrow + lane;
    f32x4 v[4]; float s = 0.f;
#pragma unroll
    for (int j = 0; j < 4; ++j) { v[j] = xr[64 * j]; s += (v[j].x * v[j].x + v[j].y * v[j].y) + (v[j].z * v[j].z + v[j].w * v[j].w); }
    const float rstd = 1.0f / sqrtf(wave_sum(s) * (1.f / DM) + EPS);
    GAS unsigned long long* o8 = (GAS unsigned long long*)orow + lane;
#pragma unroll
    for (int j = 0; j < 4; ++j) o8[64 * j] = (unsigned long long)pk2(v[j].x * rstd, v[j].y * rstd) | ((unsigned long long)pk2(v[j].z * rstd, v[j].w * rstd) << 32);
}
__device__ __forceinline__ void p0_prologue(Frame& F) {
    LAS float* scr = (LAS float*)(F.lds + RING_OFF + F.wave * 16384);
    const int gw = F.gw, NGW = F.G * NWAVES;
    constexpr int KB = DM / 64;
    constexpr int I_IN0 = KB * (3328 / 32), I_IN1 = KB * ((2572 + 31) / 32), I_MEM = KB * (512 / 32), I_OUT = KB * (DM / 32), I_UP = KB * (FF / 32), I_DN = (FF / 64) * (DM / 32);
    constexpr int NITEMS = I_IN0 + I_IN1 + 2 * I_MEM + 2 * I_OUT + 2 * I_UP + 2 * I_DN;
    for (int it = gw; it < NITEMS; it += NGW) {
        int r = it;
        if (r < I_IN0) { p0_transpose_item(F.w_in_ret, DM, 3328, F.Win0, 1, 0, F.g_pre_mix, scr, r, F.lane); continue; } r -= I_IN0;
        if (r < I_IN1) { p0_transpose_item(F.w_in_fox, DM, 2572, F.Win1, 2, 0, F.g_pre_mix + DM, scr, r, F.lane); continue; } r -= I_IN1;
        if (r < 2 * I_MEM) { const int l = r / I_MEM; p0_transpose_item(F.w_mem_kv + (size_t)l * DM * 512, DM, 512, F.Wmem, 0, l * 512, F.g_mem + l * DM, scr, r % I_MEM, F.lane); continue; } r -= 2 * I_MEM;
        if (r < 2 * I_OUT) { const int l = r / I_OUT; p0_transpose_item(F.w_out + (size_t)l * DM * DM, DM, DM, F.Wout + (size_t)l * DM * DM, 0, 0, nullptr, scr, r % I_OUT, F.lane); continue; } r -= 2 * I_OUT;
        if (r < 2 * I_UP) { const int l = r / I_UP; p0_transpose_item(F.w_up + (size_t)l * DM * FF, DM, FF, F.Wup + (size_t)l * DM * FF, 0, 0, F.g_pre_mlp + l * DM, scr, r % I_UP, F.lane); continue; } r -= 2 * I_UP;
        { const int l = r / I_DN; p0_transpose_item(F.w_down + (size_t)l * DM * FF, FF, DM, F.Wdn + (size_t)l * DM * FF, 0, 0, nullptr, scr, r % I_DN, F.lane); }
    }
    { GAS v4u* z = (GAS v4u*)(F.Win1 + (size_t)(C_G + 12) * DM); const int n16 = (NP1 - C_G - 12) * DM * 2 / 16;
      for (int i = gw * 64 + F.lane; i < n16; i += NGW * 64) z[i] = (v4u){0u, 0u, 0u, 0u}; }
    for (int m = gw; m < MTOK; m += NGW) rms_row_to_bf16(F.x + (size_t)m * DM, F.XN + (size_t)m * DM, F.lane);
    for (int m = gw; m < MMEM; m += NGW) rms_row_to_bf16(F.mem + (size_t)m * DM, F.MEMN + (size_t)m * DM, F.lane);
}

__device__ __forceinline__ void row_pass(Frame& F, const float* y, const float* base, const float* gain, float* xo, bf16* xn) {
    const int NGW = F.G * NWAVES;
    f32x4 g[4];
#pragma unroll
    for (int j = 0; j < 4; ++j) g[j] = ((const GAS f32x4*)gain)[F.lane + 64 * j];
    for (int m = F.gw; m < MTOK; m += NGW) {
        const GAS f32x4* yr = (const GAS f32x4*)(y + (size_t)m * DM) + F.lane; const GAS f32x4* br = (const GAS f32x4*)(base + (size_t)m * DM) + F.lane;
        f32x4 v[4], b[4]; float s = 0.f;
#pragma unroll
        for (int j = 0; j < 4; ++j) { v[j] = yr[64 * j]; b[j] = br[64 * j]; s += (v[j].x * v[j].x + v[j].y * v[j].y) + (v[j].z * v[j].z + v[j].w * v[j].w); }
        const float rstd = 1.0f / sqrtf(wave_sum(s) * (1.f / DM) + EPS);
        float s2 = 0.f;
#pragma unroll
        for (int j = 0; j < 4; ++j) { v[j] = b[j] + v[j] * rstd * g[j]; s2 += (v[j].x * v[j].x + v[j].y * v[j].y) + (v[j].z * v[j].z + v[j].w * v[j].w); }
        GAS f32x4* o = (GAS f32x4*)(xo + (size_t)m * DM) + F.lane;
#pragma unroll
        for (int j = 0; j < 4; ++j) o[64 * j] = v[j];
        if (xn) {
            const float r2 = 1.0f / sqrtf(wave_sum(s2) * (1.f / DM) + EPS);
            GAS unsigned long long* o8 = (GAS unsigned long long*)(xn + (size_t)m * DM) + F.lane;
#pragma unroll
            for (int j = 0; j < 4; ++j) o8[64 * j] = (unsigned long long)pk2(v[j].x * r2, v[j].y * r2) | ((unsigned long long)pk2(v[j].z * r2, v[j].w * r2) << 32);
        }
    }
}

__device__ __forceinline__ void naive_retention(Frame& F) {
    bf16* P = F.PROJ; constexpr int ld = NP0;
    for (int j = 0; j < 6; ++j) {
        const int bh = (F.gw >> 7) + 16 * j, tb = ((F.gw & 127) + 37 * j) & 127;
        const int b = bh / 6, h = bh % 6, t = tb * 16 + (F.lane >> 2), dvq = F.lane & 3;
        const size_t row = (size_t)b * SEQ + t;
        v4u qp[16];
        { const GAS v4u* qs = (const GAS v4u*)(P + row * ld + C_Q + h * 128);
#pragma unroll
          for (int i = 0; i < 16; ++i) qp[i] = qs[i]; }
        float o[32];
#pragma unroll
        for (int i = 0; i < 32; ++i) o[i] = 0.f;
        const float lg = __log2f(1.f - exp2f(-5.f - (float)h));
        const int tmax = tb * 16 + 15;
        for (int s = 0; s <= tmax; ++s) {
            const size_t srow = (size_t)b * SEQ + s;
            const GAS v4u* ks = (const GAS v4u*)(P + srow * ld + C_K + h * 128);
            float dot = 0.f;
#pragma unroll
            for (int i = 0; i < 16; ++i) { const v4u kk = ks[i];
                dot += bflo(qp[i].x) * bflo(kk.x) + bfhi(qp[i].x) * bfhi(kk.x) + bflo(qp[i].y) * bflo(kk.y) + bfhi(qp[i].y) * bfhi(kk.y)
                     + bflo(qp[i].z) * bflo(kk.z) + bfhi(qp[i].z) * bfhi(kk.z) + bflo(qp[i].w) * bflo(kk.w) + bfhi(qp[i].w) * bfhi(kk.w); }
            const float w = (s <= t) ? dot * exp2f((float)(t - s) * lg) : 0.f;
            const GAS v4u* vs = (const GAS v4u*)(P + srow * ld + C_V + h * 128 + dvq * 32);
#pragma unroll
            for (int i = 0; i < 4; ++i) { const v4u vv = vs[i];
                o[8 * i + 0] += w * bflo(vv.x); o[8 * i + 1] += w * bfhi(vv.x); o[8 * i + 2] += w * bflo(vv.y); o[8 * i + 3] += w * bfhi(vv.y);
                o[8 * i + 4] += w * bflo(vv.z); o[8 * i + 5] += w * bfhi(vv.z); o[8 * i + 6] += w * bflo(vv.w); o[8 * i + 7] += w * bfhi(vv.w); }
        }
        float ss = 0.f;
#pragma unroll
        for (int i = 0; i < 32; ++i) ss += o[i] * o[i];
        ss += __shfl_xor(ss, 1); ss += __shfl_xor(ss, 2);
        const float rstd = 1.0f / sqrtf(ss * (1.f / 128.f) + EPS);
        const GAS v4u* gs = (const GAS v4u*)(P + row * ld + C_G + h * 128 + dvq * 32);
        GAS v4u* os = (GAS v4u*)(P + row * ld + C_Q + h * 128 + dvq * 32);
#pragma unroll
        for (int i = 0; i < 4; ++i) { const v4u gg = gs[i]; v4u w;
            w.x = pk2(o[8 * i + 0] * rstd * bflo(gg.x), o[8 * i + 1] * rstd * bfhi(gg.x)); w.y = pk2(o[8 * i + 2] * rstd * bflo(gg.y), o[8 * i + 3] * rstd * bfhi(gg.y));
            w.z = pk2(o[8 * i + 4] * rstd * bflo(gg.z), o[8 * i + 5] * rstd * bfhi(gg.z)); w.w = pk2(o[8 * i + 6] * rstd * bflo(gg.w), o[8 * i + 7] * rstd * bfhi(gg.w));
            os[i] = w; }
    }
}
#define NAIVE_ATT_BODY(NKEYS, KPTR, VPTR, BIAS, VALID) \
    float o[64]; _Pragma("unroll") for (int i = 0; i < 64; ++i) o[i] = 0.f; \
    float mrun = -INFINITY, lrun = 0.f; \
    for (int s = 0; s < (NKEYS); ++s) { \
        const GAS v4u* ks = (const GAS v4u*)(KPTR); float dot = 0.f; \
        _Pragma("unroll") for (int i = 0; i < 8; ++i) { const v4u kk = ks[i]; \
            dot += bflo(qp[i].x) * bflo(kk.x) + bfhi(qp[i].x) * bfhi(kk.x) + bflo(qp[i].y) * bflo(kk.y) + bfhi(qp[i].y) * bfhi(kk.y) \
                 + bflo(qp[i].z) * bflo(kk.z) + bfhi(qp[i].z) * bfhi(kk.z) + bflo(qp[i].w) * bflo(kk.w) + bfhi(qp[i].w) * bfhi(kk.w); } \
        const float logit = dot + (BIAS); \
        if (VALID) { const float mn = fmaxf(mrun, logit), a = exp2f(mrun - mn), p = exp2f(logit - mn); lrun = lrun * a + p; mrun = mn; \
            const GAS v4u* vs = (const GAS v4u*)(VPTR); \
            _Pragma("unroll") for (int i = 0; i < 8; ++i) { const v4u vv = vs[i]; \
                o[8 * i + 0] = o[8 * i + 0] * a + p * bflo(vv.x); o[8 * i + 1] = o[8 * i + 1] * a + p * bfhi(vv.x); o[8 * i + 2] = o[8 * i + 2] * a + p * bflo(vv.y); o[8 * i + 3] = o[8 * i + 3] * a + p * bfhi(vv.y); \
                o[8 * i + 4] = o[8 * i + 4] * a + p * bflo(vv.z); o[8 * i + 5] = o[8 * i + 5] * a + p * bfhi(vv.z); o[8 * i + 6] = o[8 * i + 6] * a + p * bflo(vv.w); o[8 * i + 7] = o[8 * i + 7] * a + p * bfhi(vv.w); } } \
    } \
    const float rl = 1.0f / lrun;
#define NAIVE_ATT_STORE(OPTR) { GAS v4u* os = (GAS v4u*)(OPTR); \
    _Pragma("unroll") for (int i = 0; i < 8; ++i) { v4u w; w.x = pk2(o[8 * i + 0] * rl, o[8 * i + 1] * rl); w.y = pk2(o[8 * i + 2] * rl, o[8 * i + 3] * rl); \
        w.z = pk2(o[8 * i + 4] * rl, o[8 * i + 5] * rl); w.w = pk2(o[8 * i + 6] * rl, o[8 * i + 7] * rl); os[i] = w; } }

__device__ __forceinline__ void naive_fox(Frame& F) {
    bf16* P = F.PROJ; constexpr int ld = NP1;
    for (int j = 0; j < 3; ++j) {
        const int bh = (F.gw >> 5) + 64 * j, tb = ((F.gw & 31) + 11 * j) & 31;
        const int b = bh / 12, h = bh % 12, t = tb * 64 + F.lane;
        const size_t row = (size_t)b * SEQ + t;
        v4u qp[8];
        { const GAS v4u* qs = (const GAS v4u*)(P + row * ld + C_Q + h * 64);
#pragma unroll
          for (int i = 0; i < 8; ++i) qp[i] = qs[i]; }
        const float* cs = F.CS + (size_t)(b * 12 + h) * SEQ; const float ct = cs[t];
        const int nk = tb * 64 + 64;
        NAIVE_ATT_BODY(nk, P + ((size_t)b * SEQ + s) * ld + C_K + h * 64, P + ((size_t)b * SEQ + s) * ld + C_V + h * 64, ct - cs[s], s <= t)
        NAIVE_ATT_STORE(P + row * ld + C_Q + h * 64)
    }
}
__device__ __forceinline__ void naive_mem(Frame& F, int layer) {
    bf16* P = F.PROJ; const int ld = layer ? NP1 : NP0;
    const int b = F.gw >> 7, tb = (F.gw & 127) >> 2, hm = F.gw & 3, t = tb * 64 + F.lane;
    const size_t row = (size_t)b * SEQ + t;
    v4u qp[8];
    { const GAS v4u* qs = (const GAS v4u*)(P + row * ld + C_MQ + hm * 64);
#pragma unroll
      for (int i = 0; i < 8; ++i) qp[i] = qs[i]; }
    const bf16* kv = F.MEMKV + (size_t)b * MEML * DM + layer * 512 + hm * 64;
    NAIVE_ATT_BODY(MEML, kv + (size_t)s * DM, kv + (size_t)s * DM + 256, 0.f, true)
    NAIVE_ATT_STORE(P + row * ld + C_MQ + hm * 64)
}
__device__ __forceinline__ void scan_phase(Frame& F) {
    if (F.gw >= BATCH * 12) return;
    const int b = F.gw / 12, h = F.gw % 12;
    const float* src = F.LOGF + ((size_t)b * SEQ + F.lane * 32) * 16 + h;
    float s = 0.f;
    for (int i = 0; i < 32; ++i) s += src[(size_t)i * 16];
    float incl = s;
#pragma unroll
    for (int o = 1; o < 64; o <<= 1) { const float v = __shfl_up(incl, o); if (F.lane >= o) incl += v; }
    float run = incl - s;
    float* dst = F.CS + (size_t)(b * 12 + h) * SEQ + F.lane * 32;
    for (int i = 0; i < 32; ++i) { run += src[(size_t)i * 16]; dst[i] = run; }
}

struct Args { const float* in[15]; float* out; unsigned char* ws; int ph_lo, ph_hi; };
__global__ void __launch_bounds__(NWAVES * 64, 2) fwd_kernel(Args args) {
    extern __shared__ __attribute__((aligned(16))) unsigned char lds[];
    Frame F;
    F.lds = (LAS unsigned char*)lds;
    F.tid = threadIdx.x; F.lane = F.tid & 63; F.wave = __builtin_amdgcn_readfirstlane(F.tid >> 6);
    F.G = gridDim.x; F.gw = blockIdx.x * NWAVES + F.wave;
    unsigned char* ws = args.ws;
    F.x = args.in[0]; F.mem = args.in[1]; F.pos = (const int*)args.in[2]; F.w_in_ret = args.in[3]; F.w_in_fox = args.in[4]; F.b_forget = args.in[5]; F.w_mem_kv = args.in[6];
    F.w_out = args.in[7]; F.w_up = args.in[8]; F.w_down = args.in[9]; F.g_pre_mix = args.in[10]; F.g_post_mix = args.in[11]; F.g_pre_mlp = args.in[12]; F.g_post_mlp = args.in[13]; F.g_mem = args.in[14];
    F.out = args.out;
    F.Win0 = (bf16*)(ws + WS_WIN0); F.Win1 = (bf16*)(ws + WS_WIN1); F.Wmem = (bf16*)(ws + WS_WMEM); F.Wout = (bf16*)(ws + WS_WOUT); F.Wup = (bf16*)(ws + WS_WUP); F.Wdn = (bf16*)(ws + WS_WDN);
    F.MEMKV = (bf16*)(ws + WS_MEMKV); F.XN = (bf16*)(ws + WS_XN); F.H = (bf16*)(ws + WS_H); F.PROJ = (bf16*)(ws + WS_PROJ); F.MEMN = (bf16*)(ws + WS_MEMN);
    F.LOGF = (float*)(ws + WS_LOGF); F.CS = (float*)(ws + WS_CS); F.R1 = (float*)(ws + WS_R1);
    for (int u = F.tid; u < (LDS_BYTES - LDSCTL_OFF) / 4; u += NWAVES * 64) ((LAS unsigned*)(F.lds + LDSCTL_OFF))[u] = 0u;
    __syncthreads();
    volatile LAS unsigned* MISC = (volatile LAS unsigned*)(F.lds + MISC_OFF);
    XcdBarrier bar = xcd_barrier_post((unsigned*)(ws + WS_CTL) + CW_BAR, MISC + 8);
    const int lo = args.ph_lo, hi = args.ph_hi;
    int ph = 0;
#define RUN() (lo <= ph && ph < hi)
#define SEAM() do { if (lo <= ph && ph + 1 < hi) xcd_barrier(bar); ++ph; } while (0)
#define RELANE() do { int t_ = threadIdx.x; asm volatile("" : "+v"(t_)); F.tid = t_; F.lane = t_ & 63; F.wave = __builtin_amdgcn_readfirstlane(t_ >> 6); F.gw = blockIdx.x * NWAVES + F.wave; } while (0)
    LAS unsigned char* ring = F.lds + RING_OFF;
    const int G = F.G, c = (int)blockIdx.x;

    if (RUN()) { RELANE(); p0_prologue(F); }
    SEAM();
    for (int layer = 0; layer < 2; ++layer) {
        const int NP = layer ? NP1 : NP0;
        if (RUN()) {
            pg8::Gemm g{F.XN, layer ? F.Win1 : F.Win0, MTOK, NP, DM, DM}; pg8::StaticOrder S; S.init(MTOK, NP, G, c);
            pg8::EpiProj E{F.PROJ, NP, layer, F.pos, F.LOGF, F.b_forget};
            pg8::gemm_phase<pg8::EpiProj, pg8::StaticOrder, true, true>(ring, g, S, E);
            if (layer == 0) {
                pg8::Gemm g2{F.MEMN, F.Wmem, MMEM, DM, DM, DM}; pg8::OneUnit S2; const int idx = c - 128; S2.has = (idx >= 0 && idx < 64); S2.u0.pm = idx >> 2; S2.u0.pn = idx & 3;
                pg8::EpiBf16<0> E2{F.MEMKV, DM};
                pg8::gemm_phase<pg8::EpiBf16<0>, pg8::OneUnit, true, true>(ring, g2, S2, E2);
            }
        }
        SEAM();
        if (RUN()) { RELANE(); if (layer == 1) scan_phase(F); }
        SEAM();
        if (RUN()) { RELANE(); if (layer == 0) naive_retention(F); else naive_fox(F); RELANE(); naive_mem(F, layer); }
        SEAM();
        if (RUN()) {
            pg8::Gemm g{F.PROJ, F.Wout + (size_t)layer * DM * DM, MTOK, DM, DM, NP}; pg8::StaticOrder S; S.init(MTOK, DM, G, c);
            pg8::EpiF32 E{F.out, DM};
            pg8::gemm_phase<pg8::EpiF32, pg8::StaticOrder, true, true>(ring, g, S, E);
        }
        SEAM();
        if (RUN()) { RELANE(); row_pass(F, F.out, layer ? F.R1 : F.x, F.g_post_mix + layer * DM, F.R1, F.XN); }
        SEAM();
        if (RUN()) {
            pg8::Gemm g{F.XN, F.Wup + (size_t)layer * DM * FF, MTOK, FF, DM, DM}; pg8::StaticOrder S; S.init(MTOK, FF, G, c);
            pg8::EpiBf16<1> E{F.H, FF};
            pg8::gemm_phase<pg8::EpiBf16<1>, pg8::StaticOrder, true, true>(ring, g, S, E);
        }
        SEAM();
        if (RUN()) {
            pg8::Gemm g{F.H, F.Wdn + (size_t)layer * DM * FF, MTOK, DM, FF, FF}; pg8::StaticOrder S; S.init(MTOK, DM, G, c);
            pg8::EpiF32 E{F.out, DM};
            pg8::gemm_phase<pg8::EpiF32, pg8::StaticOrder, true, true>(ring, g, S, E);
        }
        SEAM();
        if (RUN()) { RELANE(); row_pass(F, F.out, F.R1, F.g_post_mlp + layer * DM, layer ? F.out : F.R1, layer ? nullptr : F.XN); }
        SEAM();
    }
#undef RUN
#undef SEAM
}

#ifndef MK_MULTI
#define MK_MULTI 0
#endif
constexpr int N_PHASES = 1 + 2 * 8;
extern "C" void kernel_launch(void* const* d_in, const int* in_sizes, int n_in, void* d_out, int out_size, void* d_ws, size_t ws_size, hipStream_t stream) {
    static int grid = 0;
    if (grid == 0) {
        if (n_in != 15 || in_sizes[0] != MTOK * DM || out_size != MTOK * DM || ws_size < WS_END) { fprintf(stderr, "kernel_launch: unexpected shapes (n_in %d, in0 %d, out %d, ws %zu); nothing launched\n", n_in, n_in > 0 ? in_sizes[0] : -1, out_size, ws_size); grid = -1; return; }
        int dev = 0, cus = 0, per_cu = 0;
        if (hipGetDevice(&dev) != hipSuccess || hipDeviceGetAttribute(&cus, hipDeviceAttributeMultiprocessorCount, dev) != hipSuccess) { grid = -1; return; }
        if (hipFuncSetAttribute((const void*)fwd_kernel, hipFuncAttributeMaxDynamicSharedMemorySize, LDS_BYTES) != hipSuccess) { fprintf(stderr, "kernel_launch: hipFuncSetAttribute failed\n"); grid = -1; return; }
        if (hipOccupancyMaxActiveBlocksPerMultiprocessor(&per_cu, (const void*)fwd_kernel, NWAVES * 64, LDS_BYTES) != hipSuccess || per_cu < 1)
            fprintf(stderr, "kernel_launch: occupancy query reports %d workgroups per CU\n", per_cu);
        (void)hipGetLastError();
        grid = cus;
    }
    if (grid < 0) return;
    if (hipMemsetAsync((char*)d_ws + WS_CTL, 0, CTL_ZERO_BYTES, stream) != hipSuccess) return;
    Args a{};
    for (int i = 0; i < 15; ++i) a.in[i] = (const float*)d_in[i];
    a.out = (float*)d_out; a.ws = (unsigned char*)d_ws;
#if MK_MULTI
    for (int p = 0; p < N_PHASES; ++p) { a.ph_lo = p; a.ph_hi = p + 1; hipLaunchKernelGGL(fwd_kernel, dim3(grid), dim3(NWAVES * 64), LDS_BYTES, stream, a); }
#else
    a.ph_lo = 0; a.ph_hi = N_PHASES;
    hipLaunchKernelGGL(fwd_kernel, dim3(grid), dim3(NWAVES * 64), LDS_BYTES, stream, a);
#endif
}
```

```cpp
#include <hip/hip_runtime.h>
#include <hip/hip_bf16.h>
#include <cmath>
#include <cstdio>
#include <cstdint>

constexpr int BATCH = 16, SEQ = 2048, DM = 1024, MTOK = BATCH * SEQ, MEML = 256, MMEM = BATCH * MEML, FF = 4096;
constexpr int NP0 = 3328, NP1 = 2816;
constexpr int C_Q = 0, C_MQ = 768, C_K = 1024, C_V = 1792, C_G = 2560;
constexpr float EPS = 1e-6f;
constexpr float LOG2E = 1.4426950408889634f;
constexpr float QSCALE = 0.125f * LOG2E;

namespace pg8 {
#define PG8_LAS __attribute__((address_space(3)))
typedef unsigned short bf16_t;
typedef short bf16x8 __attribute__((ext_vector_type(8)));
typedef float f32x4 __attribute__((ext_vector_type(4)));
typedef unsigned u32x4 __attribute__((ext_vector_type(4)));
constexpr int BM = 256, BK = 64, HALF = 128, HTB = HALF * BK * 2  , STAGE_BYTES = 8 * HTB, NXCD = 8, WGM = 8;

__host__ __device__ __forceinline__ int lds_byte(int r, int c) { const int st = (r >> 4) * 2 + (c >> 5), rr = r & 15, cc = c & 31, ob = rr * 64 + cc * 2; return st * 1024 + (ob ^ (((ob >> 9) & 1) << 5)); }
__host__ __device__ __forceinline__ void stage_rc(int b, int& R, int& C) { const int st = b / 1024, sb = b % 1024, swz = sb ^ (((sb >> 9) & 1) << 5); R = (st >> 1) * 16 + swz / 64; C = (st & 1) * 32 + (swz % 64) / 2; }
__host__ __device__ __forceinline__ int perm32(int rho) { const int n = rho >> 4, i = rho & 15; return 8 * (i >> 2) + 4 * n + (i & 3); }

struct Unit { int pm, pn; };
struct Gemm { const bf16_t* A; const bf16_t* Bt; int M, N, K, lda; };

struct StaticOrder {
    int nM, nN, nwg, G, c;
    __host__ __device__ void init(int M, int N, int G_, int c_) { nM = M / BM; nN = N / BM; nwg = nM * nN; G = G_; c = c_; }
    __host__ __device__ bool next(int i, Unit& u) const {
        const long L = (long)i * G + c; if (L >= nwg) return false;
        int wgid = (int)L; { const int q = nwg / NXCD, r = nwg % NXCD, xcd = wgid % NXCD, off = wgid / NXCD; wgid = (xcd < r ? xcd * (q + 1) : r * (q + 1) + (xcd - r) * q) + off; }
        const int nig = WGM * nN, gid = wgid / nig, fm = gid * WGM, gsz = (nM - fm) < WGM ? (nM - fm) : WGM;
        u.pm = fm + ((wgid % nig) % gsz); u.pn = (wgid % nig) / gsz; return true;
    }
    __device__ __forceinline__ void a_ready(const Unit&) const {}
    __device__ __forceinline__ void done(const Unit&) const {}
};
struct OneUnit {
    Unit u0; bool has;
    __device__ __forceinline__ bool next(int i, Unit& u) const { if (i != 0 || !has) return false; u = u0; return true; }
    __device__ __forceinline__ void a_ready(const Unit&) const {}
    __device__ __forceinline__ void done(const Unit&) const {}
};

typedef float f32x2_t __attribute__((ext_vector_type(2))); typedef __bf16 bf16x2_t __attribute__((ext_vector_type(2)));
__device__ __forceinline__ unsigned cvt_pk_bf16(float lo, float hi) { f32x2_t v = {lo, hi}; bf16x2_t b = __builtin_convertvector(v, bf16x2_t); return __builtin_bit_cast(unsigned, b); }

template <int ACT> struct EpiBf16 {
    static constexpr bool PERM = true, AFTER_DRAIN = false;
    bf16_t* O; int ldc;
    __device__ __forceinline__ void operator()(const f32x4 (&acc)[2][2][4][2], const Unit& u, int wr, int wc, int fr, int fq) const {
        const int row0 = u.pm * BM + wr * 64 + fr, col0 = u.pn * BM + wc * 32 + 8 * fq;
#pragma unroll
        for (int ai = 0; ai < 2; ++ai)
#pragma unroll
            for (int m = 0; m < 4; ++m) { bf16_t* rowp = O + (size_t)(row0 + ai * HALF + m * 16) * ldc + col0;
#pragma unroll
                for (int bj = 0; bj < 2; ++bj) { f32x4 v0 = acc[ai][bj][m][0], v1 = acc[ai][bj][m][1];
                    if (ACT == 1) {
#pragma unroll
                        for (int e = 0; e < 4; ++e) { const float a = fmaxf(v0[e], 0.f), b = fmaxf(v1[e], 0.f); v0[e] = a * a; v1[e] = b * b; } }
                    u32x4 w; w.x = cvt_pk_bf16(v0[0], v0[1]); w.y = cvt_pk_bf16(v0[2], v0[3]); w.z = cvt_pk_bf16(v1[0], v1[1]); w.w = cvt_pk_bf16(v1[2], v1[3]);
                    *(u32x4*)(rowp + bj * HALF) = w; } }
    }
};
struct EpiF32 {
    static constexpr bool PERM = false, AFTER_DRAIN = false;
    float* O; int ldc;
    __device__ __forceinline__ void operator()(const f32x4 (&acc)[2][2][4][2], const Unit& u, int wr, int wc, int fr, int fq) const {
        const int row0 = u.pm * BM + wr * 64 + fr, col0 = u.pn * BM + wc * 32 + 4 * fq;
#pragma unroll
        for (int ai = 0; ai < 2; ++ai)
#pragma unroll
            for (int m = 0; m < 4; ++m) { float* rowp = O + (size_t)(row0 + ai * HALF + m * 16) * ldc + col0;
#pragma unroll
                for (int bj = 0; bj < 2; ++bj)
#pragma unroll
                    for (int n = 0; n < 2; ++n) *(f32x4*)(rowp + bj * HALF + n * 16) = acc[ai][bj][m][n]; }
    }
};
struct EpiProj {
    static constexpr bool PERM = true, AFTER_DRAIN = false;
    bf16_t* O; int ldc; int layer; const int* pos; float* logf; const float* bfg;
    __device__ __forceinline__ void operator()(const f32x4 (&acc)[2][2][4][2], const Unit& u, int wr, int wc, int fr, int fq) const {
        const int row0 = u.pm * BM + wr * 64 + fr, cw = wc * 32 + 8 * fq, col0 = u.pn * BM + cw;
        int mode; float sc = 1.f;
        if (layer == 0) { if (u.pn < 3) mode = 1; else if (u.pn == 3) { mode = 0; sc = QSCALE; } else if (u.pn < 7) { mode = 1; sc = 0.08838834764831845f; } else if (u.pn < 10) mode = 0; else mode = 4; }
        else { if (u.pn < 4) { mode = 0; sc = QSCALE; } else if (u.pn < 10) mode = 0; else mode = 5; }
        if (mode == 5) {
            if (wc == 0 && fq < 2) {
#pragma unroll
                for (int ai = 0; ai < 2; ++ai)
#pragma unroll
                    for (int m = 0; m < 4; ++m) { const int row = row0 + ai * HALF + m * 16;
#pragma unroll
                        for (int n = 0; n < 2; ++n)
#pragma unroll
                            for (int e = 0; e < 4; ++e) { const int c = 8 * fq + 4 * n + e;
                                if (c < 12) { const float z = acc[ai][0][m][n][e] + bfg[c]; const float az = fabsf(z);
                                    logf[(size_t)row * 16 + c] = fminf(z, 0.f) * LOG2E - __log2f(1.f + exp2f(-az * LOG2E)); } } }
            }
            return;
        }
        float invf[4];
        if (mode == 1) {
#pragma unroll
            for (int p = 0; p < 4; ++p) invf[p] = exp2f(-(float)((cw >> 1) + p) * (13.287712379549449f / 64.f)) * 0.15915494309189535f;
        }
#pragma unroll
        for (int ai = 0; ai < 2; ++ai)
#pragma unroll
            for (int m = 0; m < 4; ++m) { const int row = row0 + ai * HALF + m * 16; bf16_t* rowp = O + (size_t)row * ldc + col0;
                float cs[4], sn[4];
                if (mode == 1) { const float ps = (float)pos[row];
#pragma unroll
                    for (int p = 0; p < 4; ++p) { float rev = ps * invf[p]; rev = rev - floorf(rev); sn[p] = __builtin_amdgcn_sinf(rev); cs[p] = __builtin_amdgcn_cosf(rev); } }
#pragma unroll
                for (int bj = 0; bj < 2; ++bj) { f32x4 v0 = acc[ai][bj][m][0], v1 = acc[ai][bj][m][1];
                    if (mode == 1) {
                        const float a0 = v0[0] * cs[0] - v0[1] * sn[0], b0 = v0[0] * sn[0] + v0[1] * cs[0];
                        const float a1 = v0[2] * cs[1] - v0[3] * sn[1], b1 = v0[2] * sn[1] + v0[3] * cs[1];
                        const float a2 = v1[0] * cs[2] - v1[1] * sn[2], b2 = v1[0] * sn[2] + v1[1] * cs[2];
                        const float a3 = v1[2] * cs[3] - v1[3] * sn[3], b3 = v1[2] * sn[3] + v1[3] * cs[3];
                        v0 = (f32x4){a0, b0, a1, b1}; v1 = (f32x4){a2, b2, a3, b3};
                    } else if (mode == 4) {
#pragma unroll
                        for (int e = 0; e < 4; ++e) { v0[e] = v0[e] / (1.f + exp2f(-v0[e] * LOG2E)); v1[e] = v1[e] / (1.f + exp2f(-v1[e] * LOG2E)); }
                    }
                    v0 = v0 * sc; v1 = v1 * sc;
                    u32x4 w; w.x = cvt_pk_bf16(v0[0], v0[1]); w.y = cvt_pk_bf16(v0[2], v0[3]); w.z = cvt_pk_bf16(v1[0], v1[1]); w.w = cvt_pk_bf16(v1[2], v1[3]);
                    *(u32x4*)(rowp + bj * HALF) = w; } }
    }
};

template <class Epi, class Sched, bool ALIGN_EPI = false, bool SP2 = false>
__device__ __forceinline__ void gemm_phase(PG8_LAS unsigned char* lds, const Gemm g, const Sched& S, const Epi& E) {
    int tid_ = threadIdx.x; asm volatile("" : "+v"(tid_));
    const int tid = tid_, wid = __builtin_amdgcn_readfirstlane(tid >> 6), lane = tid & 63, wr = wid >> 2, wc = wid & 3, fr = lane & 15, fq = lane >> 4;
    const int K = g.K, nt = K / BK;
    unsigned voffA[2], voffB[2];
#pragma unroll
    for (int i = 0; i < 2; ++i) { int R, C; stage_rc(tid * 16 + i * 8192, R, C); const int Rb = Epi::PERM ? ((R & ~31) + perm32(R & 31)) : R;
        voffA[i] = (unsigned)(R * g.lda + C) * 2u; voffB[i] = (unsigned)(Rb * K + C) * 2u; }
    const size_t kstep = (size_t)(BK * 2);
    const size_t hstepA = (size_t)HALF * g.lda * 2, hstepB = (size_t)HALF * K * 2;
    const size_t tstepA = 2 * hstepA, tstepB = 2 * hstepB;
    const unsigned ldsw = (unsigned)wid * 1024u;
    const int aoff = lds_byte(wr * 64 + fr, fq * 8), boff = lds_byte(wc * 32 + fr, fq * 8);
#define PG8_SA(b, h) (((b) * 2 + (h)) * HTB)
#define PG8_SB(b, h) ((4 + (b) * 2 + (h)) * HTB)
#define PG8_STAGE(bufoff, gbase, voff) do { _Pragma("unroll") for (int _i = 0; _i < 2; ++_i) \
        __builtin_amdgcn_global_load_lds((const unsigned*)((const char*)(gbase) + (voff)[_i]), (PG8_LAS unsigned*)(lds + (bufoff) + ldsw + _i * 8192), 16, 0, 0); } while (0)
#define PG8_LDA(dst, b, h) do { _Pragma("unroll") for (int m = 0; m < 4; ++m) _Pragma("unroll") for (int k = 0; k < 2; ++k) dst[m][k] = *(const PG8_LAS bf16x8*)(lds + PG8_SA(b, h) + aoff + m * 2048 + k * 1024); } while (0)
#define PG8_LDB(dst, b, h) do { _Pragma("unroll") for (int n = 0; n < 2; ++n) _Pragma("unroll") for (int k = 0; k < 2; ++k) dst[n][k] = *(const PG8_LAS bf16x8*)(lds + PG8_SB(b, h) + boff + n * 2048 + k * 1024); } while (0)
#define PG8_MMA(ai, bj, At, Bt) do { __builtin_amdgcn_s_setprio(1); _Pragma("unroll") for (int m = 0; m < 4; ++m) _Pragma("unroll") for (int n = 0; n < 2; ++n) _Pragma("unroll") for (int k = 0; k < 2; ++k) \
        acc[ai][bj][m][n] = __builtin_amdgcn_mfma_f32_16x16x32_bf16(Bt[n][k], At[m][k], acc[ai][bj][m][n], 0, 0, 0); __builtin_amdgcn_s_setprio(0); } while (0)
#define PG8_WAIT_V(n) asm volatile("s_waitcnt vmcnt(" #n ")" ::: "memory")
#define PG8_WAIT_L(n) asm volatile("s_waitcnt lgkmcnt(" #n ")" ::: "memory")
#define PG8_BAR __builtin_amdgcn_s_barrier()
#define PG8_SCHED __builtin_amdgcn_sched_barrier(0)
    Unit cur, nxt; int ui = 0;
    if (!S.next(0, cur)) return;
    f32x4 acc[2][2][4][2];
#pragma unroll
    for (int a = 0; a < 2; ++a)
#pragma unroll
        for (int b = 0; b < 2; ++b)
#pragma unroll
            for (int m = 0; m < 4; ++m)
#pragma unroll
                for (int n = 0; n < 2; ++n) acc[a][b][m][n] = (f32x4){0.f, 0.f, 0.f, 0.f};
    bf16x8 At[4][2], B0[2][2], B1[2][2];
    const char* cA = (const char*)g.A + (size_t)cur.pm * tstepA; const char* cB = (const char*)g.Bt + (size_t)cur.pn * tstepB;
    S.a_ready(cur);
    if constexpr (SP2) {
        PG8_STAGE(PG8_SB(0, 0), cB, voffB); PG8_STAGE(PG8_SB(0, 1), cB + hstepB, voffB); PG8_STAGE(PG8_SA(0, 0), cA, voffA); PG8_STAGE(PG8_SA(0, 1), cA + hstepA, voffA);
        if (wr == 1) PG8_BAR;
        PG8_WAIT_V(2); PG8_BAR;
        PG8_STAGE(PG8_SB(1, 0), cB + kstep, voffB); PG8_STAGE(PG8_SA(1, 0), cA + kstep, voffA); PG8_STAGE(PG8_SB(1, 1), cB + hstepB + kstep, voffB);
        PG8_WAIT_V(6); PG8_BAR;
    } else {
        PG8_STAGE(PG8_SB(0, 0), cB, voffB); PG8_STAGE(PG8_SA(0, 0), cA, voffA); PG8_STAGE(PG8_SB(0, 1), cB + hstepB, voffB); PG8_STAGE(PG8_SA(0, 1), cA + hstepA, voffA);
        if (wr == 1) PG8_BAR;
        PG8_WAIT_V(4); PG8_BAR;
        PG8_STAGE(PG8_SB(1, 0), cB + kstep, voffB); PG8_STAGE(PG8_SA(1, 0), cA + kstep, voffA); PG8_STAGE(PG8_SB(1, 1), cB + hstepB + kstep, voffB);
        PG8_WAIT_V(6); PG8_BAR;
    }
    for (;;) {
        const bool has_next = S.next(ui + 1, nxt);
        const char* nA = has_next ? (const char*)g.A + (size_t)nxt.pm * tstepA : cA; const char* nB = has_next ? (const char*)g.Bt + (size_t)nxt.pn * tstepB : cB;
        for (int t = 0; t < nt; t += 2) {
            const bool last = (t == nt - 2);
            const char* a1 = cA + (size_t)(t + 1) * kstep;
            const char* a2 = last ? nA : cA + (size_t)(t + 2) * kstep; const char* b2 = last ? nB : cB + (size_t)(t + 2) * kstep;
            const char* a3 = a2 + kstep; const char* b3 = b2 + kstep;
            if (last && has_next) S.a_ready(nxt);
            if constexpr (SP2) {
            PG8_LDB(B0, 0, 0); PG8_LDB(B1, 0, 1); PG8_SCHED; PG8_LDA(At, 0, 0); PG8_STAGE(PG8_SA(1, 1), a1 + hstepA, voffA);
            PG8_WAIT_V(8); PG8_WAIT_L(0); PG8_BAR; PG8_MMA(0, 0, At, B0); PG8_MMA(0, 1, At, B1); PG8_BAR; PG8_SCHED;
            PG8_LDA(At, 0, 1); PG8_STAGE(PG8_SB(0, 0), b2, voffB); PG8_STAGE(PG8_SB(0, 1), b2 + hstepB, voffB); PG8_STAGE(PG8_SA(0, 0), a2, voffA);
            PG8_WAIT_V(8); PG8_WAIT_L(0); PG8_BAR; PG8_MMA(1, 0, At, B0); PG8_MMA(1, 1, At, B1); PG8_BAR; PG8_SCHED;
            PG8_LDB(B0, 1, 0); PG8_LDB(B1, 1, 1); PG8_SCHED; PG8_LDA(At, 1, 0); PG8_STAGE(PG8_SA(0, 1), a2 + hstepA, voffA);
            PG8_WAIT_V(8); PG8_WAIT_L(0); PG8_BAR; PG8_MMA(0, 0, At, B0); PG8_MMA(0, 1, At, B1); PG8_BAR; PG8_SCHED;
            PG8_LDA(At, 1, 1); PG8_STAGE(PG8_SB(1, 0), b3, voffB); PG8_STAGE(PG8_SB(1, 1), b3 + hstepB, voffB); PG8_STAGE(PG8_SA(1, 0), a3, voffA);
            PG8_WAIT_V(8); PG8_WAIT_L(0); PG8_BAR; PG8_MMA(1, 0, At, B0); PG8_MMA(1, 1, At, B1); PG8_BAR; PG8_SCHED;
            } else {
            PG8_LDB(B0, 0, 0); PG8_SCHED; PG8_LDA(At, 0, 0); PG8_STAGE(PG8_SA(1, 1), a1 + hstepA, voffA);
            PG8_WAIT_L(8); PG8_BAR; PG8_WAIT_L(0); PG8_MMA(0, 0, At, B0); PG8_BAR; PG8_SCHED;
            PG8_LDB(B1, 0, 1); PG8_STAGE(PG8_SB(0, 0), b2, voffB);
            PG8_BAR; PG8_WAIT_L(0); PG8_MMA(0, 1, At, B1); PG8_BAR;
            PG8_LDA(At, 0, 1); PG8_STAGE(PG8_SA(0, 0), a2, voffA);
            PG8_BAR; PG8_WAIT_L(0); PG8_MMA(1, 0, At, B0); PG8_BAR; PG8_SCHED;
            PG8_STAGE(PG8_SB(0, 1), b2 + hstepB, voffB);
            PG8_WAIT_V(6); PG8_BAR; PG8_MMA(1, 1, At, B1); PG8_BAR;
            PG8_LDB(B0, 1, 0); PG8_SCHED; PG8_LDA(At, 1, 0); PG8_STAGE(PG8_SA(0, 1), a2 + hstepA, voffA);
            PG8_WAIT_L(8); PG8_BAR; PG8_WAIT_L(0); PG8_MMA(0, 0, At, B0); PG8_BAR; PG8_SCHED;
            PG8_LDB(B1, 1, 1); PG8_STAGE(PG8_SB(1, 0), b3, voffB);
            PG8_BAR; PG8_WAIT_L(0); PG8_MMA(0, 1, At, B1); PG8_BAR;
            PG8_LDA(At, 1, 1); PG8_STAGE(PG8_SA(1, 0), a3, voffA);
            PG8_BAR; PG8_WAIT_L(0); PG8_MMA(1, 0, At, B0); PG8_BAR; PG8_SCHED;
            PG8_STAGE(PG8_SB(1, 1), b3 + hstepB, voffB);
            PG8_WAIT_V(6); PG8_BAR; PG8_MMA(1, 1, At, B1); PG8_BAR;
            }
        }
        if constexpr (ALIGN_EPI) { if (wr == 0) PG8_BAR; }
        if constexpr (!Epi::AFTER_DRAIN) { E(acc, cur, wr, wc, fr, fq); S.done(cur); }
        if (!has_next) break;
#pragma unroll
        for (int a = 0; a < 2; ++a)
#pragma unroll
            for (int b = 0; b < 2; ++b)
#pragma unroll
                for (int m = 0; m < 4; ++m)
#pragma unroll
                    for (int n = 0; n < 2; ++n) acc[a][b][m][n] = (f32x4){0.f, 0.f, 0.f, 0.f};
        cur = nxt; cA = nA; cB = nB; ++ui;
        if constexpr (ALIGN_EPI) { if (wr == 1) PG8_BAR; }
    }
    PG8_WAIT_V(0);
    if constexpr (!ALIGN_EPI) { if (wr == 0) PG8_BAR; }
    PG8_BAR;
    if constexpr (Epi::AFTER_DRAIN) { E.fused(acc, cur, wr, wc, fr, fq, lds, wid, lane); S.done(cur); }
#undef PG8_SA
#undef PG8_SB
#undef PG8_STAGE
#undef PG8_LDA
#undef PG8_LDB
#undef PG8_MMA
#undef PG8_WAIT_V
#undef PG8_WAIT_L
#undef PG8_BAR
#undef PG8_SCHED
}
}

constexpr size_t MiB = 1u << 20;
constexpr size_t WS_CTL = 0, CTL_ZERO_BYTES = 64 * 1024;
constexpr size_t WS_WIN0 = 1 * MiB;
constexpr size_t WS_WIN1 = WS_WIN0 + (size_t)NP0 * DM * 2;
constexpr size_t WS_WMEM = 13 * MiB;
constexpr size_t WS_WOUT = 15 * MiB;
constexpr size_t WS_WUP = 19 * MiB;
constexpr size_t WS_WDN = 35 * MiB;
constexpr size_t WS_MEMKV = 51 * MiB;
constexpr size_t WS_LOGF = 59 * MiB;
constexpr size_t WS_CS = 61 * MiB;
constexpr size_t WS_XN = 64 * MiB;
constexpr size_t WS_R1 = 128 * MiB;
constexpr size_t WS_H = 256 * MiB;
constexpr size_t WS_PROJ = 256 * MiB;
constexpr size_t WS_MEMN = 464 * MiB;
constexpr size_t WS_END = 512 * MiB;
static_assert(WS_WIN1 + (size_t)NP1 * DM * 2 <= WS_WMEM && WS_PROJ + (size_t)MTOK * NP0 * 2 <= WS_MEMN, "d_ws map");
constexpr int CW_BAR = 4096;

constexpr int RING_OFF = 0, RING_BYTES = 131072;
constexpr int LDSCTL_OFF = RING_BYTES, MISC_OFF = LDSCTL_OFF + 320;
constexpr int LDS_BYTES = 147456;
constexpr int NWAVES = 8;

#define GAS __attribute__((address_space(1)))
#define LAS __attribute__((address_space(3)))
typedef unsigned short bf16;
typedef unsigned v4u __attribute__((ext_vector_type(4)));
typedef float f32x4 __attribute__((ext_vector_type(4)));
typedef GAS unsigned gu32;
#define LDS_WAIT() asm volatile("s_waitcnt lgkmcnt(0)" ::: "memory")
#define VM_WAIT() asm volatile("s_waitcnt vmcnt(0)" ::: "memory")
__device__ __forceinline__ unsigned f2bf(float f) { unsigned u = __builtin_bit_cast(unsigned, f); return (u + 0x7fffu + ((u >> 16) & 1u)) >> 16; }
__device__ __forceinline__ unsigned pk2(float lo, float hi) { return f2bf(lo) | (f2bf(hi) << 16); }
__device__ __forceinline__ float bflo(unsigned u) { return __builtin_bit_cast(float, u << 16); }
__device__ __forceinline__ float bfhi(unsigned u) { return __builtin_bit_cast(float, u & 0xffff0000u); }

namespace attn_body {
using bf16=__hip_bfloat16;
using bf16x8=__attribute__((ext_vector_type(8)))short;
using s16x4=__attribute__((ext_vector_type(4)))short;
using f32x16=__attribute__((ext_vector_type(16)))float;
using u32x4=__attribute__((ext_vector_type(4)))unsigned;
using f32x4v=__attribute__((ext_vector_type(4)))float;
constexpr int BATCH=16,NHEAD=12,SEQ=2048,D=64,DM=2816;
constexpr int NW=8,QBLK=32,QB=QBLK*NW,KVBLK=64,NQB=SEQ/QB;
constexpr int ATTN_PITCH=DM, ATTN_UNIT_ROWS=QB;
__device__ __forceinline__ int crow(int r,int hi){return (r&3)+8*(r>>2)+4*hi;}
#define SBAR() __builtin_amdgcn_sched_barrier(0)
__device__ __forceinline__ void cmask(f32x16&p0,f32x16&p1,int jb,int qrel,int hi){
  const float NEG=-INFINITY; int kb=64*jb+4*hi;
  #pragma unroll
  for(int r=0;r<16;++r){int kv=kb+(r&3)+8*(r>>2); if(kv>qrel)p0[r]=NEG; if(kv+32>qrel)p1[r]=NEG;}
}

constexpr int NSLOT=3, SLOTB=8192;
constexpr int LDS_K=0, LDS_V=NSLOT*SLOTB, LDS_WS=2*NSLOT*SLOTB, LDS_OST=LDS_WS+NW*64*4, LDS_BIAS=LDS_OST+NW*4096, LDS_BYTES=LDS_BIAS+SEQ*4;
constexpr float C2=0.125f*1.4426950408889634f;
__device__ __forceinline__ void glds16(const void*gsrc,unsigned lds_dst){unsigned keep;
  asm volatile("s_mov_b32 %0, m0\n\ts_mov_b32 m0, %2\n\ts_nop 0\n\tglobal_load_lds_dwordx4 %1, off\n\ts_mov_b32 m0, %0":"=&s"(keep):"v"(gsrc),"s"(lds_dst):"memory");}
__device__ __forceinline__ float max3f(float a,float b,float c){float r;asm("v_max3_f32 %0, %1, %2, %3":"=v"(r):"v"(a),"v"(b),"v"(c));return r;}
__device__ __forceinline__ float max2f(float a,float b){float r;asm("v_max_f32_e32 %0, %1, %2":"=v"(r):"v"(a),"v"(b));return r;}
__device__ __forceinline__ float fadd_s(float a,float b){float r;asm("v_add_f32_e32 %0, %1, %2":"=v"(r):"v"(a),"v"(b));return r;}
__device__ __forceinline__ float fsub_s(float a,float b){float r;asm("v_sub_f32_e32 %0, %1, %2":"=v"(r):"v"(a),"v"(b));return r;}
typedef float f32x2_t __attribute__((ext_vector_type(2))); typedef __bf16 bf16x2_t __attribute__((ext_vector_type(2)));
__device__ __forceinline__ unsigned cvtpk_s(float lo,float hi){f32x2_t v={lo,hi};bf16x2_t b=__builtin_convertvector(v,bf16x2_t);return __builtin_bit_cast(unsigned,b);}
#define WAIT_BAR(N) asm volatile("s_waitcnt vmcnt(" #N ") lgkmcnt(0)\n\ts_barrier":::"memory")

__device__ __forceinline__ void qkt(f32x16&p0,f32x16&p1,const char*Kslot,const bf16x8*qr,const f32x16&c0i,const f32x16&c1i,int r32,int hi){
  const char*kb=Kslot+hi*1024+r32*16;
  #pragma unroll
  for(int d0=0;d0<4;++d0){
    const bf16x8 b0=*reinterpret_cast<const bf16x8*>(kb+d0*2048);
    const bf16x8 b1=*reinterpret_cast<const bf16x8*>(kb+d0*2048+512);
    if(d0==0){p0=__builtin_amdgcn_mfma_f32_32x32x16_bf16(b0,qr[0],c0i,0,0,0);p1=__builtin_amdgcn_mfma_f32_32x32x16_bf16(b1,qr[0],c1i,0,0,0);}
    else{p0=__builtin_amdgcn_mfma_f32_32x32x16_bf16(b0,qr[d0],p0,0,0,0);p1=__builtin_amdgcn_mfma_f32_32x32x16_bf16(b1,qr[d0],p1,0,0,0);}}
}
typedef __attribute__((address_space(3))) const char* lds_cptr;
typedef short v4i16_t __attribute__((ext_vector_type(4)));
__device__ __forceinline__ void kload8(bf16x8*kf,lds_cptr kp){
  kf[0]=*(const __attribute__((address_space(3))) bf16x8*)(kp);      kf[1]=*(const __attribute__((address_space(3))) bf16x8*)(kp+512);
  kf[2]=*(const __attribute__((address_space(3))) bf16x8*)(kp+2048); kf[3]=*(const __attribute__((address_space(3))) bf16x8*)(kp+2560);
  kf[4]=*(const __attribute__((address_space(3))) bf16x8*)(kp+4096); kf[5]=*(const __attribute__((address_space(3))) bf16x8*)(kp+4608);
  kf[6]=*(const __attribute__((address_space(3))) bf16x8*)(kp+6144); kf[7]=*(const __attribute__((address_space(3))) bf16x8*)(kp+6656);
}
__device__ __forceinline__ void kload2(bf16x8*kf,lds_cptr kp,int j){ kf[2*j]=*(const __attribute__((address_space(3))) bf16x8*)(kp+j*2048); kf[2*j+1]=*(const __attribute__((address_space(3))) bf16x8*)(kp+j*2048+512); }
__device__ __forceinline__ s16x4 vtr(lds_cptr p){ return __builtin_bit_cast(s16x4,__builtin_amdgcn_ds_read_tr16_b64_v4i16((__attribute__((address_space(3))) v4i16_t*)p)); }
__device__ __forceinline__ float rowmax(const f32x16&p0,const f32x16&p1){
  float a=max3f(p0[0],p0[1],p1[0]),b=max3f(p0[2],p0[3],p1[1]);a=max3f(a,p1[2],p1[3]);
  #pragma unroll
  for(int r=4;r<16;r+=4){a=max3f(a,p0[r],p0[r+1]);b=max3f(b,p0[r+2],p0[r+3]);a=max3f(a,p1[r],p1[r+1]);b=max3f(b,p1[r+2],p1[r+3]);}
  const float m=max2f(a,b);
  auto rr=__builtin_amdgcn_permlane32_swap(__float_as_uint(m),__float_as_uint(m),false,false);
  return max2f(__uint_as_float(rr[0]),__uint_as_float(rr[1]));
}
__device__ __forceinline__ void pv(f32x16*o,int vb,bf16x8 pa0,bf16x8 pa1,bf16x8 pa2,bf16x8 pa3){
  #pragma unroll
  for(int d0=0;d0<2;++d0){s16x4 lo[4],hi[4];
    #pragma unroll
    for(int ks=0;ks<4;++ks){
      asm volatile("ds_read_b64_tr_b16 %0,%1 offset:%c2":"=&v"(lo[ks]):"v"(vb),"i"(d0*4096+ks*1024):"memory");
      asm volatile("ds_read_b64_tr_b16 %0,%1 offset:%c2":"=&v"(hi[ks]):"v"(vb),"i"(d0*4096+ks*1024+512):"memory");}
    asm volatile("s_waitcnt lgkmcnt(0)":::"memory");SBAR();
    #define PK(k) (bf16x8){lo[k][0],lo[k][1],lo[k][2],lo[k][3],hi[k][0],hi[k][1],hi[k][2],hi[k][3]}
    o[d0]=__builtin_amdgcn_mfma_f32_32x32x16_bf16(pa0,PK(0),o[d0],0,0,0);
    o[d0]=__builtin_amdgcn_mfma_f32_32x32x16_bf16(pa1,PK(1),o[d0],0,0,0);
    o[d0]=__builtin_amdgcn_mfma_f32_32x32x16_bf16(pa2,PK(2),o[d0],0,0,0);
    o[d0]=__builtin_amdgcn_mfma_f32_32x32x16_bf16(pa3,PK(3),o[d0],0,0,0);
    #undef PK
  }
}

#ifndef ATTN_STORE16
#define ATTN_STORE16(p,v) (*(u32x4*)(p)=(v))
#endif
template<int THRL> __device__ __forceinline__ void attn_unit(int b,int h,int qb,const bf16*Q,const bf16*__restrict__ K,const bf16*__restrict__ V,bf16*O,const float*cs,char*shm){
  const int tid=threadIdx.x,lane=tid&63,r32=lane&31,hi=lane>>5; const int wid=__builtin_amdgcn_readfirstlane(tid>>6);
  const long rowbase=(long)b*SEQ; const int q0=qb*QB;
  const bf16*Qw=Q+(rowbase+q0+wid*QBLK)*DM+h*D;
  const bf16*Kh=K+rowbase*DM+h*D,*Vh=V+rowbase*DM+h*D;
  const unsigned lds0=(unsigned)(uintptr_t)shm;
  float*wsf=(float*)(shm+LDS_WS)+wid*64;
  const bf16*ksrc=Kh+(long)lane*DM+wid*8;
  const bf16*vsrc=Vh+(long)(16*(wid&3)+(lane>>2))*DM+(wid>>2)*32+(lane&3)*8;
  const unsigned kdst=lds0+LDS_K+wid*1024, vdst=lds0+LDS_V+wid*1024;
  #define DMA_K(t,slot) glds16(ksrc+(long)(t)*KVBLK*DM,(unsigned)__builtin_amdgcn_readfirstlane(kdst+(slot)))
  #define DMA_V(t,slot) glds16(vsrc+(long)(t)*KVBLK*DM,(unsigned)__builtin_amdgcn_readfirstlane(vdst+(slot)))
  const int vb0=(int)(lds0+LDS_V)+((lane>>4)&1)*32+(lane&3)*8+(4*hi+((lane&15)>>2))*64;
  const char*Kbase=shm+LDS_K; bf16x8 kf[8];
  const lds_cptr shm3=(lds_cptr)shm; const lds_cptr kp0=shm3+LDS_K+hi*1024+r32*16; const lds_cptr vp0=shm3+LDS_V+((lane>>4)&1)*32+(lane&3)*8+(4*hi+((lane&15)>>2))*64;
  const int NT=(q0+QB)/KVBLK;
  typedef __attribute__((address_space(3))) float lds_f32; typedef __attribute__((address_space(3))) const f32x4v lds_cf4;
  lds_f32*biasw=(lds_f32*)(shm3+LDS_BIAS);
  { int tb_=tid; asm volatile("":"+v"(tb_));
    _Pragma("clang loop vectorize(disable) unroll(disable)") for(int i=tb_;i<q0+QB;i+=NW*64)biasw[i]=-cs[i]; }
  const lds_cf4*biasr=(const lds_cf4*)(shm3+LDS_BIAS)+hi;
  #define BINIT(C0,C1,t,mh) do{ _Pragma("unroll") for(int g_=0;g_<4;++g_){ const f32x4v b0_=biasr[16*(t)+2*g_], b1_=biasr[16*(t)+8+2*g_]; \
      C0[4*g_]=b0_[0]-(mh);C0[4*g_+1]=b0_[1]-(mh);C0[4*g_+2]=b0_[2]-(mh);C0[4*g_+3]=b0_[3]-(mh); C1[4*g_]=b1_[0]-(mh);C1[4*g_+1]=b1_[1]-(mh);C1[4*g_+2]=b1_[2]-(mh);C1[4*g_+3]=b1_[3]-(mh);} }while(0)
  DMA_K(0,0);DMA_V(0,0);DMA_K(1,SLOTB);
  bf16x8 qr[4];
  #pragma unroll
  for(int d0=0;d0<4;++d0)qr[d0]=*reinterpret_cast<const bf16x8*>(&Qw[(long)r32*DM+d0*16+hi*8]);
  float mhat=0.f,l_reg=0.f;f32x16 o[2];o[0]=f32x16{};o[1]=f32x16{};
  const int qrel=wid*QBLK+r32;
  #define CMASK(P0,P1,t) do{int jb_=(t)-(NT-4); if(jb_>=0)cmask(P0,P1,jb_,qrel,hi);}while(0)
  bool resc=false;
  #define START(P0,P1) do{ const float rm=rowmax(P0,P1); resc=false; \
    { const float dl=rm; mhat=fadd_s(mhat,dl); \
      _Pragma("unroll") for(int r=0;r<16;++r){P0[r]=fsub_s(P0[r],dl);P1[r]=fsub_s(P1[r],dl);} \
      } \
    _Pragma("unroll") for(int r=0;r<16;++r)P0[r]=__builtin_amdgcn_exp2f(P0[r]); }while(0)
  #define RESC() do{ if(resc){ asm volatile("s_waitcnt lgkmcnt(0)":::"memory"); \
      _Pragma("unroll") for(int d_=0;d_<2;++d_) _Pragma("unroll") for(int r=0;r<16;++r)o[d_][r]*=wsf[crow(r,hi)]; } }while(0)
  f32x16 pA0,pA1,pB0,pB1;
  int sl_prev=0,sl_cur=0,sl_next=SLOTB;
  #define ROT() do{sl_prev=sl_cur;sl_cur=sl_next;sl_next=(sl_next==(NSLOT-1)*SLOTB)?0:sl_next+SLOTB;}while(0)
  DMA_K(2,2*SLOTB);
  WAIT_BAR(3);
  BINIT(pA0,pA1,0,0.f);
  qkt(pA0,pA1,Kbase,qr,pA0,pA1,r32,hi);asm volatile("s_nop 15\n\ts_nop 7":"+v"(pA0),"+v"(pA1));CMASK(pA0,pA1,0);
  START(pA0,pA1);
  _Pragma("unroll") for(int r=0;r<16;++r)pA1[r]=__builtin_amdgcn_exp2f(pA1[r]);
  WAIT_BAR(0);
  DMA_K(3,0);DMA_V(1,SLOTB);
  ROT();
  kload8(kf,kp0+sl_cur);
  WAIT_BAR(2);
  s16x4 vlo[8],vhi[8]; u32x4 pw0,pw1,pw2,pw3;
  #define PKW(P,B) cvtpk_s(P[B],P[B+1])
  #define PAF(k) __builtin_bit_cast(bf16x8,pw##k)
  #define VFR(i) (bf16x8){vlo[i][0],vlo[i][1],vlo[i][2],vlo[i][3],vhi[i][0],vhi[i][1],vhi[i][2],vhi[i][3]}
  #define PIN(x) asm volatile("":"+v"(x))
  #define MX3(a,b,c) __builtin_fmaxf(__builtin_fmaxf((a),(b)),(c))
  #define GAPA(MF,A0,A1,A2,A3,W0,W1,PW) do{ MF; sacc+=A0; sacc+=A1; sacc+=A2; sacc+=A3; PIN(sacc); W0; W1; PIN(PW); SBAR(); }while(0)
  #define EX(v) __builtin_amdgcn_exp2f(v)
  #define GAPB(MF,X,B) do{ MF; X[B]=EX(X[B]); X[B+1]=EX(X[B+1]); X[B+2]=EX(X[B+2]); X[B+3]=EX(X[B+3]); PIN(X); SBAR(); }while(0)
  #define VRD(i) do{ vlo[i]=vtr(vp_+(((i)>>2)*4096+((i)&3)*1024)); vhi[i]=vtr(vp_+(((i)>>2)*4096+((i)&3)*1024+512)); }while(0)
  #define KRD(G,j) do{ if(G){ kload2(kf,kp0+sl_next,j); SBAR(); } }while(0)
  #define STEP(C0,C1,P0,P1,t,GK,GV,GL) do{ SBAR(); \
    BINIT(C0,C1,t,mhat); SBAR(); \
    const lds_cptr vp_=vp0+sl_prev; \
    VRD(0); SBAR(); float sacc=(P0[0]+P0[1]); \
    GAPA(C0=__builtin_amdgcn_mfma_f32_32x32x16_bf16(kf[0],qr[0],C0,0,0,0), P0[2],P0[3],P0[4],P0[5],     pw0[0]=PKW(P0,0), pw0[1]=PKW(P0,2), pw0); \
    VRD(4); SBAR(); GAPA(C1=__builtin_amdgcn_mfma_f32_32x32x16_bf16(kf[1],qr[0],C1,0,0,0), P0[6],P0[7],P0[8],P0[9],     pw0[2]=PKW(P0,4), pw0[3]=PKW(P0,6), pw0); \
    VRD(1); SBAR(); GAPA(C0=__builtin_amdgcn_mfma_f32_32x32x16_bf16(kf[2],qr[1],C0,0,0,0),   P0[10],P0[11],P0[12],P0[13], pw1[0]=PKW(P0,8), pw1[1]=PKW(P0,10), pw1); \
    VRD(5); SBAR(); GAPA(C1=__builtin_amdgcn_mfma_f32_32x32x16_bf16(kf[3],qr[1],C1,0,0,0),   P0[14],P0[15],P1[0],P1[1],   pw1[2]=PKW(P0,12),pw1[3]=PKW(P0,14), pw1); \
    VRD(2); SBAR(); GAPA(C0=__builtin_amdgcn_mfma_f32_32x32x16_bf16(kf[4],qr[2],C0,0,0,0),   P1[2],P1[3],P1[4],P1[5],     pw2[0]=PKW(P1,0), pw2[1]=PKW(P1,2), pw2); \
    VRD(6); SBAR(); GAPA(C1=__builtin_amdgcn_mfma_f32_32x32x16_bf16(kf[5],qr[2],C1,0,0,0),   P1[6],P1[7],P1[8],P1[9],     pw2[2]=PKW(P1,4), pw2[3]=PKW(P1,6), pw2); \
    VRD(3); SBAR(); GAPA(C0=__builtin_amdgcn_mfma_f32_32x32x16_bf16(kf[6],qr[3],C0,0,0,0),   P1[10],P1[11],P1[12],P1[13], pw3[0]=PKW(P1,8), pw3[1]=PKW(P1,10), pw3); \
    VRD(7); SBAR(); GAPA(C1=__builtin_amdgcn_mfma_f32_32x32x16_bf16(kf[7],qr[3],C1,0,0,0),   P1[14],P1[15],0.f,0.f,       pw3[2]=PKW(P1,12),pw3[3]=PKW(P1,14), pw3); \
    l_reg+=sacc; \
    if(GK){DMA_K((t)+3,sl_cur);} if(GV){DMA_V((t)+1,sl_next);} \
    CMASK(C0,C1,t); \
    { float a=MX3(C0[0],C0[1],C1[0]),b=MX3(C0[2],C0[3],C1[1]); a=MX3(a,C1[2],C1[3]); \
      _Pragma("unroll") for(int r=4;r<16;r+=4){a=MX3(a,C0[r],C0[r+1]);b=MX3(b,C0[r+2],C0[r+3]);a=MX3(a,C1[r],C1[r+1]);b=MX3(b,C1[r+2],C1[r+3]);} \
      float rm=__builtin_fmaxf(a,b); { auto rr=__builtin_amdgcn_permlane32_swap(__float_as_uint(rm),__float_as_uint(rm),false,false); rm=__builtin_fmaxf(__uint_as_float(rr[0]),__uint_as_float(rr[1])); } \
      resc=false; \
      if(__builtin_expect(__any(rm>(float)THRL),0)){ const float dl=__builtin_fmaxf(rm,0.f); mhat+=dl; \
        _Pragma("unroll") for(int r=0;r<16;++r){C0[r]-=dl;C1[r]-=dl;} \
        const float f=__builtin_amdgcn_exp2f(-dl); l_reg*=f; if(hi==0)wsf[r32]=f; resc=true; } } \
    SBAR(); \
    GAPB(o[0]=__builtin_amdgcn_mfma_f32_32x32x16_bf16(PAF(0),VFR(0),o[0],0,0,0), C0,0); \
    GAPB(o[1]=__builtin_amdgcn_mfma_f32_32x32x16_bf16(PAF(0),VFR(4),o[1],0,0,0), C0,4); \
    KRD(GL,0); GAPB(o[0]=__builtin_amdgcn_mfma_f32_32x32x16_bf16(PAF(1),VFR(1),o[0],0,0,0), C0,8); \
    KRD(GL,1); GAPB(o[1]=__builtin_amdgcn_mfma_f32_32x32x16_bf16(PAF(1),VFR(5),o[1],0,0,0), C0,12); \
    KRD(GL,2); GAPB(o[0]=__builtin_amdgcn_mfma_f32_32x32x16_bf16(PAF(2),VFR(2),o[0],0,0,0), C1,0); \
    KRD(GL,3); GAPB(o[1]=__builtin_amdgcn_mfma_f32_32x32x16_bf16(PAF(2),VFR(6),o[1],0,0,0), C1,4); \
    GAPB(o[0]=__builtin_amdgcn_mfma_f32_32x32x16_bf16(PAF(3),VFR(3),o[0],0,0,0), C1,8); \
    GAPB(o[1]=__builtin_amdgcn_mfma_f32_32x32x16_bf16(PAF(3),VFR(7),o[1],0,0,0), C1,12); \
    }while(0)
  int t=1;
  #undef CMASK
  #define CMASK(P0,P1,t) do{}while(0)
  for(;t+5<NT;t+=2){
    STEP(pB0,pB1,pA0,pA1,t,true,true,true);     WAIT_BAR(2); RESC(); ROT();
    STEP(pA0,pA1,pB0,pB1,t+1,true,true,true);   WAIT_BAR(2); RESC(); ROT();
  }
  #undef CMASK
  #define CMASK(P0,P1,t) do{int jb_=(t)-(NT-4); if(jb_>=0)cmask(P0,P1,jb_,qrel,hi);}while(0)
  #define ENDW(tt) do{ if((tt)+3<NT){WAIT_BAR(2);} else if((tt)+2<NT){WAIT_BAR(1);} else {WAIT_BAR(0);} }while(0)
  for(;t+1<NT;t+=2){
    STEP(pB0,pB1,pA0,pA1,t,(t+3<NT),(t+1<NT),(t+1<NT));       ENDW(t);   RESC(); ROT();
    STEP(pA0,pA1,pB0,pB1,t+1,(t+4<NT),(t+2<NT),(t+2<NT));     ENDW(t+1); RESC(); ROT();
  }
  STEP(pB0,pB1,pA0,pA1,NT-1,false,false,false); RESC();
  { float sacc=pB0[0]+pB0[1]; _Pragma("unroll") for(int r=2;r<16;++r)sacc+=pB0[r]; _Pragma("unroll") for(int r=0;r<16;++r)sacc+=pB1[r]; l_reg+=sacc;
    pw0=(u32x4){PKW(pB0,0),PKW(pB0,2),PKW(pB0,4),PKW(pB0,6)};pw1=(u32x4){PKW(pB0,8),PKW(pB0,10),PKW(pB0,12),PKW(pB0,14)};pw2=(u32x4){PKW(pB1,0),PKW(pB1,2),PKW(pB1,4),PKW(pB1,6)};pw3=(u32x4){PKW(pB1,8),PKW(pB1,10),PKW(pB1,12),PKW(pB1,14)};
    SBAR(); pv(o,vb0+sl_cur,PAF(0),PAF(1),PAF(2),PAF(3)); }
  #undef PKW
  #undef PAF
  #undef VFR
  #undef PIN
  #undef MX3
  #undef GAPA
  #undef GAPB
  #undef EX
  #undef VRD
  #undef KRD
  #undef STEP
  #undef ENDW
  {auto rr=__builtin_amdgcn_permlane32_swap(__float_as_uint(l_reg),__float_as_uint(l_reg),false,false);l_reg=__uint_as_float(rr[0])+__uint_as_float(rr[1]);}
  if(hi==0)wsf[32+r32]=l_reg;asm volatile("s_waitcnt lgkmcnt(0)":::"memory");
  float rli[16];
  #pragma unroll
  for(int r=0;r<16;++r)rli[r]=__builtin_amdgcn_rcpf(wsf[32+crow(r,hi)]);
  bf16*Ow=O+(rowbase+q0+wid*QBLK)*DM+h*D;
  { bf16*stg=(bf16*)(shm+LDS_OST)+wid*2048;
    #pragma unroll
    for(int r=0;r<16;++r){const int orow=crow(r,hi);
      #pragma unroll
      for(int d0=0;d0<2;++d0)stg[orow*64+d0*32+r32]=__float2bfloat16(o[d0][r]*rli[r]);}
    asm volatile("s_waitcnt lgkmcnt(0)":::"memory");
    #pragma unroll
    for(int i=0;i<4;++i){const int row=i*8+(lane>>3),ch=lane&7; const u32x4 v=*(const u32x4*)(stg+row*64+ch*8); ATTN_STORE16(Ow+(long)row*DM+ch*8,v);} }
  asm volatile("s_waitcnt lgkmcnt(0)\n\ts_barrier":::"memory");
  #undef BINIT
  #undef DMA_K
  #undef DMA_V
  #undef CMASK
  #undef START
  #undef RESC
  #undef ROT
}
constexpr int ATTN_LDS_BYTES=LDS_BYTES;
struct AttnTensors { const bf16* Q; const bf16* K; const bf16* V; bf16* O; const float* CS; };
struct AttnUnit { int bh; int qb; };
struct StaticOrder {
  int vcu;
  __device__ __forceinline__ explicit StaticOrder(int grid,int block):vcu((block%8)*(grid/8)+block/8){}
  __device__ __forceinline__ bool next(int i,AttnUnit&u)const{ if(i>=6)return false; const int p=vcu*3+(i>>1); u.bh=p>>2; const int x=p&3; u.qb=(i&1)?7-x:x; return true; }
  __device__ __forceinline__ void a_ready(const AttnUnit&)const{}
  __device__ __forceinline__ void done(const AttnUnit&)const{}
};
template<class Sched,int THRL=8> __device__ __forceinline__ void attn_phase(char*lds,const AttnTensors&T,const Sched&S){
  AttnUnit u;
  for(int i=0;S.next(i,u);++i){ S.a_ready(u); attn_unit<THRL>(u.bh/NHEAD,u.bh%NHEAD,u.qb,T.Q,T.K,T.V,T.O,T.CS+(long)u.bh*SEQ,lds); S.done(u); }
}
#undef SBAR
#undef WAIT_BAR
}
#define XB_TMO      128
#define XB_XCNT(j)  (256  + 64 * (j))
#define XB_XSUB(j)  (1280 + 64 * (j))
#define XB_XGEN(j)  (2304 + 64 * (j))
#define XB_TOP      3328
#define XB_TOPGEN   3392
#define XCD_BAR_WORDS 3456
#define XB_SPIN_CAP (1u << 18)

__device__ __forceinline__ unsigned xb_ld(unsigned* p)              { return __hip_atomic_load(p, __ATOMIC_RELAXED, __HIP_MEMORY_SCOPE_AGENT); }
__device__ __forceinline__ unsigned xb_add(unsigned* p, unsigned v) { return __hip_atomic_fetch_add(p, v, __ATOMIC_RELAXED, __HIP_MEMORY_SCOPE_AGENT); }
__device__ __forceinline__ unsigned xb_xcc_id() { return (unsigned)__builtin_amdgcn_s_getreg((3 << 11) | 20) & 0xFu; }
#define XB_SPIN(cond, bar) do { unsigned _sp = 0; while (cond) { __builtin_amdgcn_s_sleep(1); \
    if ((++_sp & 255u) == 0u) { if (xb_ld(&(bar)[XB_TMO])) break; if (_sp > XB_SPIN_CAP) { atomicAdd(&(bar)[XB_TMO], 1u); break; } } } } while (0)

struct XcdBarrier {
    unsigned* bar; unsigned x;
    volatile LAS unsigned* st;
};

__device__ __forceinline__ XcdBarrier xcd_barrier_post(unsigned* bar, volatile LAS unsigned* st) {
    XcdBarrier b; b.bar = bar; b.x = xb_xcc_id(); b.st = st;
    if (threadIdx.x == 0) (void)xb_add(&bar[XB_XCNT(b.x)], 1u);
    return b;
}
__device__ __forceinline__ void xcd_barrier_complete(unsigned* bar, unsigned x, unsigned& nloc, unsigned& nx) {
    const unsigned G = gridDim.x * gridDim.y * gridDim.z;
    unsigned sum, cnt, mine, sp = 0u;
    for (;;) {
        sum = 0u; cnt = 0u; mine = 0u;
#pragma unroll
        for (unsigned j = 0; j < 16; ++j) { const unsigned c = xb_ld(&bar[XB_XCNT(j)]); sum += c; cnt += (c > 0u) ? 1u : 0u; mine = (j == x) ? c : mine; }
        if (sum == G) break;
        __builtin_amdgcn_s_sleep(1);
        if ((++sp & 255u) == 0u) { if (xb_ld(&bar[XB_TMO])) break; if (sp > XB_SPIN_CAP) { atomicAdd(&bar[XB_TMO], 1u); break; } }
    }
    nloc = mine > 0u ? mine : 1u; nx = cnt > 0u ? cnt : 1u;
}

__device__ __forceinline__ void xcd_barrier(const XcdBarrier& b) {
    asm volatile("s_waitcnt vmcnt(0)" ::: "memory");
    __syncthreads();
    if (threadIdx.x == 0) {
        unsigned* bar = b.bar;
        __builtin_amdgcn_s_waitcnt(0);
        unsigned nloc = b.st[0], nx = b.st[1];
        if (nloc == 0u) { xcd_barrier_complete(bar, b.x, nloc, nx); b.st[0] = nloc; b.st[1] = nx; }
        const unsigned old = xb_add(&bar[XB_XSUB(b.x)], 1u);
        const unsigned gen = old / nloc;
        if (old + 1u == (gen + 1u) * nloc) {
            __builtin_amdgcn_fence(__ATOMIC_RELEASE, "agent");
            asm volatile("s_waitcnt vmcnt(0)" ::: "memory");
            const unsigned og = xb_add(&bar[XB_TOP], 1u);
            const unsigned tg = og / nx;
            if (og + 1u == (tg + 1u) * nx) xb_add(&bar[XB_TOPGEN], 1u);
            else XB_SPIN(xb_ld(&bar[XB_TOPGEN]) == tg, bar);
            __builtin_amdgcn_fence(__ATOMIC_ACQUIRE, "agent");
            xb_add(&bar[XB_XGEN(b.x)], 1u);
            asm volatile("s_waitcnt vmcnt(0)" ::: "memory");
        } else {
            XB_SPIN(xb_ld(&bar[XB_XGEN(b.x)]) == gen, bar);
            __builtin_amdgcn_fence(__ATOMIC_ACQUIRE, "agent");
            asm volatile("s_waitcnt vmcnt(0)" ::: "memory");
        }
    }
    __syncthreads();
}

struct Args { const float* in[15]; float* out; unsigned char* ws; int ph_lo, ph_hi; };
typedef const __attribute__((address_space(4))) Args* KArgs;
#define KA_GET() ({ KArgs k_ = (KArgs)__builtin_amdgcn_kernarg_segment_ptr(); asm volatile("" : "+s"(k_)); k_; })
#define WSP(T, off) ((T*)(ka->ws + (off)))
struct Frame {
    LAS unsigned char* lds;
    int tid, lane, wave, gw;
    int G;
};
__device__ __forceinline__ float wave_sum(float v) {
#pragma unroll
    for (int o = 1; o < 64; o <<= 1) v += __shfl_xor(v, o);
    return v;
}

__device__ __forceinline__ int dst_row(int mode, int n) {
    if (mode == 0) return n;
    if (mode == 1) {
        if (n < 768) { const int h = n >> 7, d = n & 127; return C_Q + h * 128 + ((d & 63) << 1) + (d >> 6); }
        if (n < 1536) { const int m = n - 768, h = m >> 7, d = m & 127; return C_K + h * 128 + ((d & 63) << 1) + (d >> 6); }
        if (n < 2304) return C_V + (n - 1536);
        if (n < 3072) return C_G + (n - 2304);
        return C_MQ + (n - 3072);
    }
    if (n < 768) return C_Q + n;
    if (n < 1536) return C_K + (n - 768);
    if (n < 2304) return C_V + (n - 1536);
    if (n < 2316) return C_G + (n - 2304);
    return C_MQ + (n - 2316);
}
__device__ __forceinline__ void p0_transpose_item(const float* W, int K, int N, bf16* WT, int mode, int row_off, const float* gain, LAS float* scr, int item, int lane) {
    const int nblk = (N + 31) / 32, kb = item / nblk, nb = item % nblk, k0 = 64 * kb, n0 = 32 * nb;
    const int nn = n0 + (lane & 31);
#pragma unroll 8
    for (int i = 0; i < 32; ++i) { const int kk = 2 * i + (lane >> 5);
        float v = 0.f; if (nn < N) { v = W[(size_t)(k0 + kk) * N + nn]; if (gain) v *= gain[k0 + kk]; }
        scr[kk * 33 + (lane & 31)] = v; }
    LDS_WAIT(); asm volatile("" ::: "memory");
    const int c = lane & 7;
#pragma unroll
    for (int j = 0; j < 4; ++j) { const int nl = (lane >> 3) + 8 * j; const int n = n0 + nl;
        if (n < N) { const LAS float* s = scr + (8 * c) * 33 + nl;
            v4u o; o.x = pk2(s[0 * 33], s[1 * 33]); o.y = pk2(s[2 * 33], s[3 * 33]); o.z = pk2(s[4 * 33], s[5 * 33]); o.w = pk2(s[6 * 33], s[7 * 33]);
            *(GAS v4u*)(WT + (size_t)(row_off + dst_row(mode, n)) * K + k0 + 8 * c) = o; } }
    LDS_WAIT(); asm volatile("" ::: "memory");
}
__device__ __forceinline__ void rms_row_to_bf16(const float* xrow, bf16* orow, int lane) {
    const GAS f32x4* xr = (const GAS f32x4*)xrow + lane;
    f32x4 v[4]; float s = 0.f;
#pragma unroll
    for (int j = 0; j < 4; ++j) { v[j] = xr[64 * j]; s += (v[j].x * v[j].x + v[j].y * v[j].y) + (v[j].z * v[j].z + v[j].w * v[j].w); }
    const float rstd = 1.0f / sqrtf(wave_sum(s) * (1.f / DM) + EPS);
    GAS unsigned long long* o8 = (GAS unsigned long long*)orow + lane;
#pragma unroll
    for (int j = 0; j < 4; ++j) o8[64 * j] = (unsigned long long)pk2(v[j].x * rstd, v[j].y * rstd) | ((unsigned long long)pk2(v[j].z * rstd, v[j].w * rstd) << 32);
}
__device__ __forceinline__ void p0_prologue(Frame& F, KArgs ka) {
    const float *w_in_ret = ka->in[3], *w_in_fox = ka->in[4], *w_mem_kv = ka->in[6], *w_out = ka->in[7], *w_up = ka->in[8], *w_down = ka->in[9];
    const float *g_pre_mix = ka->in[10], *g_pre_mlp = ka->in[12], *g_mem = ka->in[14];
    bf16 *Win0 = WSP(bf16, WS_WIN0), *Win1 = WSP(bf16, WS_WIN1), *Wmem = WSP(bf16, WS_WMEM), *Wout = WSP(bf16, WS_WOUT), *Wup = WSP(bf16, WS_WUP), *Wdn = WSP(bf16, WS_WDN);
    LAS float* scr = (LAS float*)(F.lds + RING_OFF + F.wave * 16384);
    const int gw = F.gw, NGW = F.G * NWAVES;
    constexpr int KB = DM / 64;
    constexpr int I_IN0 = KB * (3328 / 32), I_IN1 = KB * ((2572 + 31) / 32), I_MEM = KB * (512 / 32), I_OUT = KB * (DM / 32), I_UP = KB * (FF / 32), I_DN = (FF / 64) * (DM / 32);
    constexpr int NITEMS = I_IN0 + I_IN1 + 2 * I_MEM + 2 * I_OUT + 2 * I_UP + 2 * I_DN;
    for (int it = gw; it < NITEMS; it += NGW) {
        int r = it;
        if (r < I_IN0) { p0_transpose_item(w_in_ret, DM, 3328, Win0, 1, 0, g_pre_mix, scr, r, F.lane); continue; } r -= I_IN0;
        if (r < I_IN1) { p0_transpose_item(w_in_fox, DM, 2572, Win1, 2, 0, g_pre_mix + DM, scr, r, F.lane); continue; } r -= I_IN1;
        if (r < 2 * I_MEM) { const int l = r / I_MEM; p0_transpose_item(w_mem_kv + (size_t)l * DM * 512, DM, 512, Wmem, 0, l * 512, g_mem + l * DM, scr, r % I_MEM, F.lane); continue; } r -= 2 * I_MEM;
        if (r < 2 * I_OUT) { const int l = r / I_OUT; p0_transpose_item(w_out + (size_t)l * DM * DM, DM, DM, Wout + (size_t)l * DM * DM, 0, 0, nullptr, scr, r % I_OUT, F.lane); continue; } r -= 2 * I_OUT;
        if (r < 2 * I_UP) { const int l = r / I_UP; p0_transpose_item(w_up + (size_t)l * DM * FF, DM, FF, Wup + (size_t)l * DM * FF, 0, 0, g_pre_mlp + l * DM, scr, r % I_UP, F.lane); continue; } r -= 2 * I_UP;
        { const int l = r / I_DN; p0_transpose_item(w_down + (size_t)l * DM * FF, FF, DM, Wdn + (size_t)l * DM * FF, 0, 0, nullptr, scr, r % I_DN, F.lane); }
    }
    { GAS v4u* z = (GAS v4u*)(Win1 + (size_t)(C_G + 12) * DM); const int n16 = (NP1 - C_G - 12) * DM * 2 / 16;
      for (int i = gw * 64 + F.lane; i < n16; i += NGW * 64) z[i] = (v4u){0u, 0u, 0u, 0u}; }
    for (int m = gw; m < MTOK; m += NGW) rms_row_to_bf16(ka->in[0] + (size_t)m * DM, WSP(bf16, WS_XN) + (size_t)m * DM, F.lane);
    for (int m = gw; m < MMEM; m += NGW) rms_row_to_bf16(ka->in[1] + (size_t)m * DM, WSP(bf16, WS_MEMN) + (size_t)m * DM, F.lane);
}

__device__ __forceinline__ void row_pass(Frame& F, const float* y, const float* base, const float* gain, float* xo, bf16* xn) {
    const int NGW = F.G * NWAVES;
    f32x4 g[4];
#pragma unroll
    for (int j = 0; j < 4; ++j) g[j] = ((const GAS f32x4*)gain)[F.lane + 64 * j];
    for (int m = F.gw; m < MTOK; m += NGW) {
        const GAS f32x4* yr = (const GAS f32x4*)(y + (size_t)m * DM) + F.lane; const GAS f32x4* br = (const GAS f32x4*)(base + (size_t)m * DM) + F.lane;
        f32x4 v[4], b[4]; float s = 0.f;
#pragma unroll
        for (int j = 0; j < 4; ++j) { v[j] = yr[64 * j]; b[j] = br[64 * j]; s += (v[j].x * v[j].x + v[j].y * v[j].y) + (v[j].z * v[j].z + v[j].w * v[j].w); }
        const float rstd = 1.0f / sqrtf(wave_sum(s) * (1.f / DM) + EPS);
        float s2 = 0.f;
#pragma unroll
        for (int j = 0; j < 4; ++j) { v[j] = b[j] + v[j] * rstd * g[j]; s2 += (v[j].x * v[j].x + v[j].y * v[j].y) + (v[j].z * v[j].z + v[j].w * v[j].w); }
        GAS f32x4* o = (GAS f32x4*)(xo + (size_t)m * DM) + F.lane;
#pragma unroll
        for (int j = 0; j < 4; ++j) o[64 * j] = v[j];
        if (xn) {
            const float r2 = 1.0f / sqrtf(wave_sum(s2) * (1.f / DM) + EPS);
            GAS unsigned long long* o8 = (GAS unsigned long long*)(xn + (size_t)m * DM) + F.lane;
#pragma unroll
            for (int j = 0; j < 4; ++j) o8[64 * j] = (unsigned long long)pk2(v[j].x * r2, v[j].y * r2) | ((unsigned long long)pk2(v[j].z * r2, v[j].w * r2) << 32);
        }
    }
}

__device__ __forceinline__ void naive_retention(Frame& F, KArgs ka) {
    bf16* P = WSP(bf16, WS_PROJ); constexpr int ld = NP0;
    for (int j = 0; j < 6; ++j) {
        const int bh = (F.gw >> 7) + 16 * j, tb = ((F.gw & 127) + 37 * j) & 127;
        const int b = bh / 6, h = bh % 6, t = tb * 16 + (F.lane >> 2), dvq = F.lane & 3;
        const size_t row = (size_t)b * SEQ + t;
        v4u qp[16];
        { const GAS v4u* qs = (const GAS v4u*)(P + row * ld + C_Q + h * 128);
#pragma unroll
          for (int i = 0; i < 16; ++i) qp[i] = qs[i]; }
        float o[32];
#pragma unroll
        for (int i = 0; i < 32; ++i) o[i] = 0.f;
        const float lg = __log2f(1.f - exp2f(-5.f - (float)h));
        const int tmax = tb * 16 + 15;
        for (int s = 0; s <= tmax; ++s) {
            const size_t srow = (size_t)b * SEQ + s;
            const GAS v4u* ks = (const GAS v4u*)(P + srow * ld + C_K + h * 128);
            float dot = 0.f;
#pragma unroll
            for (int i = 0; i < 16; ++i) { const v4u kk = ks[i];
                dot += bflo(qp[i].x) * bflo(kk.x) + bfhi(qp[i].x) * bfhi(kk.x) + bflo(qp[i].y) * bflo(kk.y) + bfhi(qp[i].y) * bfhi(kk.y)
                     + bflo(qp[i].z) * bflo(kk.z) + bfhi(qp[i].z) * bfhi(kk.z) + bflo(qp[i].w) * bflo(kk.w) + bfhi(qp[i].w) * bfhi(kk.w); }
            const float w = (s <= t) ? dot * exp2f((float)(t - s) * lg) : 0.f;
            const GAS v4u* vs = (const GAS v4u*)(P + srow * ld + C_V + h * 128 + dvq * 32);
#pragma unroll
            for (int i = 0; i < 4; ++i) { const v4u vv = vs[i];
                o[8 * i + 0] += w * bflo(vv.x); o[8 * i + 1] += w * bfhi(vv.x); o[8 * i + 2] += w * bflo(vv.y); o[8 * i + 3] += w * bfhi(vv.y);
                o[8 * i + 4] += w * bflo(vv.z); o[8 * i + 5] += w * bfhi(vv.z); o[8 * i + 6] += w * bflo(vv.w); o[8 * i + 7] += w * bfhi(vv.w); }
        }
        float ss = 0.f;
#pragma unroll
        for (int i = 0; i < 32; ++i) ss += o[i] * o[i];
        ss += __shfl_xor(ss, 1); ss += __shfl_xor(ss, 2);
        const float rstd = 1.0f / sqrtf(ss * (1.f / 128.f) + EPS);
        const GAS v4u* gs = (const GAS v4u*)(P + row * ld + C_G + h * 128 + dvq * 32);
        GAS v4u* os = (GAS v4u*)(P + row * ld + C_Q + h * 128 + dvq * 32);
#pragma unroll
        for (int i = 0; i < 4; ++i) { const v4u gg = gs[i]; v4u w;
            w.x = pk2(o[8 * i + 0] * rstd * bflo(gg.x), o[8 * i + 1] * rstd * bfhi(gg.x)); w.y = pk2(o[8 * i + 2] * rstd * bflo(gg.y), o[8 * i + 3] * rstd * bfhi(gg.y));
            w.z = pk2(o[8 * i + 4] * rstd * bflo(gg.z), o[8 * i + 5] * rstd * bfhi(gg.z)); w.w = pk2(o[8 * i + 6] * rstd * bflo(gg.w), o[8 * i + 7] * rstd * bfhi(gg.w));
            os[i] = w; }
    }
}
#define NAIVE_ATT_BODY(NKEYS, KPTR, VPTR, BIAS, VALID) \
    float o[64]; _Pragma("unroll") for (int i = 0; i < 64; ++i) o[i] = 0.f; \
    float mrun = -INFINITY, lrun = 0.f; \
    for (int s = 0; s < (NKEYS); ++s) { \
        const GAS v4u* ks = (const GAS v4u*)(KPTR); float dot = 0.f; \
        _Pragma("unroll") for (int i = 0; i < 8; ++i) { const v4u kk = ks[i]; \
            dot += bflo(qp[i].x) * bflo(kk.x) + bfhi(qp[i].x) * bfhi(kk.x) + bflo(qp[i].y) * bflo(kk.y) + bfhi(qp[i].y) * bfhi(kk.y) \
                 + bflo(qp[i].z) * bflo(kk.z) + bfhi(qp[i].z) * bfhi(kk.z) + bflo(qp[i].w) * bflo(kk.w) + bfhi(qp[i].w) * bfhi(kk.w); } \
        const float logit = dot + (BIAS); \
        if (VALID) { const float mn = fmaxf(mrun, logit), a = exp2f(mrun - mn), p = exp2f(logit - mn); lrun = lrun * a + p; mrun = mn; \
            const GAS v4u* vs = (const GAS v4u*)(VPTR); \
            _Pragma("unroll") for (int i = 0; i < 8; ++i) { const v4u vv = vs[i]; \
                o[8 * i + 0] = o[8 * i + 0] * a + p * bflo(vv.x); o[8 * i + 1] = o[8 * i + 1] * a + p * bfhi(vv.x); o[8 * i + 2] = o[8 * i + 2] * a + p * bflo(vv.y); o[8 * i + 3] = o[8 * i + 3] * a + p * bfhi(vv.y); \
                o[8 * i + 4] = o[8 * i + 4] * a + p * bflo(vv.z); o[8 * i + 5] = o[8 * i + 5] * a + p * bfhi(vv.z); o[8 * i + 6] = o[8 * i + 6] * a + p * bflo(vv.w); o[8 * i + 7] = o[8 * i + 7] * a + p * bfhi(vv.w); } } \
    } \
    const float rl = 1.0f / lrun;
#define NAIVE_ATT_STORE(OPTR) { GAS v4u* os = (GAS v4u*)(OPTR); \
    _Pragma("unroll") for (int i = 0; i < 8; ++i) { v4u w; w.x = pk2(o[8 * i + 0] * rl, o[8 * i + 1] * rl); w.y = pk2(o[8 * i + 2] * rl, o[8 * i + 3] * rl); \
        w.z = pk2(o[8 * i + 4] * rl, o[8 * i + 5] * rl); w.w = pk2(o[8 * i + 6] * rl, o[8 * i + 7] * rl); os[i] = w; } }

__device__ __forceinline__ void naive_mem(Frame& F, KArgs ka, int layer) {
    bf16* P = WSP(bf16, WS_PROJ); const int ld = layer ? NP1 : NP0;
    const int b = F.gw >> 7, tb = (F.gw & 127) >> 2, hm = F.gw & 3, t = tb * 64 + F.lane;
    const size_t row = (size_t)b * SEQ + t;
    v4u qp[8];
    { const GAS v4u* qs = (const GAS v4u*)(P + row * ld + C_MQ + hm * 64);
#pragma unroll
      for (int i = 0; i < 8; ++i) qp[i] = qs[i]; }
    const bf16* kv = WSP(bf16, WS_MEMKV) + (size_t)b * MEML * DM + layer * 512 + hm * 64;
    NAIVE_ATT_BODY(MEML, kv + (size_t)s * DM, kv + (size_t)s * DM + 256, 0.f, true)
    NAIVE_ATT_STORE(P + row * ld + C_MQ + hm * 64)
}
__device__ __forceinline__ void scan_phase(Frame& F, KArgs ka) {
    if (F.gw >= BATCH * 12) return;
    const int b = F.gw / 12, h = F.gw % 12;
    const float* src = WSP(float, WS_LOGF) + ((size_t)b * SEQ + F.lane * 32) * 16 + h;
    float s = 0.f;
    for (int i = 0; i < 32; ++i) s += src[(size_t)i * 16];
    float incl = s;
#pragma unroll
    for (int o = 1; o < 64; o <<= 1) { const float v = __shfl_up(incl, o); if (F.lane >= o) incl += v; }
    float run = incl - s;
    float* dst = WSP(float, WS_CS) + (size_t)(b * 12 + h) * SEQ + F.lane * 32;
    for (int i = 0; i < 32; ++i) { run += src[(size_t)i * 16]; dst[i] = run; }
}

#define RUN() (lo <= ph && ph < hi)
#define SEAM() do { if (lo <= ph && ph + 1 < hi) xcd_barrier(bar); ++ph; } while (0)
#define RELANE() do { int t_ = threadIdx.x; asm volatile("" : "+v"(t_)); F.tid = t_; F.lane = t_ & 63; F.wave = __builtin_amdgcn_readfirstlane(t_ >> 6); F.gw = blockIdx.x * NWAVES + F.wave; } while (0)
template <int layer> __device__ __forceinline__ void run_layer(Frame& F, const XcdBarrier& bar, const int lo, const int hi, int& ph, LAS unsigned char* ring, unsigned char* lds, const int G, const int c) {
        const int NP = layer ? NP1 : NP0;
        if (RUN()) {
            KArgs ka = KA_GET();
            pg8::Gemm g{WSP(bf16, WS_XN), layer ? WSP(bf16, WS_WIN1) : WSP(bf16, WS_WIN0), MTOK, NP, DM, DM}; pg8::StaticOrder S; S.init(MTOK, NP, G, c);
            pg8::EpiProj E{WSP(bf16, WS_PROJ), NP, layer, (const int*)ka->in[2], WSP(float, WS_LOGF), ka->in[5]};
            pg8::gemm_phase<pg8::EpiProj, pg8::StaticOrder, true, true>(ring, g, S, E);
            if (layer == 0) {
                pg8::Gemm g2{WSP(bf16, WS_MEMN), WSP(bf16, WS_WMEM), MMEM, DM, DM, DM}; pg8::OneUnit S2; const int idx = c - 128; S2.has = (idx >= 0 && idx < 64); S2.u0.pm = idx >> 2; S2.u0.pn = idx & 3;
                pg8::EpiBf16<0> E2{WSP(bf16, WS_MEMKV), DM};
                pg8::gemm_phase<pg8::EpiBf16<0>, pg8::OneUnit, true, true>(ring, g2, S2, E2);
            }
        }
        SEAM();
        if (RUN()) { RELANE(); if (layer == 1) scan_phase(F, KA_GET()); }
        SEAM();
        if (RUN()) { RELANE(); KArgs ka = KA_GET(); if (layer == 0) naive_retention(F, ka);
            else {
                static_assert(attn_body::ATTN_LDS_BYTES <= RING_BYTES, "attention LDS");
                bf16* PR = WSP(bf16, WS_PROJ); const attn_body::AttnTensors AT{(const attn_body::bf16*)(PR + C_Q), (const attn_body::bf16*)(PR + C_K), (const attn_body::bf16*)(PR + C_V), (attn_body::bf16*)(PR + C_Q), WSP(float, WS_CS)};
                const attn_body::StaticOrder S((int)F.G, (int)blockIdx.x);
                attn_body::attn_phase<attn_body::StaticOrder>((char*)lds + RING_OFF, AT, S);
            }
            RELANE(); naive_mem(F, KA_GET(), layer); }
        SEAM();
        if (RUN()) {
            KArgs ka = KA_GET();
            pg8::Gemm g{WSP(bf16, WS_PROJ), WSP(bf16, WS_WOUT) + (size_t)layer * DM * DM, MTOK, DM, DM, NP}; pg8::StaticOrder S; S.init(MTOK, DM, G, c);
            pg8::EpiF32 E{ka->out, DM};
            pg8::gemm_phase<pg8::EpiF32, pg8::StaticOrder, true, true>(ring, g, S, E);
        }
        SEAM();
        if (RUN()) { RELANE(); KArgs ka = KA_GET(); row_pass(F, ka->out, layer ? WSP(float, WS_R1) : ka->in[0], ka->in[11] + layer * DM, WSP(float, WS_R1), WSP(bf16, WS_XN)); }
        SEAM();
        if (RUN()) {
            KArgs ka = KA_GET();
            pg8::Gemm g{WSP(bf16, WS_XN), WSP(bf16, WS_WUP) + (size_t)layer * DM * FF, MTOK, FF, DM, DM}; pg8::StaticOrder S; S.init(MTOK, FF, G, c);
            pg8::EpiBf16<1> E{WSP(bf16, WS_H), FF};
            pg8::gemm_phase<pg8::EpiBf16<1>, pg8::StaticOrder, true, true>(ring, g, S, E);
        }
        SEAM();
        if (RUN()) {
            KArgs ka = KA_GET();
            pg8::Gemm g{WSP(bf16, WS_H), WSP(bf16, WS_WDN) + (size_t)layer * DM * FF, MTOK, DM, FF, FF}; pg8::StaticOrder S; S.init(MTOK, DM, G, c);
            pg8::EpiF32 E{ka->out, DM};
            pg8::gemm_phase<pg8::EpiF32, pg8::StaticOrder, true, true>(ring, g, S, E);
        }
        SEAM();
        if (RUN()) { RELANE(); KArgs ka = KA_GET(); row_pass(F, ka->out, WSP(float, WS_R1), ka->in[13] + layer * DM, layer ? ka->out : WSP(float, WS_R1), layer ? nullptr : WSP(bf16, WS_XN)); }
        SEAM();
    }
__global__ void __launch_bounds__(NWAVES * 64, 2) fwd_kernel(Args args) {
    extern __shared__ __attribute__((aligned(16))) unsigned char lds[];
    Frame F;
    F.lds = (LAS unsigned char*)lds;
    F.tid = threadIdx.x; F.lane = F.tid & 63; F.wave = __builtin_amdgcn_readfirstlane(F.tid >> 6);
    F.G = gridDim.x; F.gw = blockIdx.x * NWAVES + F.wave;
    for (int u = F.tid; u < (LDS_BYTES - LDSCTL_OFF) / 4; u += NWAVES * 64) ((LAS unsigned*)(F.lds + LDSCTL_OFF))[u] = 0u;
    __syncthreads();
    volatile LAS unsigned* MISC = (volatile LAS unsigned*)(F.lds + MISC_OFF);
    XcdBarrier bar = xcd_barrier_post((unsigned*)(args.ws + WS_CTL) + CW_BAR, MISC + 8);
    const int lo = args.ph_lo, hi = args.ph_hi;
    int ph = 0;
    LAS unsigned char* ring = F.lds + RING_OFF;
    const int G = F.G, c = (int)blockIdx.x;

    if (RUN()) { RELANE(); p0_prologue(F, KA_GET()); }
    SEAM();
    run_layer<0>(F, bar, lo, hi, ph, ring, lds, G, c);
    run_layer<1>(F, bar, lo, hi, ph, ring, lds, G, c);
#undef RUN
#undef SEAM
}

#ifndef MK_MULTI
#define MK_MULTI 0
#endif
constexpr int N_PHASES = 1 + 2 * 8;
extern "C" void kernel_launch(void* const* d_in, const int* in_sizes, int n_in, void* d_out, int out_size, void* d_ws, size_t ws_size, hipStream_t stream) {
    static int grid = 0;
    if (grid == 0) {
        if (n_in != 15 || in_sizes[0] != MTOK * DM || out_size != MTOK * DM || ws_size < WS_END) { fprintf(stderr, "kernel_launch: unexpected shapes (n_in %d, in0 %d, out %d, ws %zu); nothing launched\n", n_in, n_in > 0 ? in_sizes[0] : -1, out_size, ws_size); grid = -1; return; }
        int dev = 0, cus = 0, per_cu = 0;
        if (hipGetDevice(&dev) != hipSuccess || hipDeviceGetAttribute(&cus, hipDeviceAttributeMultiprocessorCount, dev) != hipSuccess) { grid = -1; return; }
        if (hipFuncSetAttribute((const void*)fwd_kernel, hipFuncAttributeMaxDynamicSharedMemorySize, LDS_BYTES) != hipSuccess) { fprintf(stderr, "kernel_launch: hipFuncSetAttribute failed\n"); grid = -1; return; }
        if (hipOccupancyMaxActiveBlocksPerMultiprocessor(&per_cu, (const void*)fwd_kernel, NWAVES * 64, LDS_BYTES) != hipSuccess || per_cu < 1)
            fprintf(stderr, "kernel_launch: occupancy query reports %d workgroups per CU\n", per_cu);
        (void)hipGetLastError();
        grid = cus;
    }
    if (grid < 0) return;
    if (hipMemsetAsync((char*)d_ws + WS_CTL, 0, CTL_ZERO_BYTES, stream) != hipSuccess) return;
    Args a{};
    for (int i = 0; i < 15; ++i) a.in[i] = (const float*)d_in[i];
    a.out = (float*)d_out; a.ws = (unsigned char*)d_ws;
#if MK_MULTI
    for (int p = 0; p < N_PHASES; ++p) { a.ph_lo = p; a.ph_hi = p + 1; hipLaunchKernelGGL(fwd_kernel, dim3(grid), dim3(NWAVES * 64), LDS_BYTES, stream, a); }
#else
    a.ph_lo = 0; a.ph_hi = N_PHASES;
    hipLaunchKernelGGL(fwd_kernel, dim3(grid), dim3(NWAVES * 64), LDS_BYTES, stream, a);
#endif
}
```

```cpp
#include <hip/hip_runtime.h>
#include <hip/hip_bf16.h>
#include <cmath>
#include <cstdio>
#include <cstdint>

constexpr int BATCH = 16, SEQ = 2048, DM = 1024, MTOK = BATCH * SEQ, MEML = 256, MMEM = BATCH * MEML, FF = 4096;
constexpr int NP0 = 3328, NP1 = 2816;
constexpr int C_Q = 0, C_MQ = 768, C_K = 1024, C_V = 1792, C_G = 2560;
constexpr float EPS = 1e-6f;
constexpr float LOG2E = 1.4426950408889634f;
constexpr float QSCALE = 0.125f * LOG2E;

namespace pg8 {
#define PG8_LAS __attribute__((address_space(3)))
typedef unsigned short bf16_t;
typedef short bf16x8 __attribute__((ext_vector_type(8)));
typedef float f32x4 __attribute__((ext_vector_type(4)));
typedef unsigned u32x4 __attribute__((ext_vector_type(4)));
constexpr int BM = 256, BK = 64, HALF = 128, HTB = HALF * BK * 2  , STAGE_BYTES = 8 * HTB, NXCD = 8, WGM = 8;

__host__ __device__ __forceinline__ int lds_byte(int r, int c) { const int st = (r >> 4) * 2 + (c >> 5), rr = r & 15, cc = c & 31, ob = rr * 64 + cc * 2; return st * 1024 + (ob ^ (((ob >> 9) & 1) << 5)); }
__host__ __device__ __forceinline__ void stage_rc(int b, int& R, int& C) { const int st = b / 1024, sb = b % 1024, swz = sb ^ (((sb >> 9) & 1) << 5); R = (st >> 1) * 16 + swz / 64; C = (st & 1) * 32 + (swz % 64) / 2; }
__host__ __device__ __forceinline__ int perm32(int rho) { const int n = rho >> 4, i = rho & 15; return 8 * (i >> 2) + 4 * n + (i & 3); }

struct Unit { int pm, pn; };
struct Gemm { const bf16_t* A; const bf16_t* Bt; int M, N, K, lda; };

struct StaticOrder {
    int nM, nN, nwg, G, c;
    __host__ __device__ void init(int M, int N, int G_, int c_) { nM = M / BM; nN = N / BM; nwg = nM * nN; G = G_; c = c_; }
    __host__ __device__ bool next(int i, Unit& u) const {
        const long L = (long)i * G + c; if (L >= nwg) return false;
        int wgid = (int)L; { const int q = nwg / NXCD, r = nwg % NXCD, xcd = wgid % NXCD, off = wgid / NXCD; wgid = (xcd < r ? xcd * (q + 1) : r * (q + 1) + (xcd - r) * q) + off; }
        const int nig = WGM * nN, gid = wgid / nig, fm = gid * WGM, gsz = (nM - fm) < WGM ? (nM - fm) : WGM;
        u.pm = fm + ((wgid % nig) % gsz); u.pn = (wgid % nig) / gsz; return true;
    }
    __device__ __forceinline__ void a_ready(const Unit&) const {}
    __device__ __forceinline__ void done(const Unit&) const {}
};
struct OneUnit {
    Unit u0; bool has;
    __device__ __forceinline__ bool next(int i, Unit& u) const { if (i != 0 || !has) return false; u = u0; return true; }
    __device__ __forceinline__ void a_ready(const Unit&) const {}
    __device__ __forceinline__ void done(const Unit&) const {}
};

typedef float f32x2_t __attribute__((ext_vector_type(2))); typedef __bf16 bf16x2_t __attribute__((ext_vector_type(2)));
__device__ __forceinline__ unsigned cvt_pk_bf16(float lo, float hi) { f32x2_t v = {lo, hi}; bf16x2_t b = __builtin_convertvector(v, bf16x2_t); return __builtin_bit_cast(unsigned, b); }

template <int ACT> struct EpiBf16 {
    static constexpr bool PERM = true, AFTER_DRAIN = false;
    bf16_t* O; int ldc;
    __device__ __forceinline__ void operator()(const f32x4 (&acc)[2][2][4][2], const Unit& u, int wr, int wc, int fr, int fq) const {
        const int row0 = u.pm * BM + wr * 64 + fr, col0 = u.pn * BM + wc * 32 + 8 * fq;
#pragma unroll
        for (int ai = 0; ai < 2; ++ai)
#pragma unroll
            for (int m = 0; m < 4; ++m) { bf16_t* rowp = O + (size_t)(row0 + ai * HALF + m * 16) * ldc + col0;
#pragma unroll
                for (int bj = 0; bj < 2; ++bj) { f32x4 v0 = acc[ai][bj][m][0], v1 = acc[ai][bj][m][1];
                    if (ACT == 1) {
#pragma unroll
                        for (int e = 0; e < 4; ++e) { const float a = fmaxf(v0[e], 0.f), b = fmaxf(v1[e], 0.f); v0[e] = a * a; v1[e] = b * b; } }
                    u32x4 w; w.x = cvt_pk_bf16(v0[0], v0[1]); w.y = cvt_pk_bf16(v0[2], v0[3]); w.z = cvt_pk_bf16(v1[0], v1[1]); w.w = cvt_pk_bf16(v1[2], v1[3]);
                    *(u32x4*)(rowp + bj * HALF) = w; } }
    }
};
struct EpiF32 {
    static constexpr bool PERM = false, AFTER_DRAIN = false;
    float* O; int ldc;
    __device__ __forceinline__ void operator()(const f32x4 (&acc)[2][2][4][2], const Unit& u, int wr, int wc, int fr, int fq) const {
        const int row0 = u.pm * BM + wr * 64 + fr, col0 = u.pn * BM + wc * 32 + 4 * fq;
#pragma unroll
        for (int ai = 0; ai < 2; ++ai)
#pragma unroll
            for (int m = 0; m < 4; ++m) { float* rowp = O + (size_t)(row0 + ai * HALF + m * 16) * ldc + col0;
#pragma unroll
                for (int bj = 0; bj < 2; ++bj)
#pragma unroll
                    for (int n = 0; n < 2; ++n) *(f32x4*)(rowp + bj * HALF + n * 16) = acc[ai][bj][m][n]; }
    }
};
struct EpiProj {
    static constexpr bool PERM = true, AFTER_DRAIN = false;
    bf16_t* O; int ldc; int layer; const int* pos; float* logf; const float* bfg;
    __device__ __forceinline__ void operator()(const f32x4 (&acc)[2][2][4][2], const Unit& u, int wr, int wc, int fr, int fq) const {
        const int row0 = u.pm * BM + wr * 64 + fr, cw = wc * 32 + 8 * fq, col0 = u.pn * BM + cw;
        int mode; float sc = 1.f;
        if (layer == 0) { if (u.pn < 3) mode = 1; else if (u.pn == 3) { mode = 0; sc = QSCALE; } else if (u.pn < 7) { mode = 1; sc = 0.08838834764831845f; } else if (u.pn < 10) mode = 0; else mode = 4; }
        else { if (u.pn < 4) { mode = 0; sc = QSCALE; } else if (u.pn < 10) mode = 0; else mode = 5; }
        if (mode == 5) {
            if (wc == 0 && fq < 2) {
#pragma unroll
                for (int ai = 0; ai < 2; ++ai)
#pragma unroll
                    for (int m = 0; m < 4; ++m) { const int row = row0 + ai * HALF + m * 16;
#pragma unroll
                        for (int n = 0; n < 2; ++n)
#pragma unroll
                            for (int e = 0; e < 4; ++e) { const int c = 8 * fq + 4 * n + e;
                                if (c < 12) { const float z = acc[ai][0][m][n][e] + bfg[c]; const float az = fabsf(z);
                                    logf[(size_t)row * 16 + c] = fminf(z, 0.f) * LOG2E - __log2f(1.f + exp2f(-az * LOG2E)); } } }
            }
            return;
        }
        float invf[4];
        if (mode == 1) {
#pragma unroll
            for (int p = 0; p < 4; ++p) invf[p] = exp2f(-(float)((cw >> 1) + p) * (13.287712379549449f / 64.f)) * 0.15915494309189535f;
        }
#pragma unroll
        for (int ai = 0; ai < 2; ++ai)
#pragma unroll
            for (int m = 0; m < 4; ++m) { const int row = row0 + ai * HALF + m * 16; bf16_t* rowp = O + (size_t)row * ldc + col0;
                float cs[4], sn[4];
                if (mode == 1) { const float ps = (float)pos[row];
#pragma unroll
                    for (int p = 0; p < 4; ++p) { float rev = ps * invf[p]; rev = rev - floorf(rev); sn[p] = __builtin_amdgcn_sinf(rev); cs[p] = __builtin_amdgcn_cosf(rev); } }
#pragma unroll
                for (int bj = 0; bj < 2; ++bj) { f32x4 v0 = acc[ai][bj][m][0], v1 = acc[ai][bj][m][1];
                    if (mode == 1) {
                        const float a0 = v0[0] * cs[0] - v0[1] * sn[0], b0 = v0[0] * sn[0] + v0[1] * cs[0];
                        const float a1 = v0[2] * cs[1] - v0[3] * sn[1], b1 = v0[2] * sn[1] + v0[3] * cs[1];
                        const float a2 = v1[0] * cs[2] - v1[1] * sn[2], b2 = v1[0] * sn[2] + v1[1] * cs[2];
                        const float a3 = v1[2] * cs[3] - v1[3] * sn[3], b3 = v1[2] * sn[3] + v1[3] * cs[3];
                        v0 = (f32x4){a0, b0, a1, b1}; v1 = (f32x4){a2, b2, a3, b3};
                    } else if (mode == 4) {
#pragma unroll
                        for (int e = 0; e < 4; ++e) { v0[e] = v0[e] / (1.f + exp2f(-v0[e] * LOG2E)); v1[e] = v1[e] / (1.f + exp2f(-v1[e] * LOG2E)); }
                    }
                    v0 = v0 * sc; v1 = v1 * sc;
                    u32x4 w; w.x = cvt_pk_bf16(v0[0], v0[1]); w.y = cvt_pk_bf16(v0[2], v0[3]); w.z = cvt_pk_bf16(v1[0], v1[1]); w.w = cvt_pk_bf16(v1[2], v1[3]);
                    *(u32x4*)(rowp + bj * HALF) = w; } }
    }
};

template <class Epi, class Sched, bool ALIGN_EPI = false, bool SP2 = false>
__device__ __forceinline__ void gemm_phase(PG8_LAS unsigned char* lds, const Gemm g, const Sched& S, const Epi& E) {
    int tid_ = threadIdx.x; asm volatile("" : "+v"(tid_));
    const int tid = tid_, wid = __builtin_amdgcn_readfirstlane(tid >> 6), lane = tid & 63, wr = wid >> 2, wc = wid & 3, fr = lane & 15, fq = lane >> 4;
    const int K = g.K, nt = K / BK;
    unsigned voffA[2], voffB[2];
#pragma unroll
    for (int i = 0; i < 2; ++i) { int R, C; stage_rc(tid * 16 + i * 8192, R, C); const int Rb = Epi::PERM ? ((R & ~31) + perm32(R & 31)) : R;
        voffA[i] = (unsigned)(R * g.lda + C) * 2u; voffB[i] = (unsigned)(Rb * K + C) * 2u; }
    const size_t kstep = (size_t)(BK * 2);
    const size_t hstepA = (size_t)HALF * g.lda * 2, hstepB = (size_t)HALF * K * 2;
    const size_t tstepA = 2 * hstepA, tstepB = 2 * hstepB;
    const unsigned ldsw = (unsigned)wid * 1024u;
    const int aoff = lds_byte(wr * 64 + fr, fq * 8), boff = lds_byte(wc * 32 + fr, fq * 8);
#define PG8_SA(b, h) (((b) * 2 + (h)) * HTB)
#define PG8_SB(b, h) ((4 + (b) * 2 + (h)) * HTB)
#define PG8_STAGE(bufoff, gbase, voff) do { _Pragma("unroll") for (int _i = 0; _i < 2; ++_i) \
        __builtin_amdgcn_global_load_lds((const unsigned*)((const char*)(gbase) + (voff)[_i]), (PG8_LAS unsigned*)(lds + (bufoff) + ldsw + _i * 8192), 16, 0, 0); } while (0)
#define PG8_LDA(dst, b, h) do { _Pragma("unroll") for (int m = 0; m < 4; ++m) _Pragma("unroll") for (int k = 0; k < 2; ++k) dst[m][k] = *(const PG8_LAS bf16x8*)(lds + PG8_SA(b, h) + aoff + m * 2048 + k * 1024); } while (0)
#define PG8_LDB(dst, b, h) do { _Pragma("unroll") for (int n = 0; n < 2; ++n) _Pragma("unroll") for (int k = 0; k < 2; ++k) dst[n][k] = *(const PG8_LAS bf16x8*)(lds + PG8_SB(b, h) + boff + n * 2048 + k * 1024); } while (0)
#define PG8_MMA(ai, bj, At, Bt) do { __builtin_amdgcn_s_setprio(1); _Pragma("unroll") for (int m = 0; m < 4; ++m) _Pragma("unroll") for (int n = 0; n < 2; ++n) _Pragma("unroll") for (int k = 0; k < 2; ++k) \
        acc[ai][bj][m][n] = __builtin_amdgcn_mfma_f32_16x16x32_bf16(Bt[n][k], At[m][k], acc[ai][bj][m][n], 0, 0, 0); __builtin_amdgcn_s_setprio(0); } while (0)
#define PG8_WAIT_V(n) asm volatile("s_waitcnt vmcnt(" #n ")" ::: "memory")
#define PG8_WAIT_L(n) asm volatile("s_waitcnt lgkmcnt(" #n ")" ::: "memory")
#define PG8_BAR __builtin_amdgcn_s_barrier()
#define PG8_SCHED __builtin_amdgcn_sched_barrier(0)
    Unit cur, nxt; int ui = 0;
    if (!S.next(0, cur)) return;
    f32x4 acc[2][2][4][2];
#pragma unroll
    for (int a = 0; a < 2; ++a)
#pragma unroll
        for (int b = 0; b < 2; ++b)
#pragma unroll
            for (int m = 0; m < 4; ++m)
#pragma unroll
                for (int n = 0; n < 2; ++n) acc[a][b][m][n] = (f32x4){0.f, 0.f, 0.f, 0.f};
    bf16x8 At[4][2], B0[2][2], B1[2][2];
    const char* cA = (const char*)g.A + (size_t)cur.pm * tstepA; const char* cB = (const char*)g.Bt + (size_t)cur.pn * tstepB;
    S.a_ready(cur);
    if constexpr (SP2) {
        PG8_STAGE(PG8_SB(0, 0), cB, voffB); PG8_STAGE(PG8_SB(0, 1), cB + hstepB, voffB); PG8_STAGE(PG8_SA(0, 0), cA, voffA); PG8_STAGE(PG8_SA(0, 1), cA + hstepA, voffA);
        if (wr == 1) PG8_BAR;
        PG8_WAIT_V(2); PG8_BAR;
        PG8_STAGE(PG8_SB(1, 0), cB + kstep, voffB); PG8_STAGE(PG8_SA(1, 0), cA + kstep, voffA); PG8_STAGE(PG8_SB(1, 1), cB + hstepB + kstep, voffB);
        PG8_WAIT_V(6); PG8_BAR;
    } else {
        PG8_STAGE(PG8_SB(0, 0), cB, voffB); PG8_STAGE(PG8_SA(0, 0), cA, voffA); PG8_STAGE(PG8_SB(0, 1), cB + hstepB, voffB); PG8_STAGE(PG8_SA(0, 1), cA + hstepA, voffA);
        if (wr == 1) PG8_BAR;
        PG8_WAIT_V(4); PG8_BAR;
        PG8_STAGE(PG8_SB(1, 0), cB + kstep, voffB); PG8_STAGE(PG8_SA(1, 0), cA + kstep, voffA); PG8_STAGE(PG8_SB(1, 1), cB + hstepB + kstep, voffB);
        PG8_WAIT_V(6); PG8_BAR;
    }
    for (;;) {
        const bool has_next = S.next(ui + 1, nxt);
        const char* nA = has_next ? (const char*)g.A + (size_t)nxt.pm * tstepA : cA; const char* nB = has_next ? (const char*)g.Bt + (size_t)nxt.pn * tstepB : cB;
        for (int t = 0; t < nt; t += 2) {
            const bool last = (t == nt - 2);
            const char* a1 = cA + (size_t)(t + 1) * kstep;
            const char* a2 = last ? nA : cA + (size_t)(t + 2) * kstep; const char* b2 = last ? nB : cB + (size_t)(t + 2) * kstep;
            const char* a3 = a2 + kstep; const char* b3 = b2 + kstep;
            if (last && has_next) S.a_ready(nxt);
            if constexpr (SP2) {
            PG8_LDB(B0, 0, 0); PG8_LDB(B1, 0, 1); PG8_SCHED; PG8_LDA(At, 0, 0); PG8_STAGE(PG8_SA(1, 1), a1 + hstepA, voffA);
            PG8_WAIT_V(8); PG8_WAIT_L(0); PG8_BAR; PG8_MMA(0, 0, At, B0); PG8_MMA(0, 1, At, B1); PG8_BAR; PG8_SCHED;
            PG8_LDA(At, 0, 1); PG8_STAGE(PG8_SB(0, 0), b2, voffB); PG8_STAGE(PG8_SB(0, 1), b2 + hstepB, voffB); PG8_STAGE(PG8_SA(0, 0), a2, voffA);
            PG8_WAIT_V(8); PG8_WAIT_L(0); PG8_BAR; PG8_MMA(1, 0, At, B0); PG8_MMA(1, 1, At, B1); PG8_BAR; PG8_SCHED;
            PG8_LDB(B0, 1, 0); PG8_LDB(B1, 1, 1); PG8_SCHED; PG8_LDA(At, 1, 0); PG8_STAGE(PG8_SA(0, 1), a2 + hstepA, voffA);
            PG8_WAIT_V(8); PG8_WAIT_L(0); PG8_BAR; PG8_MMA(0, 0, At, B0); PG8_MMA(0, 1, At, B1); PG8_BAR; PG8_SCHED;
            PG8_LDA(At, 1, 1); PG8_STAGE(PG8_SB(1, 0), b3, voffB); PG8_STAGE(PG8_SB(1, 1), b3 + hstepB, voffB); PG8_STAGE(PG8_SA(1, 0), a3, voffA);
            PG8_WAIT_V(8); PG8_WAIT_L(0); PG8_BAR; PG8_MMA(1, 0, At, B0); PG8_MMA(1, 1, At, B1); PG8_BAR; PG8_SCHED;
            } else {
            PG8_LDB(B0, 0, 0); PG8_SCHED; PG8_LDA(At, 0, 0); PG8_STAGE(PG8_SA(1, 1), a1 + hstepA, voffA);
            PG8_WAIT_L(8); PG8_BAR; PG8_WAIT_L(0); PG8_MMA(0, 0, At, B0); PG8_BAR; PG8_SCHED;
            PG8_LDB(B1, 0, 1); PG8_STAGE(PG8_SB(0, 0), b2, voffB);
            PG8_BAR; PG8_WAIT_L(0); PG8_MMA(0, 1, At, B1); PG8_BAR;
            PG8_LDA(At, 0, 1); PG8_STAGE(PG8_SA(0, 0), a2, voffA);
            PG8_BAR; PG8_WAIT_L(0); PG8_MMA(1, 0, At, B0); PG8_BAR; PG8_SCHED;
            PG8_STAGE(PG8_SB(0, 1), b2 + hstepB, voffB);
            PG8_WAIT_V(6); PG8_BAR; PG8_MMA(1, 1, At, B1); PG8_BAR;
            PG8_LDB(B0, 1, 0); PG8_SCHED; PG8_LDA(At, 1, 0); PG8_STAGE(PG8_SA(0, 1), a2 + hstepA, voffA);
            PG8_WAIT_L(8); PG8_BAR; PG8_WAIT_L(0); PG8_MMA(0, 0, At, B0); PG8_BAR; PG8_SCHED;
            PG8_LDB(B1, 1, 1); PG8_STAGE(PG8_SB(1, 0), b3, voffB);
            PG8_BAR; PG8_WAIT_L(0); PG8_MMA(0, 1, At, B1); PG8_BAR;
            PG8_LDA(At, 1, 1); PG8_STAGE(PG8_SA(1, 0), a3, voffA);
            PG8_BAR; PG8_WAIT_L(0); PG8_MMA(1, 0, At, B0); PG8_BAR; PG8_SCHED;
            PG8_STAGE(PG8_SB(1, 1), b3 + hstepB, voffB);
            PG8_WAIT_V(6); PG8_BAR; PG8_MMA(1, 1, At, B1); PG8_BAR;
            }
        }
        if constexpr (ALIGN_EPI) { if (wr == 0) PG8_BAR; }
        if constexpr (!Epi::AFTER_DRAIN) { E(acc, cur, wr, wc, fr, fq); S.done(cur); }
        if (!has_next) break;
#pragma unroll
        for (int a = 0; a < 2; ++a)
#pragma unroll
            for (int b = 0; b < 2; ++b)
#pragma unroll
                for (int m = 0; m < 4; ++m)
#pragma unroll
                    for (int n = 0; n < 2; ++n) acc[a][b][m][n] = (f32x4){0.f, 0.f, 0.f, 0.f};
        cur = nxt; cA = nA; cB = nB; ++ui;
        if constexpr (ALIGN_EPI) { if (wr == 1) PG8_BAR; }
    }
    PG8_WAIT_V(0);
    if constexpr (!ALIGN_EPI) { if (wr == 0) PG8_BAR; }
    PG8_BAR;
    if constexpr (Epi::AFTER_DRAIN) { E.fused(acc, cur, wr, wc, fr, fq, lds, wid, lane); S.done(cur); }
#undef PG8_SA
#undef PG8_SB
#undef PG8_STAGE
#undef PG8_LDA
#undef PG8_LDB
#undef PG8_MMA
#undef PG8_WAIT_V
#undef PG8_WAIT_L
#undef PG8_BAR
#undef PG8_SCHED
}
}

constexpr size_t MiB = 1u << 20;
constexpr size_t WS_CTL = 0, CTL_ZERO_BYTES = 64 * 1024;
constexpr size_t WS_WIN0 = 1 * MiB;
constexpr size_t WS_WIN1 = WS_WIN0 + (size_t)NP0 * DM * 2;
constexpr size_t WS_WMEM = 13 * MiB;
constexpr size_t WS_WOUT = 15 * MiB;
constexpr size_t WS_WUP = 19 * MiB;
constexpr size_t WS_WDN = 35 * MiB;
constexpr size_t WS_MEMKV = 51 * MiB;
constexpr size_t WS_LOGF = 59 * MiB;
constexpr size_t WS_CS = 61 * MiB;
constexpr size_t WS_XN = 64 * MiB;
constexpr size_t WS_R1 = 128 * MiB;
constexpr size_t WS_H = 256 * MiB;
constexpr size_t WS_PROJ = 256 * MiB;
constexpr size_t WS_MEMN = 464 * MiB;
constexpr size_t WS_END = 512 * MiB;
static_assert(WS_WIN1 + (size_t)NP1 * DM * 2 <= WS_WMEM && WS_PROJ + (size_t)MTOK * NP0 * 2 <= WS_MEMN, "d_ws map");
constexpr int CW_BAR = 4096;

constexpr int RING_OFF = 0, RING_BYTES = 131072;
constexpr int LDSCTL_OFF = RING_BYTES, MISC_OFF = LDSCTL_OFF + 320;
constexpr int LDS_BYTES = 147456;
constexpr int NWAVES = 8;

#define GAS __attribute__((address_space(1)))
#define LAS __attribute__((address_space(3)))
typedef unsigned short bf16;
typedef unsigned v4u __attribute__((ext_vector_type(4)));
typedef float f32x4 __attribute__((ext_vector_type(4)));
typedef GAS unsigned gu32;
#define LDS_WAIT() asm volatile("s_waitcnt lgkmcnt(0)" ::: "memory")
#define VM_WAIT() asm volatile("s_waitcnt vmcnt(0)" ::: "memory")
__device__ __forceinline__ unsigned f2bf(float f) { unsigned u = __builtin_bit_cast(unsigned, f); return (u + 0x7fffu + ((u >> 16) & 1u)) >> 16; }
__device__ __forceinline__ unsigned pk2(float lo, float hi) { return f2bf(lo) | (f2bf(hi) << 16); }
__device__ __forceinline__ float bflo(unsigned u) { return __builtin_bit_cast(float, u << 16); }
__device__ __forceinline__ float bfhi(unsigned u) { return __builtin_bit_cast(float, u & 0xffff0000u); }

namespace attn_body {
using bf16=__hip_bfloat16;
using bf16x8=__attribute__((ext_vector_type(8)))short;
using s16x4=__attribute__((ext_vector_type(4)))short;
using f32x16=__attribute__((ext_vector_type(16)))float;
using u32x4=__attribute__((ext_vector_type(4)))unsigned;
using f32x4v=__attribute__((ext_vector_type(4)))float;
constexpr int BATCH=16,NHEAD=12,SEQ=2048,D=64,DM=2816;
constexpr int NW=8,QBLK=32,QB=QBLK*NW,KVBLK=64,NQB=SEQ/QB;
constexpr int ATTN_PITCH=DM, ATTN_UNIT_ROWS=QB;
__device__ __forceinline__ int crow(int r,int hi){return (r&3)+8*(r>>2)+4*hi;}
#define SBAR() __builtin_amdgcn_sched_barrier(0)
__device__ __forceinline__ void cmask(f32x16&p0,f32x16&p1,int jb,int qrel,int hi){
  const float NEG=-INFINITY; int kb=64*jb+4*hi;
  #pragma unroll
  for(int r=0;r<16;++r){int kv=kb+(r&3)+8*(r>>2); if(kv>qrel)p0[r]=NEG; if(kv+32>qrel)p1[r]=NEG;}
}

constexpr int NSLOT=3, SLOTB=8192;
constexpr int LDS_K=0, LDS_V=NSLOT*SLOTB, LDS_WS=2*NSLOT*SLOTB, LDS_OST=LDS_WS+NW*64*4, LDS_BIAS=LDS_OST+NW*4096, LDS_BYTES=LDS_BIAS+SEQ*4;
constexpr float C2=0.125f*1.4426950408889634f;
__device__ __forceinline__ void glds16(const void*gsrc,unsigned lds_dst){unsigned keep;
  asm volatile("s_mov_b32 %0, m0\n\ts_mov_b32 m0, %2\n\ts_nop 0\n\tglobal_load_lds_dwordx4 %1, off\n\ts_mov_b32 m0, %0":"=&s"(keep):"v"(gsrc),"s"(lds_dst):"memory");}
__device__ __forceinline__ float max3f(float a,float b,float c){float r;asm("v_max3_f32 %0, %1, %2, %3":"=v"(r):"v"(a),"v"(b),"v"(c));return r;}
__device__ __forceinline__ float max2f(float a,float b){float r;asm("v_max_f32_e32 %0, %1, %2":"=v"(r):"v"(a),"v"(b));return r;}
__device__ __forceinline__ float fadd_s(float a,float b){float r;asm("v_add_f32_e32 %0, %1, %2":"=v"(r):"v"(a),"v"(b));return r;}
__device__ __forceinline__ float fsub_s(float a,float b){float r;asm("v_sub_f32_e32 %0, %1, %2":"=v"(r):"v"(a),"v"(b));return r;}
typedef float f32x2_t __attribute__((ext_vector_type(2))); typedef __bf16 bf16x2_t __attribute__((ext_vector_type(2)));
__device__ __forceinline__ unsigned cvtpk_s(float lo,float hi){f32x2_t v={lo,hi};bf16x2_t b=__builtin_convertvector(v,bf16x2_t);return __builtin_bit_cast(unsigned,b);}
#define WAIT_BAR(N) asm volatile("s_waitcnt vmcnt(" #N ") lgkmcnt(0)\n\ts_barrier":::"memory")

__device__ __forceinline__ void qkt(f32x16&p0,f32x16&p1,const char*Kslot,const bf16x8*qr,const f32x16&c0i,const f32x16&c1i,int r32,int hi){
  const char*kb=Kslot+hi*1024+r32*16;
  #pragma unroll
  for(int d0=0;d0<4;++d0){
    const bf16x8 b0=*reinterpret_cast<const bf16x8*>(kb+d0*2048);
    const bf16x8 b1=*reinterpret_cast<const bf16x8*>(kb+d0*2048+512);
    if(d0==0){p0=__builtin_amdgcn_mfma_f32_32x32x16_bf16(b0,qr[0],c0i,0,0,0);p1=__builtin_amdgcn_mfma_f32_32x32x16_bf16(b1,qr[0],c1i,0,0,0);}
    else{p0=__builtin_amdgcn_mfma_f32_32x32x16_bf16(b0,qr[d0],p0,0,0,0);p1=__builtin_amdgcn_mfma_f32_32x32x16_bf16(b1,qr[d0],p1,0,0,0);}}
}
typedef __attribute__((address_space(3))) const char* lds_cptr;
typedef short v4i16_t __attribute__((ext_vector_type(4)));
__device__ __forceinline__ void kload8(bf16x8*kf,lds_cptr kp){
  kf[0]=*(const __attribute__((address_space(3))) bf16x8*)(kp);      kf[1]=*(const __attribute__((address_space(3))) bf16x8*)(kp+512);
  kf[2]=*(const __attribute__((address_space(3))) bf16x8*)(kp+2048); kf[3]=*(const __attribute__((address_space(3))) bf16x8*)(kp+2560);
  kf[4]=*(const __attribute__((address_space(3))) bf16x8*)(kp+4096); kf[5]=*(const __attribute__((address_space(3))) bf16x8*)(kp+4608);
  kf[6]=*(const __attribute__((address_space(3))) bf16x8*)(kp+6144); kf[7]=*(const __attribute__((address_space(3))) bf16x8*)(kp+6656);
}
__device__ __forceinline__ void kload2(bf16x8*kf,lds_cptr kp,int j){ kf[2*j]=*(const __attribute__((address_space(3))) bf16x8*)(kp+j*2048); kf[2*j+1]=*(const __attribute__((address_space(3))) bf16x8*)(kp+j*2048+512); }
__device__ __forceinline__ s16x4 vtr(lds_cptr p){ return __builtin_bit_cast(s16x4,__builtin_amdgcn_ds_read_tr16_b64_v4i16((__attribute__((address_space(3))) v4i16_t*)p)); }
__device__ __forceinline__ float rowmax(const f32x16&p0,const f32x16&p1){
  float a=max3f(p0[0],p0[1],p1[0]),b=max3f(p0[2],p0[3],p1[1]);a=max3f(a,p1[2],p1[3]);
  #pragma unroll
  for(int r=4;r<16;r+=4){a=max3f(a,p0[r],p0[r+1]);b=max3f(b,p0[r+2],p0[r+3]);a=max3f(a,p1[r],p1[r+1]);b=max3f(b,p1[r+2],p1[r+3]);}
  const float m=max2f(a,b);
  auto rr=__builtin_amdgcn_permlane32_swap(__float_as_uint(m),__float_as_uint(m),false,false);
  return max2f(__uint_as_float(rr[0]),__uint_as_float(rr[1]));
}
__device__ __forceinline__ void pv(f32x16*o,int vb,bf16x8 pa0,bf16x8 pa1,bf16x8 pa2,bf16x8 pa3){
  #pragma unroll
  for(int d0=0;d0<2;++d0){s16x4 lo[4],hi[4];
    #pragma unroll
    for(int ks=0;ks<4;++ks){
      asm volatile("ds_read_b64_tr_b16 %0,%1 offset:%c2":"=&v"(lo[ks]):"v"(vb),"i"(d0*4096+ks*1024):"memory");
      asm volatile("ds_read_b64_tr_b16 %0,%1 offset:%c2":"=&v"(hi[ks]):"v"(vb),"i"(d0*4096+ks*1024+512):"memory");}
    asm volatile("s_waitcnt lgkmcnt(0)":::"memory");SBAR();
    #define PK(k) (bf16x8){lo[k][0],lo[k][1],lo[k][2],lo[k][3],hi[k][0],hi[k][1],hi[k][2],hi[k][3]}
    o[d0]=__builtin_amdgcn_mfma_f32_32x32x16_bf16(pa0,PK(0),o[d0],0,0,0);
    o[d0]=__builtin_amdgcn_mfma_f32_32x32x16_bf16(pa1,PK(1),o[d0],0,0,0);
    o[d0]=__builtin_amdgcn_mfma_f32_32x32x16_bf16(pa2,PK(2),o[d0],0,0,0);
    o[d0]=__builtin_amdgcn_mfma_f32_32x32x16_bf16(pa3,PK(3),o[d0],0,0,0);
    #undef PK
  }
}

#ifndef ATTN_STORE16
#define ATTN_STORE16(p,v) (*(u32x4*)(p)=(v))
#endif
template<int THRL,int PQ,int PKV,bool CAUSAL,bool BIAS> __device__ __forceinline__ void attn_unit(const bf16*Qu,const bf16*__restrict__ Kh,const bf16*__restrict__ Vh,bf16*Ou,const float*cs,const int NT,char*shm){
  const int tid=threadIdx.x,lane=tid&63,r32=lane&31,hi=lane>>5; const int wid=__builtin_amdgcn_readfirstlane(tid>>6);
  const bf16*Qw=Qu+(long)(wid*QBLK)*PQ;
  const unsigned lds0=(unsigned)(uintptr_t)shm;
  float*wsf=(float*)(shm+LDS_WS)+wid*64;
  const bf16*ksrc=Kh+(long)lane*PKV+wid*8;
  const bf16*vsrc=Vh+(long)(16*(wid&3)+(lane>>2))*PKV+(wid>>2)*32+(lane&3)*8;
  const unsigned kdst=lds0+LDS_K+wid*1024, vdst=lds0+LDS_V+wid*1024;
  #define DMA_K(t,slot) glds16(ksrc+(long)(t)*KVBLK*PKV,(unsigned)__builtin_amdgcn_readfirstlane(kdst+(slot)))
  #define DMA_V(t,slot) glds16(vsrc+(long)(t)*KVBLK*PKV,(unsigned)__builtin_amdgcn_readfirstlane(vdst+(slot)))
  const int vb0=(int)(lds0+LDS_V)+((lane>>4)&1)*32+(lane&3)*8+(4*hi+((lane&15)>>2))*64;
  const char*Kbase=shm+LDS_K; bf16x8 kf[8];
  const lds_cptr shm3=(lds_cptr)shm; const lds_cptr kp0=shm3+LDS_K+hi*1024+r32*16; const lds_cptr vp0=shm3+LDS_V+((lane>>4)&1)*32+(lane&3)*8+(4*hi+((lane&15)>>2))*64;
  typedef __attribute__((address_space(3))) float lds_f32; typedef __attribute__((address_space(3))) const f32x4v lds_cf4;
  lds_f32*biasw=(lds_f32*)(shm3+LDS_BIAS);
  { int tb_=tid; asm volatile("":"+v"(tb_));
    if(BIAS){ _Pragma("clang loop vectorize(disable) unroll(disable)") for(int i=tb_;i<NT*KVBLK;i+=NW*64)biasw[i]=-cs[i]; } }
  const lds_cf4*biasr=(const lds_cf4*)(shm3+LDS_BIAS)+hi;
  #define BINIT(C0,C1,t,mh) do{ if(BIAS){ _Pragma("unroll") for(int g_=0;g_<4;++g_){ const f32x4v b0_=biasr[16*(t)+2*g_], b1_=biasr[16*(t)+8+2*g_]; \
      C0[4*g_]=b0_[0]-(mh);C0[4*g_+1]=b0_[1]-(mh);C0[4*g_+2]=b0_[2]-(mh);C0[4*g_+3]=b0_[3]-(mh); C1[4*g_]=b1_[0]-(mh);C1[4*g_+1]=b1_[1]-(mh);C1[4*g_+2]=b1_[2]-(mh);C1[4*g_+3]=b1_[3]-(mh);} } \
    else { const float nm_=-(mh); _Pragma("unroll") for(int r_=0;r_<16;++r_){C0[r_]=nm_;C1[r_]=nm_;} } }while(0)
  DMA_K(0,0);DMA_V(0,0);DMA_K(1,SLOTB);
  bf16x8 qr[4];
  #pragma unroll
  for(int d0=0;d0<4;++d0)qr[d0]=*reinterpret_cast<const bf16x8*>(&Qw[(long)r32*PQ+d0*16+hi*8]);
  float mhat=0.f,l_reg=0.f;f32x16 o[2];o[0]=f32x16{};o[1]=f32x16{};
  const int qrel=wid*QBLK+r32;
  #define CMASK(P0,P1,t) do{ if(CAUSAL){int jb_=(t)-(NT-4); if(jb_>=0)cmask(P0,P1,jb_,qrel,hi);} }while(0)
  bool resc=false;
  #define START(P0,P1) do{ const float rm=rowmax(P0,P1); resc=false; \
    { const float dl=rm; mhat=fadd_s(mhat,dl); \
      _Pragma("unroll") for(int r=0;r<16;++r){P0[r]=fsub_s(P0[r],dl);P1[r]=fsub_s(P1[r],dl);} \
      } \
    _Pragma("unroll") for(int r=0;r<16;++r)P0[r]=__builtin_amdgcn_exp2f(P0[r]); }while(0)
  #define RESC() do{ if(resc){ asm volatile("s_waitcnt lgkmcnt(0)":::"memory"); \
      _Pragma("unroll") for(int d_=0;d_<2;++d_) _Pragma("unroll") for(int r=0;r<16;++r)o[d_][r]*=wsf[crow(r,hi)]; } }while(0)
  f32x16 pA0,pA1,pB0,pB1;
  int sl_prev=0,sl_cur=0,sl_next=SLOTB;
  #define ROT() do{sl_prev=sl_cur;sl_cur=sl_next;sl_next=(sl_next==(NSLOT-1)*SLOTB)?0:sl_next+SLOTB;}while(0)
  DMA_K(2,2*SLOTB);
  WAIT_BAR(3);
  BINIT(pA0,pA1,0,0.f);
  qkt(pA0,pA1,Kbase,qr,pA0,pA1,r32,hi);asm volatile("s_nop 15\n\ts_nop 7":"+v"(pA0),"+v"(pA1));CMASK(pA0,pA1,0);
  START(pA0,pA1);
  _Pragma("unroll") for(int r=0;r<16;++r)pA1[r]=__builtin_amdgcn_exp2f(pA1[r]);
  WAIT_BAR(0);
  DMA_K(3,0);DMA_V(1,SLOTB);
  ROT();
  kload8(kf,kp0+sl_cur);
  WAIT_BAR(2);
  s16x4 vlo[8],vhi[8]; u32x4 pw0,pw1,pw2,pw3;
  #define PKW(P,B) cvtpk_s(P[B],P[B+1])
  #define PAF(k) __builtin_bit_cast(bf16x8,pw##k)
  #define VFR(i) (bf16x8){vlo[i][0],vlo[i][1],vlo[i][2],vlo[i][3],vhi[i][0],vhi[i][1],vhi[i][2],vhi[i][3]}
  #define PIN(x) asm volatile("":"+v"(x))
  #define MX3(a,b,c) __builtin_fmaxf(__builtin_fmaxf((a),(b)),(c))
  #define GAPA(MF,A0,A1,A2,A3,W0,W1,PW) do{ MF; sacc+=A0; sacc+=A1; sacc+=A2; sacc+=A3; PIN(sacc); W0; W1; PIN(PW); SBAR(); }while(0)
  #define EX(v) __builtin_amdgcn_exp2f(v)
  #define GAPB(MF,X,B) do{ MF; X[B]=EX(X[B]); X[B+1]=EX(X[B+1]); X[B+2]=EX(X[B+2]); X[B+3]=EX(X[B+3]); PIN(X); SBAR(); }while(0)
  #define VRD(i) do{ vlo[i]=vtr(vp_+(((i)>>2)*4096+((i)&3)*1024)); vhi[i]=vtr(vp_+(((i)>>2)*4096+((i)&3)*1024+512)); }while(0)
  #define KRD(G,j) do{ if(G){ kload2(kf,kp0+sl_next,j); SBAR(); } }while(0)
  #define STEP(C0,C1,P0,P1,t,GK,GV,GL) do{ SBAR(); \
    BINIT(C0,C1,t,mhat); SBAR(); \
    const lds_cptr vp_=vp0+sl_prev; \
    VRD(0); SBAR(); float sacc=(P0[0]+P0[1]); \
    GAPA(C0=__builtin_amdgcn_mfma_f32_32x32x16_bf16(kf[0],qr[0],C0,0,0,0), P0[2],P0[3],P0[4],P0[5],     pw0[0]=PKW(P0,0), pw0[1]=PKW(P0,2), pw0); \
    VRD(4); SBAR(); GAPA(C1=__builtin_amdgcn_mfma_f32_32x32x16_bf16(kf[1],qr[0],C1,0,0,0), P0[6],P0[7],P0[8],P0[9],     pw0[2]=PKW(P0,4), pw0[3]=PKW(P0,6), pw0); \
    VRD(1); SBAR(); GAPA(C0=__builtin_amdgcn_mfma_f32_32x32x16_bf16(kf[2],qr[1],C0,0,0,0),   P0[10],P0[11],P0[12],P0[13], pw1[0]=PKW(P0,8), pw1[1]=PKW(P0,10), pw1); \
    VRD(5); SBAR(); GAPA(C1=__builtin_amdgcn_mfma_f32_32x32x16_bf16(kf[3],qr[1],C1,0,0,0),   P0[14],P0[15],P1[0],P1[1],   pw1[2]=PKW(P0,12),pw1[3]=PKW(P0,14), pw1); \
    VRD(2); SBAR(); GAPA(C0=__builtin_amdgcn_mfma_f32_32x32x16_bf16(kf[4],qr[2],C0,0,0,0),   P1[2],P1[3],P1[4],P1[5],     pw2[0]=PKW(P1,0), pw2[1]=PKW(P1,2), pw2); \
    VRD(6); SBAR(); GAPA(C1=__builtin_amdgcn_mfma_f32_32x32x16_bf16(kf[5],qr[2],C1,0,0,0),   P1[6],P1[7],P1[8],P1[9],     pw2[2]=PKW(P1,4), pw2[3]=PKW(P1,6), pw2); \
    VRD(3); SBAR(); GAPA(C0=__builtin_amdgcn_mfma_f32_32x32x16_bf16(kf[6],qr[3],C0,0,0,0),   P1[10],P1[11],P1[12],P1[13], pw3[0]=PKW(P1,8), pw3[1]=PKW(P1,10), pw3); \
    VRD(7); SBAR(); GAPA(C1=__builtin_amdgcn_mfma_f32_32x32x16_bf16(kf[7],qr[3],C1,0,0,0),   P1[14],P1[15],0.f,0.f,       pw3[2]=PKW(P1,12),pw3[3]=PKW(P1,14), pw3); \
    l_reg+=sacc; \
    if(GK){DMA_K((t)+3,sl_cur);} if(GV){DMA_V((t)+1,sl_next);} \
    CMASK(C0,C1,t); \
    { float a=MX3(C0[0],C0[1],C1[0]),b=MX3(C0[2],C0[3],C1[1]); a=MX3(a,C1[2],C1[3]); \
      _Pragma("unroll") for(int r=4;r<16;r+=4){a=MX3(a,C0[r],C0[r+1]);b=MX3(b,C0[r+2],C0[r+3]);a=MX3(a,C1[r],C1[r+1]);b=MX3(b,C1[r+2],C1[r+3]);} \
      float rm=__builtin_fmaxf(a,b); { auto rr=__builtin_amdgcn_permlane32_swap(__float_as_uint(rm),__float_as_uint(rm),false,false); rm=__builtin_fmaxf(__uint_as_float(rr[0]),__uint_as_float(rr[1])); } \
      resc=false; \
      if(__builtin_expect(__any(rm>(float)THRL),0)){ const float dl=__builtin_fmaxf(rm,0.f); mhat+=dl; \
        _Pragma("unroll") for(int r=0;r<16;++r){C0[r]-=dl;C1[r]-=dl;} \
        const float f=__builtin_amdgcn_exp2f(-dl); l_reg*=f; if(hi==0)wsf[r32]=f; resc=true; } } \
    SBAR(); \
    GAPB(o[0]=__builtin_amdgcn_mfma_f32_32x32x16_bf16(PAF(0),VFR(0),o[0],0,0,0), C0,0); \
    GAPB(o[1]=__builtin_amdgcn_mfma_f32_32x32x16_bf16(PAF(0),VFR(4),o[1],0,0,0), C0,4); \
    KRD(GL,0); GAPB(o[0]=__builtin_amdgcn_mfma_f32_32x32x16_bf16(PAF(1),VFR(1),o[0],0,0,0), C0,8); \
    KRD(GL,1); GAPB(o[1]=__builtin_amdgcn_mfma_f32_32x32x16_bf16(PAF(1),VFR(5),o[1],0,0,0), C0,12); \
    KRD(GL,2); GAPB(o[0]=__builtin_amdgcn_mfma_f32_32x32x16_bf16(PAF(2),VFR(2),o[0],0,0,0), C1,0); \
    KRD(GL,3); GAPB(o[1]=__builtin_amdgcn_mfma_f32_32x32x16_bf16(PAF(2),VFR(6),o[1],0,0,0), C1,4); \
    GAPB(o[0]=__builtin_amdgcn_mfma_f32_32x32x16_bf16(PAF(3),VFR(3),o[0],0,0,0), C1,8); \
    GAPB(o[1]=__builtin_amdgcn_mfma_f32_32x32x16_bf16(PAF(3),VFR(7),o[1],0,0,0), C1,12); \
    }while(0)
  int t=1;
  #undef CMASK
  #define CMASK(P0,P1,t) do{}while(0)
  for(;t+5<NT;t+=2){
    STEP(pB0,pB1,pA0,pA1,t,true,true,true);     WAIT_BAR(2); RESC(); ROT();
    STEP(pA0,pA1,pB0,pB1,t+1,true,true,true);   WAIT_BAR(2); RESC(); ROT();
  }
  #undef CMASK
  #define CMASK(P0,P1,t) do{ if(CAUSAL){int jb_=(t)-(NT-4); if(jb_>=0)cmask(P0,P1,jb_,qrel,hi);} }while(0)
  #define ENDW(tt) do{ if((tt)+3<NT){WAIT_BAR(2);} else if((tt)+2<NT){WAIT_BAR(1);} else {WAIT_BAR(0);} }while(0)
  for(;t+1<NT;t+=2){
    STEP(pB0,pB1,pA0,pA1,t,(t+3<NT),(t+1<NT),(t+1<NT));       ENDW(t);   RESC(); ROT();
    STEP(pA0,pA1,pB0,pB1,t+1,(t+4<NT),(t+2<NT),(t+2<NT));     ENDW(t+1); RESC(); ROT();
  }
  STEP(pB0,pB1,pA0,pA1,NT-1,false,false,false); RESC();
  { float sacc=pB0[0]+pB0[1]; _Pragma("unroll") for(int r=2;r<16;++r)sacc+=pB0[r]; _Pragma("unroll") for(int r=0;r<16;++r)sacc+=pB1[r]; l_reg+=sacc;
    pw0=(u32x4){PKW(pB0,0),PKW(pB0,2),PKW(pB0,4),PKW(pB0,6)};pw1=(u32x4){PKW(pB0,8),PKW(pB0,10),PKW(pB0,12),PKW(pB0,14)};pw2=(u32x4){PKW(pB1,0),PKW(pB1,2),PKW(pB1,4),PKW(pB1,6)};pw3=(u32x4){PKW(pB1,8),PKW(pB1,10),PKW(pB1,12),PKW(pB1,14)};
    SBAR(); pv(o,vb0+sl_cur,PAF(0),PAF(1),PAF(2),PAF(3)); }
  #undef PKW
  #undef PAF
  #undef VFR
  #undef PIN
  #undef MX3
  #undef GAPA
  #undef GAPB
  #undef EX
  #undef VRD
  #undef KRD
  #undef STEP
  #undef ENDW
  {auto rr=__builtin_amdgcn_permlane32_swap(__float_as_uint(l_reg),__float_as_uint(l_reg),false,false);l_reg=__uint_as_float(rr[0])+__uint_as_float(rr[1]);}
  if(hi==0)wsf[32+r32]=l_reg;asm volatile("s_waitcnt lgkmcnt(0)":::"memory");
  float rli[16];
  #pragma unroll
  for(int r=0;r<16;++r)rli[r]=__builtin_amdgcn_rcpf(wsf[32+crow(r,hi)]);
  bf16*Ow=Ou+(long)(wid*QBLK)*PQ;
  { bf16*stg=(bf16*)(shm+LDS_OST)+wid*2048;
    #pragma unroll
    for(int r=0;r<16;++r){const int orow=crow(r,hi);
      #pragma unroll
      for(int d0=0;d0<2;++d0)stg[orow*64+d0*32+r32]=__float2bfloat16(o[d0][r]*rli[r]);}
    asm volatile("s_waitcnt lgkmcnt(0)":::"memory");
    #pragma unroll
    for(int i=0;i<4;++i){const int row=i*8+(lane>>3),ch=lane&7; const u32x4 v=*(const u32x4*)(stg+row*64+ch*8); ATTN_STORE16(Ow+(long)row*PQ+ch*8,v);} }
  asm volatile("s_waitcnt lgkmcnt(0)\n\ts_barrier":::"memory");
  #undef BINIT
  #undef DMA_K
  #undef DMA_V
  #undef CMASK
  #undef START
  #undef RESC
  #undef ROT
}
constexpr int ATTN_LDS_BYTES=LDS_BYTES;
template<int THRL=8> __device__ __forceinline__ void fox_phase(char*lds,const bf16*PROJ,const float*CS,int grid,int block){
  constexpr int PQ=2816; const int vcu=(block%8)*(grid/8)+block/8;
  for(int i=0;i<6;++i){ const int p=vcu*3+(i>>1), bh=p>>2, x=p&3, qb=(i&1)?7-x:x, b=bh/12, h=bh%12;
    const bf16*rowb=PROJ+(long)b*SEQ*PQ;
    attn_unit<THRL,PQ,PQ,true,true>(rowb+(long)qb*QB*PQ+0+h*D, rowb+1024+h*D, rowb+1792+h*D, (bf16*)(rowb+(long)qb*QB*PQ+0+h*D), CS+(long)bh*SEQ, 4*qb+4, lds); }
}
template<int PQ,int THRL=8> __device__ __forceinline__ void mem_phase(char*lds,const bf16*PROJ,const bf16*MEMKV,int layer,int grid,int block){
  const int vcu=(block%8)*(grid/8)+block/8;
  for(int i=0;i<2;++i){ const int u=vcu*2+i, b=u>>5, hm=(u>>3)&3, qb=u&7;
    const bf16*qp=PROJ+((long)b*SEQ+(long)qb*QB)*PQ+768+hm*D; const bf16*kv=MEMKV+(long)b*256*1024+layer*512+hm*D;
    attn_unit<THRL,PQ,1024,false,false>(qp, kv, kv+256, (bf16*)qp, nullptr, 4, lds); }
}
#undef SBAR
#undef WAIT_BAR
}
#define XB_TMO      128
#define XB_XCNT(j)  (256  + 64 * (j))
#define XB_XSUB(j)  (1280 + 64 * (j))
#define XB_XGEN(j)  (2304 + 64 * (j))
#define XB_TOP      3328
#define XB_TOPGEN   3392
#define XCD_BAR_WORDS 3456
#define XB_SPIN_CAP (1u << 18)

__device__ __forceinline__ unsigned xb_ld(unsigned* p)              { return __hip_atomic_load(p, __ATOMIC_RELAXED, __HIP_MEMORY_SCOPE_AGENT); }
__device__ __forceinline__ unsigned xb_add(unsigned* p, unsigned v) { return __hip_atomic_fetch_add(p, v, __ATOMIC_RELAXED, __HIP_MEMORY_SCOPE_AGENT); }
__device__ __forceinline__ unsigned xb_xcc_id() { return (unsigned)__builtin_amdgcn_s_getreg((3 << 11) | 20) & 0xFu; }
#define XB_SPIN(cond, bar) do { unsigned _sp = 0; while (cond) { __builtin_amdgcn_s_sleep(1); \
    if ((++_sp & 255u) == 0u) { if (xb_ld(&(bar)[XB_TMO])) break; if (_sp > XB_SPIN_CAP) { atomicAdd(&(bar)[XB_TMO], 1u); break; } } } } while (0)

struct XcdBarrier {
    unsigned* bar; unsigned x;
    volatile LAS unsigned* st;
};

__device__ __forceinline__ XcdBarrier xcd_barrier_post(unsigned* bar, volatile LAS unsigned* st) {
    XcdBarrier b; b.bar = bar; b.x = xb_xcc_id(); b.st = st;
    if (threadIdx.x == 0) (void)xb_add(&bar[XB_XCNT(b.x)], 1u);
    return b;
}
__device__ __forceinline__ void xcd_barrier_complete(unsigned* bar, unsigned x, unsigned& nloc, unsigned& nx) {
    const unsigned G = gridDim.x * gridDim.y * gridDim.z;
    unsigned sum, cnt, mine, sp = 0u;
    for (;;) {
        sum = 0u; cnt = 0u; mine = 0u;
#pragma unroll
        for (unsigned j = 0; j < 16; ++j) { const unsigned c = xb_ld(&bar[XB_XCNT(j)]); sum += c; cnt += (c > 0u) ? 1u : 0u; mine = (j == x) ? c : mine; }
        if (sum == G) break;
        __builtin_amdgcn_s_sleep(1);
        if ((++sp & 255u) == 0u) { if (xb_ld(&bar[XB_TMO])) break; if (sp > XB_SPIN_CAP) { atomicAdd(&bar[XB_TMO], 1u); break; } }
    }
    nloc = mine > 0u ? mine : 1u; nx = cnt > 0u ? cnt : 1u;
}

__device__ __forceinline__ void xcd_barrier(const XcdBarrier& b) {
    asm volatile("s_waitcnt vmcnt(0)" ::: "memory");
    __syncthreads();
    if (threadIdx.x == 0) {
        unsigned* bar = b.bar;
        __builtin_amdgcn_s_waitcnt(0);
        unsigned nloc = b.st[0], nx = b.st[1];
        if (nloc == 0u) { xcd_barrier_complete(bar, b.x, nloc, nx); b.st[0] = nloc; b.st[1] = nx; }
        const unsigned old = xb_add(&bar[XB_XSUB(b.x)], 1u);
        const unsigned gen = old / nloc;
        if (old + 1u == (gen + 1u) * nloc) {
            __builtin_amdgcn_fence(__ATOMIC_RELEASE, "agent");
            asm volatile("s_waitcnt vmcnt(0)" ::: "memory");
            const unsigned og = xb_add(&bar[XB_TOP], 1u);
            const unsigned tg = og / nx;
            if (og + 1u == (tg + 1u) * nx) xb_add(&bar[XB_TOPGEN], 1u);
            else XB_SPIN(xb_ld(&bar[XB_TOPGEN]) == tg, bar);
            __builtin_amdgcn_fence(__ATOMIC_ACQUIRE, "agent");
            xb_add(&bar[XB_XGEN(b.x)], 1u);
            asm volatile("s_waitcnt vmcnt(0)" ::: "memory");
        } else {
            XB_SPIN(xb_ld(&bar[XB_XGEN(b.x)]) == gen, bar);
            __builtin_amdgcn_fence(__ATOMIC_ACQUIRE, "agent");
            asm volatile("s_waitcnt vmcnt(0)" ::: "memory");
        }
    }
    __syncthreads();
}

struct Args { const float* in[15]; float* out; unsigned char* ws; int ph_lo, ph_hi; };
typedef const __attribute__((address_space(4))) Args* KArgs;
#define KA_GET() ({ KArgs k_ = (KArgs)__builtin_amdgcn_kernarg_segment_ptr(); asm volatile("" : "+s"(k_)); k_; })
#define WSP(T, off) ((T*)(ka->ws + (off)))
struct Frame {
    LAS unsigned char* lds;
    int tid, lane, wave, gw;
    int G;
};
__device__ __forceinline__ float wave_sum(float v) {
#pragma unroll
    for (int o = 1; o < 64; o <<= 1) v += __shfl_xor(v, o);
    return v;
}

__device__ __forceinline__ int dst_row(int mode, int n) {
    if (mode == 0) return n;
    if (mode == 1) {
        if (n < 768) { const int h = n >> 7, d = n & 127; return C_Q + h * 128 + ((d & 63) << 1) + (d >> 6); }
        if (n < 1536) { const int m = n - 768, h = m >> 7, d = m & 127; return C_K + h * 128 + ((d & 63) << 1) + (d >> 6); }
        if (n < 2304) return C_V + (n - 1536);
        if (n < 3072) return C_G + (n - 2304);
        return C_MQ + (n - 3072);
    }
    if (n < 768) return C_Q + n;
    if (n < 1536) return C_K + (n - 768);
    if (n < 2304) return C_V + (n - 1536);
    if (n < 2316) return C_G + (n - 2304);
    return C_MQ + (n - 2316);
}
__device__ __forceinline__ void p0_transpose_item(const float* W, int K, int N, bf16* WT, int mode, int row_off, const float* gain, LAS float* scr, int item, int lane) {
    const int nblk = (N + 31) / 32, kb = item / nblk, nb = item % nblk, k0 = 64 * kb, n0 = 32 * nb;
    const int nn = n0 + (lane & 31);
#pragma unroll 8
    for (int i = 0; i < 32; ++i) { const int kk = 2 * i + (lane >> 5);
        float v = 0.f; if (nn < N) { v = W[(size_t)(k0 + kk) * N + nn]; if (gain) v *= gain[k0 + kk]; }
        scr[kk * 33 + (lane & 31)] = v; }
    LDS_WAIT(); asm volatile("" ::: "memory");
    const int c = lane & 7;
#pragma unroll
    for (int j = 0; j < 4; ++j) { const int nl = (lane >> 3) + 8 * j; const int n = n0 + nl;
        if (n < N) { const LAS float* s = scr + (8 * c) * 33 + nl;
            v4u o; o.x = pk2(s[0 * 33], s[1 * 33]); o.y = pk2(s[2 * 33], s[3 * 33]); o.z = pk2(s[4 * 33], s[5 * 33]); o.w = pk2(s[6 * 33], s[7 * 33]);
            *(GAS v4u*)(WT + (size_t)(row_off + dst_row(mode, n)) * K + k0 + 8 * c) = o; } }
    LDS_WAIT(); asm volatile("" ::: "memory");
}
__device__ __forceinline__ void rms_row_to_bf16(const float* xrow, bf16* orow, int lane) {
    const GAS f32x4* xr = (const GAS f32x4*)xrow + lane;
    f32x4 v[4]; float s = 0.f;
#pragma unroll
    for (int j = 0; j < 4; ++j) { v[j] = xr[64 * j]; s += (v[j].x * v[j].x + v[j].y * v[j].y) + (v[j].z * v[j].z + v[j].w * v[j].w); }
    const float rstd = 1.0f / sqrtf(wave_sum(s) * (1.f / DM) + EPS);
    GAS unsigned long long* o8 = (GAS unsigned long long*)orow + lane;
#pragma unroll
    for (int j = 0; j < 4; ++j) o8[64 * j] = (unsigned long long)pk2(v[j].x * rstd, v[j].y * rstd) | ((unsigned long long)pk2(v[j].z * rstd, v[j].w * rstd) << 32);
}
__device__ __forceinline__ void p0_prologue(Frame& F, KArgs ka) {
    const float *w_in_ret = ka->in[3], *w_in_fox = ka->in[4], *w_mem_kv = ka->in[6], *w_out = ka->in[7], *w_up = ka->in[8], *w_down = ka->in[9];
    const float *g_pre_mix = ka->in[10], *g_pre_mlp = ka->in[12], *g_mem = ka->in[14];
    bf16 *Win0 = WSP(bf16, WS_WIN0), *Win1 = WSP(bf16, WS_WIN1), *Wmem = WSP(bf16, WS_WMEM), *Wout = WSP(bf16, WS_WOUT), *Wup = WSP(bf16, WS_WUP), *Wdn = WSP(bf16, WS_WDN);
    LAS float* scr = (LAS float*)(F.lds + RING_OFF + F.wave * 16384);
    const int gw = F.gw, NGW = F.G * NWAVES;
    constexpr int KB = DM / 64;
    constexpr int I_IN0 = KB * (3328 / 32), I_IN1 = KB * ((2572 + 31) / 32), I_MEM = KB * (512 / 32), I_OUT = KB * (DM / 32), I_UP = KB * (FF / 32), I_DN = (FF / 64) * (DM / 32);
    constexpr int NITEMS = I_IN0 + I_IN1 + 2 * I_MEM + 2 * I_OUT + 2 * I_UP + 2 * I_DN;
    for (int it = gw; it < NITEMS; it += NGW) {
        int r = it;
        if (r < I_IN0) { p0_transpose_item(w_in_ret, DM, 3328, Win0, 1, 0, g_pre_mix, scr, r, F.lane); continue; } r -= I_IN0;
        if (r < I_IN1) { p0_transpose_item(w_in_fox, DM, 2572, Win1, 2, 0, g_pre_mix + DM, scr, r, F.lane); continue; } r -= I_IN1;
        if (r < 2 * I_MEM) { const int l = r / I_MEM; p0_transpose_item(w_mem_kv + (size_t)l * DM * 512, DM, 512, Wmem, 0, l * 512, g_mem + l * DM, scr, r % I_MEM, F.lane); continue; } r -= 2 * I_MEM;
        if (r < 2 * I_OUT) { const int l = r / I_OUT; p0_transpose_item(w_out + (size_t)l * DM * DM, DM, DM, Wout + (size_t)l * DM * DM, 0, 0, nullptr, scr, r % I_OUT, F.lane); continue; } r -= 2 * I_OUT;
        if (r < 2 * I_UP) { const int l = r / I_UP; p0_transpose_item(w_up + (size_t)l * DM * FF, DM, FF, Wup + (size_t)l * DM * FF, 0, 0, g_pre_mlp + l * DM, scr, r % I_UP, F.lane); continue; } r -= 2 * I_UP;
        { const int l = r / I_DN; p0_transpose_item(w_down + (size_t)l * DM * FF, FF, DM, Wdn + (size_t)l * DM * FF, 0, 0, nullptr, scr, r % I_DN, F.lane); }
    }
    { GAS v4u* z = (GAS v4u*)(Win1 + (size_t)(C_G + 12) * DM); const int n16 = (NP1 - C_G - 12) * DM * 2 / 16;
      for (int i = gw * 64 + F.lane; i < n16; i += NGW * 64) z[i] = (v4u){0u, 0u, 0u, 0u}; }
    for (int m = gw; m < MTOK; m += NGW) rms_row_to_bf16(ka->in[0] + (size_t)m * DM, WSP(bf16, WS_XN) + (size_t)m * DM, F.lane);
    for (int m = gw; m < MMEM; m += NGW) rms_row_to_bf16(ka->in[1] + (size_t)m * DM, WSP(bf16, WS_MEMN) + (size_t)m * DM, F.lane);
}

__device__ __forceinline__ void row_pass(Frame& F, const float* y, const float* base, const float* gain, float* xo, bf16* xn) {
    const int NGW = F.G * NWAVES;
    f32x4 g[4];
#pragma unroll
    for (int j = 0; j < 4; ++j) g[j] = ((const GAS f32x4*)gain)[F.lane + 64 * j];
    for (int m = F.gw; m < MTOK; m += NGW) {
        const GAS f32x4* yr = (const GAS f32x4*)(y + (size_t)m * DM) + F.lane; const GAS f32x4* br = (const GAS f32x4*)(base + (size_t)m * DM) + F.lane;
        f32x4 v[4], b[4]; float s = 0.f;
#pragma unroll
        for (int j = 0; j < 4; ++j) { v[j] = yr[64 * j]; b[j] = br[64 * j]; s += (v[j].x * v[j].x + v[j].y * v[j].y) + (v[j].z * v[j].z + v[j].w * v[j].w); }
        const float rstd = 1.0f / sqrtf(wave_sum(s) * (1.f / DM) + EPS);
        float s2 = 0.f;
#pragma unroll
        for (int j = 0; j < 4; ++j) { v[j] = b[j] + v[j] * rstd * g[j]; s2 += (v[j].x * v[j].x + v[j].y * v[j].y) + (v[j].z * v[j].z + v[j].w * v[j].w); }
        GAS f32x4* o = (GAS f32x4*)(xo + (size_t)m * DM) + F.lane;
#pragma unroll
        for (int j = 0; j < 4; ++j) o[64 * j] = v[j];
        if (xn) {
            const float r2 = 1.0f / sqrtf(wave_sum(s2) * (1.f / DM) + EPS);
            GAS unsigned long long* o8 = (GAS unsigned long long*)(xn + (size_t)m * DM) + F.lane;
#pragma unroll
            for (int j = 0; j < 4; ++j) o8[64 * j] = (unsigned long long)pk2(v[j].x * r2, v[j].y * r2) | ((unsigned long long)pk2(v[j].z * r2, v[j].w * r2) << 32);
        }
    }
}

__device__ __forceinline__ void naive_retention(Frame& F, KArgs ka) {
    bf16* P = WSP(bf16, WS_PROJ); constexpr int ld = NP0;
    for (int j = 0; j < 6; ++j) {
        const int bh = (F.gw >> 7) + 16 * j, tb = ((F.gw & 127) + 37 * j) & 127;
        const int b = bh / 6, h = bh % 6, t = tb * 16 + (F.lane >> 2), dvq = F.lane & 3;
        const size_t row = (size_t)b * SEQ + t;
        v4u qp[16];
        { const GAS v4u* qs = (const GAS v4u*)(P + row * ld + C_Q + h * 128);
#pragma unroll
          for (int i = 0; i < 16; ++i) qp[i] = qs[i]; }
        float o[32];
#pragma unroll
        for (int i = 0; i < 32; ++i) o[i] = 0.f;
        const float lg = __log2f(1.f - exp2f(-5.f - (float)h));
        const int tmax = tb * 16 + 15;
        for (int s = 0; s <= tmax; ++s) {
            const size_t srow = (size_t)b * SEQ + s;
            const GAS v4u* ks = (const GAS v4u*)(P + srow * ld + C_K + h * 128);
            float dot = 0.f;
#pragma unroll
            for (int i = 0; i < 16; ++i) { const v4u kk = ks[i];
                dot += bflo(qp[i].x) * bflo(kk.x) + bfhi(qp[i].x) * bfhi(kk.x) + bflo(qp[i].y) * bflo(kk.y) + bfhi(qp[i].y) * bfhi(kk.y)
                     + bflo(qp[i].z) * bflo(kk.z) + bfhi(qp[i].z) * bfhi(kk.z) + bflo(qp[i].w) * bflo(kk.w) + bfhi(qp[i].w) * bfhi(kk.w); }
            const float w = (s <= t) ? dot * exp2f((float)(t - s) * lg) : 0.f;
            const GAS v4u* vs = (const GAS v4u*)(P + srow * ld + C_V + h * 128 + dvq * 32);
#pragma unroll
            for (int i = 0; i < 4; ++i) { const v4u vv = vs[i];
                o[8 * i + 0] += w * bflo(vv.x); o[8 * i + 1] += w * bfhi(vv.x); o[8 * i + 2] += w * bflo(vv.y); o[8 * i + 3] += w * bfhi(vv.y);
                o[8 * i + 4] += w * bflo(vv.z); o[8 * i + 5] += w * bfhi(vv.z); o[8 * i + 6] += w * bflo(vv.w); o[8 * i + 7] += w * bfhi(vv.w); }
        }
        float ss = 0.f;
#pragma unroll
        for (int i = 0; i < 32; ++i) ss += o[i] * o[i];
        ss += __shfl_xor(ss, 1); ss += __shfl_xor(ss, 2);
        const float rstd = 1.0f / sqrtf(ss * (1.f / 128.f) + EPS);
        const GAS v4u* gs = (const GAS v4u*)(P + row * ld + C_G + h * 128 + dvq * 32);
        GAS v4u* os = (GAS v4u*)(P + row * ld + C_Q + h * 128 + dvq * 32);
#pragma unroll
        for (int i = 0; i < 4; ++i) { const v4u gg = gs[i]; v4u w;
            w.x = pk2(o[8 * i + 0] * rstd * bflo(gg.x), o[8 * i + 1] * rstd * bfhi(gg.x)); w.y = pk2(o[8 * i + 2] * rstd * bflo(gg.y), o[8 * i + 3] * rstd * bfhi(gg.y));
            w.z = pk2(o[8 * i + 4] * rstd * bflo(gg.z), o[8 * i + 5] * rstd * bfhi(gg.z)); w.w = pk2(o[8 * i + 6] * rstd * bflo(gg.w), o[8 * i + 7] * rstd * bfhi(gg.w));
            os[i] = w; }
    }
}
#define NAIVE_ATT_BODY(NKEYS, KPTR, VPTR, BIAS, VALID) \
    float o[64]; _Pragma("unroll") for (int i = 0; i < 64; ++i) o[i] = 0.f; \
    float mrun = -INFINITY, lrun = 0.f; \
    for (int s = 0; s < (NKEYS); ++s) { \
        const GAS v4u* ks = (const GAS v4u*)(KPTR); float dot = 0.f; \
        _Pragma("unroll") for (int i = 0; i < 8; ++i) { const v4u kk = ks[i]; \
            dot += bflo(qp[i].x) * bflo(kk.x) + bfhi(qp[i].x) * bfhi(kk.x) + bflo(qp[i].y) * bflo(kk.y) + bfhi(qp[i].y) * bfhi(kk.y) \
                 + bflo(qp[i].z) * bflo(kk.z) + bfhi(qp[i].z) * bfhi(kk.z) + bflo(qp[i].w) * bflo(kk.w) + bfhi(qp[i].w) * bfhi(kk.w); } \
        const float logit = dot + (BIAS); \
        if (VALID) { const float mn = fmaxf(mrun, logit), a = exp2f(mrun - mn), p = exp2f(logit - mn); lrun = lrun * a + p; mrun = mn; \
            const GAS v4u* vs = (const GAS v4u*)(VPTR); \
            _Pragma("unroll") for (int i = 0; i < 8; ++i) { const v4u vv = vs[i]; \
                o[8 * i + 0] = o[8 * i + 0] * a + p * bflo(vv.x); o[8 * i + 1] = o[8 * i + 1] * a + p * bfhi(vv.x); o[8 * i + 2] = o[8 * i + 2] * a + p * bflo(vv.y); o[8 * i + 3] = o[8 * i + 3] * a + p * bfhi(vv.y); \
                o[8 * i + 4] = o[8 * i + 4] * a + p * bflo(vv.z); o[8 * i + 5] = o[8 * i + 5] * a + p * bfhi(vv.z); o[8 * i + 6] = o[8 * i + 6] * a + p * bflo(vv.w); o[8 * i + 7] = o[8 * i + 7] * a + p * bfhi(vv.w); } } \
    } \
    const float rl = 1.0f / lrun;
#define NAIVE_ATT_STORE(OPTR) { GAS v4u* os = (GAS v4u*)(OPTR); \
    _Pragma("unroll") for (int i = 0; i < 8; ++i) { v4u w; w.x = pk2(o[8 * i + 0] * rl, o[8 * i + 1] * rl); w.y = pk2(o[8 * i + 2] * rl, o[8 * i + 3] * rl); \
        w.z = pk2(o[8 * i + 4] * rl, o[8 * i + 5] * rl); w.w = pk2(o[8 * i + 6] * rl, o[8 * i + 7] * rl); os[i] = w; } }

__device__ __forceinline__ void naive_mem(Frame& F, KArgs ka, int layer) {
    bf16* P = WSP(bf16, WS_PROJ); const int ld = layer ? NP1 : NP0;
    const int b = F.gw >> 7, tb = (F.gw & 127) >> 2, hm = F.gw & 3, t = tb * 64 + F.lane;
    const size_t row = (size_t)b * SEQ + t;
    v4u qp[8];
    { const GAS v4u* qs = (const GAS v4u*)(P + row * ld + C_MQ + hm * 64);
#pragma unroll
      for (int i = 0; i < 8; ++i) qp[i] = qs[i]; }
    const bf16* kv = WSP(bf16, WS_MEMKV) + (size_t)b * MEML * DM + layer * 512 + hm * 64;
    NAIVE_ATT_BODY(MEML, kv + (size_t)s * DM, kv + (size_t)s * DM + 256, 0.f, true)
    NAIVE_ATT_STORE(P + row * ld + C_MQ + hm * 64)
}
__device__ __forceinline__ void scan_phase(Frame& F, KArgs ka) {
    if (F.gw >= BATCH * 12) return;
    const int b = F.gw / 12, h = F.gw % 12;
    const float* src = WSP(float, WS_LOGF) + ((size_t)b * SEQ + F.lane * 32) * 16 + h;
    float s = 0.f;
    for (int i = 0; i < 32; ++i) s += src[(size_t)i * 16];
    float incl = s;
#pragma unroll
    for (int o = 1; o < 64; o <<= 1) { const float v = __shfl_up(incl, o); if (F.lane >= o) incl += v; }
    float run = incl - s;
    float* dst = WSP(float, WS_CS) + (size_t)(b * 12 + h) * SEQ + F.lane * 32;
    for (int i = 0; i < 32; ++i) { run += src[(size_t)i * 16]; dst[i] = run; }
}

#define RUN() (lo <= ph && ph < hi)
#define SEAM() do { if (lo <= ph && ph + 1 < hi) xcd_barrier(bar); ++ph; } while (0)
#define RELANE() do { int t_ = threadIdx.x; asm volatile("" : "+v"(t_)); F.tid = t_; F.lane = t_ & 63; F.wave = __builtin_amdgcn_readfirstlane(t_ >> 6); F.gw = blockIdx.x * NWAVES + F.wave; } while (0)
template <int layer> __device__ __forceinline__ void run_layer(Frame& F, const XcdBarrier& bar, const int lo, const int hi, int& ph, LAS unsigned char* ring, unsigned char* lds, const int G, const int c) {
        const int NP = layer ? NP1 : NP0;
        if (RUN()) {
            KArgs ka = KA_GET();
            pg8::Gemm g{WSP(bf16, WS_XN), layer ? WSP(bf16, WS_WIN1) : WSP(bf16, WS_WIN0), MTOK, NP, DM, DM}; pg8::StaticOrder S; S.init(MTOK, NP, G, c);
            pg8::EpiProj E{WSP(bf16, WS_PROJ), NP, layer, (const int*)ka->in[2], WSP(float, WS_LOGF), ka->in[5]};
            pg8::gemm_phase<pg8::EpiProj, pg8::StaticOrder, true, true>(ring, g, S, E);
            if (layer == 0) {
                pg8::Gemm g2{WSP(bf16, WS_MEMN), WSP(bf16, WS_WMEM), MMEM, DM, DM, DM}; pg8::OneUnit S2; const int idx = c - 128; S2.has = (idx >= 0 && idx < 64); S2.u0.pm = idx >> 2; S2.u0.pn = idx & 3;
                pg8::EpiBf16<0> E2{WSP(bf16, WS_MEMKV), DM};
                pg8::gemm_phase<pg8::EpiBf16<0>, pg8::OneUnit, true, true>(ring, g2, S2, E2);
            }
        }
        SEAM();
        if (RUN()) { RELANE(); if (layer == 1) scan_phase(F, KA_GET()); }
        SEAM();
        if (RUN()) { RELANE(); KArgs ka = KA_GET(); if (layer == 0) naive_retention(F, ka);
            else attn_body::fox_phase<8>((char*)lds + RING_OFF, (const attn_body::bf16*)WSP(bf16, WS_PROJ), WSP(float, WS_CS), (int)F.G, (int)blockIdx.x);
            static_assert(attn_body::ATTN_LDS_BYTES <= RING_BYTES, "attention LDS");
            attn_body::mem_phase<(layer ? NP1 : NP0), 8>((char*)lds + RING_OFF, (const attn_body::bf16*)WSP(bf16, WS_PROJ), (const attn_body::bf16*)WSP(bf16, WS_MEMKV), layer, (int)F.G, (int)blockIdx.x); }
        SEAM();
        if (RUN()) {
            KArgs ka = KA_GET();
            pg8::Gemm g{WSP(bf16, WS_PROJ), WSP(bf16, WS_WOUT) + (size_t)layer * DM * DM, MTOK, DM, DM, NP}; pg8::StaticOrder S; S.init(MTOK, DM, G, c);
            pg8::EpiF32 E{ka->out, DM};
            pg8::gemm_phase<pg8::EpiF32, pg8::StaticOrder, true, true>(ring, g, S, E);
        }
        SEAM();
        if (RUN()) { RELANE(); KArgs ka = KA_GET(); row_pass(F, ka->out, layer ? WSP(float, WS_R1) : ka->in[0], ka->in[11] + layer * DM, WSP(float, WS_R1), WSP(bf16, WS_XN)); }
        SEAM();
        if (RUN()) {
            KArgs ka = KA_GET();
            pg8::Gemm g{WSP(bf16, WS_XN), WSP(bf16, WS_WUP) + (size_t)layer * DM * FF, MTOK, FF, DM, DM}; pg8::StaticOrder S; S.init(MTOK, FF, G, c);
            pg8::EpiBf16<1> E{WSP(bf16, WS_H), FF};
            pg8::gemm_phase<pg8::EpiBf16<1>, pg8::StaticOrder, true, true>(ring, g, S, E);
        }
        SEAM();
        if (RUN()) {
            KArgs ka = KA_GET();
            pg8::Gemm g{WSP(bf16, WS_H), WSP(bf16, WS_WDN) + (size_t)layer * DM * FF, MTOK, DM, FF, FF}; pg8::StaticOrder S; S.init(MTOK, DM, G, c);
            pg8::EpiF32 E{ka->out, DM};
            pg8::gemm_phase<pg8::EpiF32, pg8::StaticOrder, true, true>(ring, g, S, E);
        }
        SEAM();
        if (RUN()) { RELANE(); KArgs ka = KA_GET(); row_pass(F, ka->out, WSP(float, WS_R1), ka->in[13] + layer * DM, layer ? ka->out : WSP(float, WS_R1), layer ? nullptr : WSP(bf16, WS_XN)); }
        SEAM();
    }
__global__ void __launch_bounds__(NWAVES * 64, 2) fwd_kernel(Args args) {
    extern __shared__ __attribute__((aligned(16))) unsigned char lds[];
    Frame F;
    F.lds = (LAS unsigned char*)lds;
    F.tid = threadIdx.x; F.lane = F.tid & 63; F.wave = __builtin_amdgcn_readfirstlane(F.tid >> 6);
    F.G = gridDim.x; F.gw = blockIdx.x * NWAVES + F.wave;
    for (int u = F.tid; u < (LDS_BYTES - LDSCTL_OFF) / 4; u += NWAVES * 64) ((LAS unsigned*)(F.lds + LDSCTL_OFF))[u] = 0u;
    __syncthreads();
    volatile LAS unsigned* MISC = (volatile LAS unsigned*)(F.lds + MISC_OFF);
    XcdBarrier bar = xcd_barrier_post((unsigned*)(args.ws + WS_CTL) + CW_BAR, MISC + 8);
    const int lo = args.ph_lo, hi = args.ph_hi;
    int ph = 0;
    LAS unsigned char* ring = F.lds + RING_OFF;
    const int G = F.G, c = (int)blockIdx.x;

    if (RUN()) { RELANE(); p0_prologue(F, KA_GET()); }
    SEAM();
    run_layer<0>(F, bar, lo, hi, ph, ring, lds, G, c);
    run_layer<1>(F, bar, lo, hi, ph, ring, lds, G, c);
#undef RUN
#undef SEAM
}

#ifndef MK_MULTI
#define MK_MULTI 0
#endif
constexpr int N_PHASES = 1 + 2 * 8;
extern "C" void kernel_launch(void* const* d_in, const int* in_sizes, int n_in, void* d_out, int out_size, void* d_ws, size_t ws_size, hipStream_t stream) {
    static int grid = 0;
    if (grid == 0) {
        if (n_in != 15 || in_sizes[0] != MTOK * DM || out_size != MTOK * DM || ws_size < WS_END) { fprintf(stderr, "kernel_launch: unexpected shapes (n_in %d, in0 %d, out %d, ws %zu); nothing launched\n", n_in, n_in > 0 ? in_sizes[0] : -1, out_size, ws_size); grid = -1; return; }
        int dev = 0, cus = 0, per_cu = 0;
        if (hipGetDevice(&dev) != hipSuccess || hipDeviceGetAttribute(&cus, hipDeviceAttributeMultiprocessorCount, dev) != hipSuccess) { grid = -1; return; }
        if (hipFuncSetAttribute((const void*)fwd_kernel, hipFuncAttributeMaxDynamicSharedMemorySize, LDS_BYTES) != hipSuccess) { fprintf(stderr, "kernel_launch: hipFuncSetAttribute failed\n"); grid = -1; return; }
        if (hipOccupancyMaxActiveBlocksPerMultiprocessor(&per_cu, (const void*)fwd_kernel, NWAVES * 64, LDS_BYTES) != hipSuccess || per_cu < 1)
            fprintf(stderr, "kernel_launch: occupancy query reports %d workgroups per CU\n", per_cu);
        (void)hipGetLastError();
        grid = cus;
    }
    if (grid < 0) return;
    if (hipMemsetAsync((char*)d_ws + WS_CTL, 0, CTL_ZERO_BYTES, stream) != hipSuccess) return;
    Args a{};
    for (int i = 0; i < 15; ++i) a.in[i] = (const float*)d_in[i];
    a.out = (float*)d_out; a.ws = (unsigned char*)d_ws;
#if MK_MULTI
    for (int p = 0; p < N_PHASES; ++p) { a.ph_lo = p; a.ph_hi = p + 1; hipLaunchKernelGGL(fwd_kernel, dim3(grid), dim3(NWAVES * 64), LDS_BYTES, stream, a); }
#else
    a.ph_lo = 0; a.ph_hi = N_PHASES;
    hipLaunchKernelGGL(fwd_kernel, dim3(grid), dim3(NWAVES * 64), LDS_BYTES, stream, a);
#endif
}
```

```cpp
#include <hip/hip_runtime.h>
#include <hip/hip_bf16.h>
#include <cmath>
#include <cstdio>
#include <cstdint>

constexpr int BATCH = 16, SEQ = 2048, DM = 1024, MTOK = BATCH * SEQ, MEML = 256, MMEM = BATCH * MEML, FF = 4096;
constexpr int NP0 = 3328, NP1 = 2816;
constexpr int C_Q = 0, C_MQ = 768, C_K = 1024, C_V = 1792, C_G = 2560;
constexpr float EPS = 1e-6f;
constexpr float LOG2E = 1.4426950408889634f;
constexpr float QSCALE = 0.125f * LOG2E;

namespace pg8 {
#define PG8_LAS __attribute__((address_space(3)))
typedef unsigned short bf16_t;
typedef short bf16x8 __attribute__((ext_vector_type(8)));
typedef float f32x4 __attribute__((ext_vector_type(4)));
typedef unsigned u32x4 __attribute__((ext_vector_type(4)));
constexpr int BM = 256, BK = 64, HALF = 128, HTB = HALF * BK * 2  , STAGE_BYTES = 8 * HTB, NXCD = 8, WGM = 8;

__host__ __device__ __forceinline__ int lds_byte(int r, int c) { const int st = (r >> 4) * 2 + (c >> 5), rr = r & 15, cc = c & 31, ob = rr * 64 + cc * 2; return st * 1024 + (ob ^ (((ob >> 9) & 1) << 5)); }
__host__ __device__ __forceinline__ void stage_rc(int b, int& R, int& C) { const int st = b / 1024, sb = b % 1024, swz = sb ^ (((sb >> 9) & 1) << 5); R = (st >> 1) * 16 + swz / 64; C = (st & 1) * 32 + (swz % 64) / 2; }
__host__ __device__ __forceinline__ int perm32(int rho) { const int n = rho >> 4, i = rho & 15; return 8 * (i >> 2) + 4 * n + (i & 3); }

struct Unit { int pm, pn; };
struct Gemm { const bf16_t* A; const bf16_t* Bt; int M, N, K, lda; };

struct StaticOrder {
    int nM, nN, nwg, G, c;
    __host__ __device__ void init(int M, int N, int G_, int c_) { nM = M / BM; nN = N / BM; nwg = nM * nN; G = G_; c = c_; }
    __host__ __device__ bool next(int i, Unit& u) const {
        const long L = (long)i * G + c; if (L >= nwg) return false;
        int wgid = (int)L; { const int q = nwg / NXCD, r = nwg % NXCD, xcd = wgid % NXCD, off = wgid / NXCD; wgid = (xcd < r ? xcd * (q + 1) : r * (q + 1) + (xcd - r) * q) + off; }
        const int nig = WGM * nN, gid = wgid / nig, fm = gid * WGM, gsz = (nM - fm) < WGM ? (nM - fm) : WGM;
        u.pm = fm + ((wgid % nig) % gsz); u.pn = (wgid % nig) / gsz; return true;
    }
    __device__ __forceinline__ void a_ready(const Unit&) const {}
    __device__ __forceinline__ void done(const Unit&) const {}
};
struct OneUnit {
    Unit u0; bool has;
    __device__ __forceinline__ bool next(int i, Unit& u) const { if (i != 0 || !has) return false; u = u0; return true; }
    __device__ __forceinline__ void a_ready(const Unit&) const {}
    __device__ __forceinline__ void done(const Unit&) const {}
};

typedef float f32x2_t __attribute__((ext_vector_type(2))); typedef __bf16 bf16x2_t __attribute__((ext_vector_type(2)));
__device__ __forceinline__ unsigned cvt_pk_bf16(float lo, float hi) { f32x2_t v = {lo, hi}; bf16x2_t b = __builtin_convertvector(v, bf16x2_t); return __builtin_bit_cast(unsigned, b); }

template <int ACT> struct EpiBf16 {
    static constexpr bool PERM = true, AFTER_DRAIN = false;
    bf16_t* O; int ldc;
    __device__ __forceinline__ void operator()(const f32x4 (&acc)[2][2][4][2], const Unit& u, int wr, int wc, int fr, int fq) const {
        const int row0 = u.pm * BM + wr * 64 + fr, col0 = u.pn * BM + wc * 32 + 8 * fq;
#pragma unroll
        for (int ai = 0; ai < 2; ++ai)
#pragma unroll
            for (int m = 0; m < 4; ++m) { bf16_t* rowp = O + (size_t)(row0 + ai * HALF + m * 16) * ldc + col0;
#pragma unroll
                for (int bj = 0; bj < 2; ++bj) { f32x4 v0 = acc[ai][bj][m][0], v1 = acc[ai][bj][m][1];
                    if (ACT == 1) {
#pragma unroll
                        for (int e = 0; e < 4; ++e) { const float a = fmaxf(v0[e], 0.f), b = fmaxf(v1[e], 0.f); v0[e] = a * a; v1[e] = b * b; } }
                    u32x4 w; w.x = cvt_pk_bf16(v0[0], v0[1]); w.y = cvt_pk_bf16(v0[2], v0[3]); w.z = cvt_pk_bf16(v1[0], v1[1]); w.w = cvt_pk_bf16(v1[2], v1[3]);
                    *(u32x4*)(rowp + bj * HALF) = w; } }
    }
};
struct EpiF32 {
    static constexpr bool PERM = false, AFTER_DRAIN = false;
    float* O; int ldc;
    __device__ __forceinline__ void operator()(const f32x4 (&acc)[2][2][4][2], const Unit& u, int wr, int wc, int fr, int fq) const {
        const int row0 = u.pm * BM + wr * 64 + fr, col0 = u.pn * BM + wc * 32 + 4 * fq;
#pragma unroll
        for (int ai = 0; ai < 2; ++ai)
#pragma unroll
            for (int m = 0; m < 4; ++m) { float* rowp = O + (size_t)(row0 + ai * HALF + m * 16) * ldc + col0;
#pragma unroll
                for (int bj = 0; bj < 2; ++bj)
#pragma unroll
                    for (int n = 0; n < 2; ++n) *(f32x4*)(rowp + bj * HALF + n * 16) = acc[ai][bj][m][n]; }
    }
};
struct EpiProj {
    static constexpr bool PERM = true, AFTER_DRAIN = false;
    bf16_t* O; int ldc; int layer; const int* pos; float* logf; const float* bfg;
    __device__ __forceinline__ void operator()(const f32x4 (&acc)[2][2][4][2], const Unit& u, int wr, int wc, int fr, int fq) const {
        const int row0 = u.pm * BM + wr * 64 + fr, cw = wc * 32 + 8 * fq, col0 = u.pn * BM + cw;
        int mode; float sc = 1.f;
        if (layer == 0) { if (u.pn < 3) mode = 1; else if (u.pn == 3) { mode = 0; sc = QSCALE; } else if (u.pn < 7) { mode = 1; sc = 0.08838834764831845f; } else if (u.pn < 10) mode = 0; else mode = 4; }
        else { if (u.pn < 4) { mode = 0; sc = QSCALE; } else if (u.pn < 10) mode = 0; else mode = 5; }
        if (mode == 5) {
            if (wc == 0 && fq < 2) {
#pragma unroll
                for (int ai = 0; ai < 2; ++ai)
#pragma unroll
                    for (int m = 0; m < 4; ++m) { const int row = row0 + ai * HALF + m * 16;
#pragma unroll
                        for (int n = 0; n < 2; ++n)
#pragma unroll
                            for (int e = 0; e < 4; ++e) { const int c = 8 * fq + 4 * n + e;
                                if (c < 12) { const float z = acc[ai][0][m][n][e] + bfg[c]; const float az = fabsf(z);
                                    logf[(size_t)row * 16 + c] = fminf(z, 0.f) * LOG2E - __log2f(1.f + exp2f(-az * LOG2E)); } } }
            }
            return;
        }
        float invf[4];
        if (mode == 1) {
#pragma unroll
            for (int p = 0; p < 4; ++p) invf[p] = exp2f(-(float)((cw >> 1) + p) * (13.287712379549449f / 64.f)) * 0.15915494309189535f;
        }
#pragma unroll
        for (int ai = 0; ai < 2; ++ai)
#pragma unroll
            for (int m = 0; m < 4; ++m) { const int row = row0 + ai * HALF + m * 16; bf16_t* rowp = O + (size_t)row * ldc + col0;
                float cs[4], sn[4];
                if (mode == 1) { const float ps = (float)pos[row];
#pragma unroll
                    for (int p = 0; p < 4; ++p) { float rev = ps * invf[p]; rev = rev - floorf(rev); sn[p] = __builtin_amdgcn_sinf(rev); cs[p] = __builtin_amdgcn_cosf(rev); } }
#pragma unroll
                for (int bj = 0; bj < 2; ++bj) { f32x4 v0 = acc[ai][bj][m][0], v1 = acc[ai][bj][m][1];
                    if (mode == 1) {
                        const float a0 = v0[0] * cs[0] - v0[1] * sn[0], b0 = v0[0] * sn[0] + v0[1] * cs[0];
                        const float a1 = v0[2] * cs[1] - v0[3] * sn[1], b1 = v0[2] * sn[1] + v0[3] * cs[1];
                        const float a2 = v1[0] * cs[2] - v1[1] * sn[2], b2 = v1[0] * sn[2] + v1[1] * cs[2];
                        const float a3 = v1[2] * cs[3] - v1[3] * sn[3], b3 = v1[2] * sn[3] + v1[3] * cs[3];
                        v0 = (f32x4){a0, b0, a1, b1}; v1 = (f32x4){a2, b2, a3, b3};
                    } else if (mode == 4) {
#pragma unroll
                        for (int e = 0; e < 4; ++e) { v0[e] = v0[e] / (1.f + exp2f(-v0[e] * LOG2E)); v1[e] = v1[e] / (1.f + exp2f(-v1[e] * LOG2E)); }
                    }
                    v0 = v0 * sc; v1 = v1 * sc;
                    u32x4 w; w.x = cvt_pk_bf16(v0[0], v0[1]); w.y = cvt_pk_bf16(v0[2], v0[3]); w.z = cvt_pk_bf16(v1[0], v1[1]); w.w = cvt_pk_bf16(v1[2], v1[3]);
                    *(u32x4*)(rowp + bj * HALF) = w; } }
    }
};

template <class Epi, class Sched, bool ALIGN_EPI = false, bool SP2 = false>
__device__ __forceinline__ void gemm_phase(PG8_LAS unsigned char* lds, const Gemm g, const Sched& S, const Epi& E) {
    int tid_ = threadIdx.x; asm volatile("" : "+v"(tid_));
    const int tid = tid_, wid = __builtin_amdgcn_readfirstlane(tid >> 6), lane = tid & 63, wr = wid >> 2, wc = wid & 3, fr = lane & 15, fq = lane >> 4;
    const int K = g.K, nt = K / BK;
    unsigned voffA[2], voffB[2];
#pragma unroll
    for (int i = 0; i < 2; ++i) { int R, C; stage_rc(tid * 16 + i * 8192, R, C); const int Rb = Epi::PERM ? ((R & ~31) + perm32(R & 31)) : R;
        voffA[i] = (unsigned)(R * g.lda + C) * 2u; voffB[i] = (unsigned)(Rb * K + C) * 2u; }
    const size_t kstep = (size_t)(BK * 2);
    const size_t hstepA = (size_t)HALF * g.lda * 2, hstepB = (size_t)HALF * K * 2;
    const size_t tstepA = 2 * hstepA, tstepB = 2 * hstepB;
    const unsigned ldsw = (unsigned)wid * 1024u;
    const int aoff = lds_byte(wr * 64 + fr, fq * 8), boff = lds_byte(wc * 32 + fr, fq * 8);
#define PG8_SA(b, h) (((b) * 2 + (h)) * HTB)
#define PG8_SB(b, h) ((4 + (b) * 2 + (h)) * HTB)
#define PG8_STAGE(bufoff, gbase, voff) do { _Pragma("unroll") for (int _i = 0; _i < 2; ++_i) \
        __builtin_amdgcn_global_load_lds((const unsigned*)((const char*)(gbase) + (voff)[_i]), (PG8_LAS unsigned*)(lds + (bufoff) + ldsw + _i * 8192), 16, 0, 0); } while (0)
#define PG8_LDA(dst, b, h) do { _Pragma("unroll") for (int m = 0; m < 4; ++m) _Pragma("unroll") for (int k = 0; k < 2; ++k) dst[m][k] = *(const PG8_LAS bf16x8*)(lds + PG8_SA(b, h) + aoff + m * 2048 + k * 1024); } while (0)
#define PG8_LDB(dst, b, h) do { _Pragma("unroll") for (int n = 0; n < 2; ++n) _Pragma("unroll") for (int k = 0; k < 2; ++k) dst[n][k] = *(const PG8_LAS bf16x8*)(lds + PG8_SB(b, h) + boff + n * 2048 + k * 1024); } while (0)
#define PG8_MMA(ai, bj, At, Bt) do { __builtin_amdgcn_s_setprio(1); _Pragma("unroll") for (int m = 0; m < 4; ++m) _Pragma("unroll") for (int n = 0; n < 2; ++n) _Pragma("unroll") for (int k = 0; k < 2; ++k) \
        acc[ai][bj][m][n] = __builtin_amdgcn_mfma_f32_16x16x32_bf16(Bt[n][k], At[m][k], acc[ai][bj][m][n], 0, 0, 0); __builtin_amdgcn_s_setprio(0); } while (0)
#define PG8_WAIT_V(n) asm volatile("s_waitcnt vmcnt(" #n ")" ::: "memory")
#define PG8_WAIT_L(n) asm volatile("s_waitcnt lgkmcnt(" #n ")" ::: "memory")
#define PG8_BAR __builtin_amdgcn_s_barrier()
#define PG8_SCHED __builtin_amdgcn_sched_barrier(0)
    Unit cur, nxt; int ui = 0;
    if (!S.next(0, cur)) return;
    f32x4 acc[2][2][4][2];
#pragma unroll
    for (int a = 0; a < 2; ++a)
#pragma unroll
        for (int b = 0; b < 2; ++b)
#pragma unroll
            for (int m = 0; m < 4; ++m)
#pragma unroll
                for (int n = 0; n < 2; ++n) acc[a][b][m][n] = (f32x4){0.f, 0.f, 0.f, 0.f};
    bf16x8 At[4][2], B0[2][2], B1[2][2];
    const char* cA = (const char*)g.A + (size_t)cur.pm * tstepA; const char* cB = (const char*)g.Bt + (size_t)cur.pn * tstepB;
    S.a_ready(cur);
    if constexpr (SP2) {
        PG8_STAGE(PG8_SB(0, 0), cB, voffB); PG8_STAGE(PG8_SB(0, 1), cB + hstepB, voffB); PG8_STAGE(PG8_SA(0, 0), cA, voffA); PG8_STAGE(PG8_SA(0, 1), cA + hstepA, voffA);
        if (wr == 1) PG8_BAR;
        PG8_WAIT_V(2); PG8_BAR;
        PG8_STAGE(PG8_SB(1, 0), cB + kstep, voffB); PG8_STAGE(PG8_SA(1, 0), cA + kstep, voffA); PG8_STAGE(PG8_SB(1, 1), cB + hstepB + kstep, voffB);
        PG8_WAIT_V(6); PG8_BAR;
    } else {
        PG8_STAGE(PG8_SB(0, 0), cB, voffB); PG8_STAGE(PG8_SA(0, 0), cA, voffA); PG8_STAGE(PG8_SB(0, 1), cB + hstepB, voffB); PG8_STAGE(PG8_SA(0, 1), cA + hstepA, voffA);
        if (wr == 1) PG8_BAR;
        PG8_WAIT_V(4); PG8_BAR;
        PG8_STAGE(PG8_SB(1, 0), cB + kstep, voffB); PG8_STAGE(PG8_SA(1, 0), cA + kstep, voffA); PG8_STAGE(PG8_SB(1, 1), cB + hstepB + kstep, voffB);
        PG8_WAIT_V(6); PG8_BAR;
    }
    for (;;) {
        const bool has_next = S.next(ui + 1, nxt);
        const char* nA = has_next ? (const char*)g.A + (size_t)nxt.pm * tstepA : cA; const char* nB = has_next ? (const char*)g.Bt + (size_t)nxt.pn * tstepB : cB;
        for (int t = 0; t < nt; t += 2) {
            const bool last = (t == nt - 2);
            const char* a1 = cA + (size_t)(t + 1) * kstep;
            const char* a2 = last ? nA : cA + (size_t)(t + 2) * kstep; const char* b2 = last ? nB : cB + (size_t)(t + 2) * kstep;
            const char* a3 = a2 + kstep; const char* b3 = b2 + kstep;
            if (last && has_next) S.a_ready(nxt);
            if constexpr (SP2) {
            PG8_LDB(B0, 0, 0); PG8_LDB(B1, 0, 1); PG8_SCHED; PG8_LDA(At, 0, 0); PG8_STAGE(PG8_SA(1, 1), a1 + hstepA, voffA);
            PG8_WAIT_V(8); PG8_WAIT_L(0); PG8_BAR; PG8_MMA(0, 0, At, B0); PG8_MMA(0, 1, At, B1); PG8_BAR; PG8_SCHED;
            PG8_LDA(At, 0, 1); PG8_STAGE(PG8_SB(0, 0), b2, voffB); PG8_STAGE(PG8_SB(0, 1), b2 + hstepB, voffB); PG8_STAGE(PG8_SA(0, 0), a2, voffA);
            PG8_WAIT_V(8); PG8_WAIT_L(0); PG8_BAR; PG8_MMA(1, 0, At, B0); PG8_MMA(1, 1, At, B1); PG8_BAR; PG8_SCHED;
            PG8_LDB(B0, 1, 0); PG8_LDB(B1, 1, 1); PG8_SCHED; PG8_LDA(At, 1, 0); PG8_STAGE(PG8_SA(0, 1), a2 + hstepA, voffA);
            PG8_WAIT_V(8); PG8_WAIT_L(0); PG8_BAR; PG8_MMA(0, 0, At, B0); PG8_MMA(0, 1, At, B1); PG8_BAR; PG8_SCHED;
            PG8_LDA(At, 1, 1); PG8_STAGE(PG8_SB(1, 0), b3, voffB); PG8_STAGE(PG8_SB(1, 1), b3 + hstepB, voffB); PG8_STAGE(PG8_SA(1, 0), a3, voffA);
            PG8_WAIT_V(8); PG8_WAIT_L(0); PG8_BAR; PG8_MMA(1, 0, At, B0); PG8_MMA(1, 1, At, B1); PG8_BAR; PG8_SCHED;
            } else {
            PG8_LDB(B0, 0, 0); PG8_SCHED; PG8_LDA(At, 0, 0); PG8_STAGE(PG8_SA(1, 1), a1 + hstepA, voffA);
            PG8_WAIT_L(8); PG8_BAR; PG8_WAIT_L(0); PG8_MMA(0, 0, At, B0); PG8_BAR; PG8_SCHED;
            PG8_LDB(B1, 0, 1); PG8_STAGE(PG8_SB(0, 0), b2, voffB);
            PG8_BAR; PG8_WAIT_L(0); PG8_MMA(0, 1, At, B1); PG8_BAR;
            PG8_LDA(At, 0, 1); PG8_STAGE(PG8_SA(0, 0), a2, voffA);
            PG8_BAR; PG8_WAIT_L(0); PG8_MMA(1, 0, At, B0); PG8_BAR; PG8_SCHED;
            PG8_STAGE(PG8_SB(0, 1), b2 + hstepB, voffB);
            PG8_WAIT_V(6); PG8_BAR; PG8_MMA(1, 1, At, B1); PG8_BAR;
            PG8_LDB(B0, 1, 0); PG8_SCHED; PG8_LDA(At, 1, 0); PG8_STAGE(PG8_SA(0, 1), a2 + hstepA, voffA);
            PG8_WAIT_L(8); PG8_BAR; PG8_WAIT_L(0); PG8_MMA(0, 0, At, B0); PG8_BAR; PG8_SCHED;
            PG8_LDB(B1, 1, 1); PG8_STAGE(PG8_SB(1, 0), b3, voffB);
            PG8_BAR; PG8_WAIT_L(0); PG8_MMA(0, 1, At, B1); PG8_BAR;
            PG8_LDA(At, 1, 1); PG8_STAGE(PG8_SA(1, 0), a3, voffA);
            PG8_BAR; PG8_WAIT_L(0); PG8_MMA(1, 0, At, B0); PG8_BAR; PG8_SCHED;
            PG8_STAGE(PG8_SB(1, 1), b3 + hstepB, voffB);
            PG8_WAIT_V(6); PG8_BAR; PG8_MMA(1, 1, At, B1); PG8_BAR;
            }
        }
        if constexpr (ALIGN_EPI) { if (wr == 0) PG8_BAR; }
        if constexpr (!Epi::AFTER_DRAIN) { E(acc, cur, wr, wc, fr, fq); S.done(cur); }
        if (!has_next) break;
#pragma unroll
        for (int a = 0; a < 2; ++a)
#pragma unroll
            for (int b = 0; b < 2; ++b)
#pragma unroll
                for (int m = 0; m < 4; ++m)
#pragma unroll
                    for (int n = 0; n < 2; ++n) acc[a][b][m][n] = (f32x4){0.f, 0.f, 0.f, 0.f};
        cur = nxt; cA = nA; cB = nB; ++ui;
        if constexpr (ALIGN_EPI) { if (wr == 1) PG8_BAR; }
    }
    PG8_WAIT_V(0);
    if constexpr (!ALIGN_EPI) { if (wr == 0) PG8_BAR; }
    PG8_BAR;
    if constexpr (Epi::AFTER_DRAIN) { E.fused(acc, cur, wr, wc, fr, fq, lds, wid, lane); S.done(cur); }
#undef PG8_SA
#undef PG8_SB
#undef PG8_STAGE
#undef PG8_LDA
#undef PG8_LDB
#undef PG8_MMA
#undef PG8_WAIT_V
#undef PG8_WAIT_L
#undef PG8_BAR
#undef PG8_SCHED
}
}

constexpr size_t MiB = 1u << 20;
constexpr size_t WS_CTL = 0, CTL_ZERO_BYTES = 64 * 1024;
constexpr size_t WS_WIN0 = 1 * MiB;
constexpr size_t WS_WIN1 = WS_WIN0 + (size_t)NP0 * DM * 2;
constexpr size_t WS_WMEM = 13 * MiB;
constexpr size_t WS_WOUT = 15 * MiB;
constexpr size_t WS_WUP = 19 * MiB;
constexpr size_t WS_WDN = 35 * MiB;
constexpr size_t WS_MEMKV = 51 * MiB;
constexpr size_t WS_LOGF = 59 * MiB;
constexpr size_t WS_CS = 61 * MiB;
constexpr size_t WS_XN = 64 * MiB;
constexpr size_t WS_R1 = 128 * MiB;
constexpr size_t WS_H = 256 * MiB;
constexpr size_t WS_PROJ = 256 * MiB;
constexpr size_t WS_MEMN = 464 * MiB;
constexpr size_t WS_END = 512 * MiB;
static_assert(WS_WIN1 + (size_t)NP1 * DM * 2 <= WS_WMEM && WS_PROJ + (size_t)MTOK * NP0 * 2 <= WS_MEMN, "d_ws map");
constexpr int CW_BAR = 4096;

constexpr int RING_OFF = 0, RING_BYTES = 131072;
constexpr int LDSCTL_OFF = RING_BYTES, MISC_OFF = LDSCTL_OFF + 320;
constexpr int LDS_BYTES = 147456;
constexpr int NWAVES = 8;

#define GAS __attribute__((address_space(1)))
#define LAS __attribute__((address_space(3)))
typedef unsigned short bf16;
typedef unsigned v4u __attribute__((ext_vector_type(4)));
typedef float f32x4 __attribute__((ext_vector_type(4)));
typedef GAS unsigned gu32;
#define LDS_WAIT() asm volatile("s_waitcnt lgkmcnt(0)" ::: "memory")
#define VM_WAIT() asm volatile("s_waitcnt vmcnt(0)" ::: "memory")
__device__ __forceinline__ unsigned f2bf(float f) { unsigned u = __builtin_bit_cast(unsigned, f); return (u + 0x7fffu + ((u >> 16) & 1u)) >> 16; }
__device__ __forceinline__ unsigned pk2(float lo, float hi) { return f2bf(lo) | (f2bf(hi) << 16); }
__device__ __forceinline__ float bflo(unsigned u) { return __builtin_bit_cast(float, u << 16); }
__device__ __forceinline__ float bfhi(unsigned u) { return __builtin_bit_cast(float, u & 0xffff0000u); }

namespace attn_body {
using bf16=__hip_bfloat16;
using bf16x8=__attribute__((ext_vector_type(8)))short;
using s16x4=__attribute__((ext_vector_type(4)))short;
using f32x16=__attribute__((ext_vector_type(16)))float;
using u32x4=__attribute__((ext_vector_type(4)))unsigned;
using f32x4v=__attribute__((ext_vector_type(4)))float;
constexpr int BATCH=16,NHEAD=12,SEQ=2048,D=64,DM=2816;
constexpr int NW=8,QBLK=32,QB=QBLK*NW,KVBLK=64,NQB=SEQ/QB;
constexpr int ATTN_PITCH=DM, ATTN_UNIT_ROWS=QB;
__device__ __forceinline__ int crow(int r,int hi){return (r&3)+8*(r>>2)+4*hi;}
#define SBAR() __builtin_amdgcn_sched_barrier(0)
__device__ __forceinline__ void cmask(f32x16&p0,f32x16&p1,int jb,int qrel,int hi){
  const float NEG=-INFINITY; int kb=64*jb+4*hi;
  #pragma unroll
  for(int r=0;r<16;++r){int kv=kb+(r&3)+8*(r>>2); if(kv>qrel)p0[r]=NEG; if(kv+32>qrel)p1[r]=NEG;}
}

constexpr int NSLOT=3, SLOTB=8192;
constexpr int LDS_K=0, LDS_V=NSLOT*SLOTB, LDS_WS=2*NSLOT*SLOTB, LDS_OST=LDS_WS+NW*64*4, LDS_BIAS=LDS_OST+NW*4096, LDS_BYTES=LDS_BIAS+SEQ*4;
constexpr float C2=0.125f*1.4426950408889634f;
__device__ __forceinline__ void glds16(const void*gsrc,unsigned lds_dst){unsigned keep;
  asm volatile("s_mov_b32 %0, m0\n\ts_mov_b32 m0, %2\n\ts_nop 0\n\tglobal_load_lds_dwordx4 %1, off\n\ts_mov_b32 m0, %0":"=&s"(keep):"v"(gsrc),"s"(lds_dst):"memory");}
__device__ __forceinline__ float max3f(float a,float b,float c){float r;asm("v_max3_f32 %0, %1, %2, %3":"=v"(r):"v"(a),"v"(b),"v"(c));return r;}
__device__ __forceinline__ float max2f(float a,float b){float r;asm("v_max_f32_e32 %0, %1, %2":"=v"(r):"v"(a),"v"(b));return r;}
__device__ __forceinline__ float fadd_s(float a,float b){float r;asm("v_add_f32_e32 %0, %1, %2":"=v"(r):"v"(a),"v"(b));return r;}
__device__ __forceinline__ float fsub_s(float a,float b){float r;asm("v_sub_f32_e32 %0, %1, %2":"=v"(r):"v"(a),"v"(b));return r;}
typedef float f32x2_t __attribute__((ext_vector_type(2))); typedef __bf16 bf16x2_t __attribute__((ext_vector_type(2)));
__device__ __forceinline__ unsigned cvtpk_s(float lo,float hi){f32x2_t v={lo,hi};bf16x2_t b=__builtin_convertvector(v,bf16x2_t);return __builtin_bit_cast(unsigned,b);}
#define WAIT_BAR(N) asm volatile("s_waitcnt vmcnt(" #N ") lgkmcnt(0)\n\ts_barrier":::"memory")

__device__ __forceinline__ void qkt(f32x16&p0,f32x16&p1,const char*Kslot,const bf16x8*qr,const f32x16&c0i,const f32x16&c1i,int r32,int hi){
  const char*kb=Kslot+hi*1024+r32*16;
  #pragma unroll
  for(int d0=0;d0<4;++d0){
    const bf16x8 b0=*reinterpret_cast<const bf16x8*>(kb+d0*2048);
    const bf16x8 b1=*reinterpret_cast<const bf16x8*>(kb+d0*2048+512);
    if(d0==0){p0=__builtin_amdgcn_mfma_f32_32x32x16_bf16(b0,qr[0],c0i,0,0,0);p1=__builtin_amdgcn_mfma_f32_32x32x16_bf16(b1,qr[0],c1i,0,0,0);}
    else{p0=__builtin_amdgcn_mfma_f32_32x32x16_bf16(b0,qr[d0],p0,0,0,0);p1=__builtin_amdgcn_mfma_f32_32x32x16_bf16(b1,qr[d0],p1,0,0,0);}}
}
typedef __attribute__((address_space(3))) const char* lds_cptr;
typedef short v4i16_t __attribute__((ext_vector_type(4)));
__device__ __forceinline__ void kload8(bf16x8*kf,lds_cptr kp){
  kf[0]=*(const __attribute__((address_space(3))) bf16x8*)(kp);      kf[1]=*(const __attribute__((address_space(3))) bf16x8*)(kp+512);
  kf[2]=*(const __attribute__((address_space(3))) bf16x8*)(kp+2048); kf[3]=*(const __attribute__((address_space(3))) bf16x8*)(kp+2560);
  kf[4]=*(const __attribute__((address_space(3))) bf16x8*)(kp+4096); kf[5]=*(const __attribute__((address_space(3))) bf16x8*)(kp+4608);
  kf[6]=*(const __attribute__((address_space(3))) bf16x8*)(kp+6144); kf[7]=*(const __attribute__((address_space(3))) bf16x8*)(kp+6656);
}
__device__ __forceinline__ void kload2(bf16x8*kf,lds_cptr kp,int j){ kf[2*j]=*(const __attribute__((address_space(3))) bf16x8*)(kp+j*2048); kf[2*j+1]=*(const __attribute__((address_space(3))) bf16x8*)(kp+j*2048+512); }
__device__ __forceinline__ s16x4 vtr(lds_cptr p){ return __builtin_bit_cast(s16x4,__builtin_amdgcn_ds_read_tr16_b64_v4i16((__attribute__((address_space(3))) v4i16_t*)p)); }
__device__ __forceinline__ float rowmax(const f32x16&p0,const f32x16&p1){
  float a=max3f(p0[0],p0[1],p1[0]),b=max3f(p0[2],p0[3],p1[1]);a=max3f(a,p1[2],p1[3]);
  #pragma unroll
  for(int r=4;r<16;r+=4){a=max3f(a,p0[r],p0[r+1]);b=max3f(b,p0[r+2],p0[r+3]);a=max3f(a,p1[r],p1[r+1]);b=max3f(b,p1[r+2],p1[r+3]);}
  const float m=max2f(a,b);
  auto rr=__builtin_amdgcn_permlane32_swap(__float_as_uint(m),__float_as_uint(m),false,false);
  return max2f(__uint_as_float(rr[0]),__uint_as_float(rr[1]));
}
__device__ __forceinline__ void pv(f32x16*o,int vb,bf16x8 pa0,bf16x8 pa1,bf16x8 pa2,bf16x8 pa3){
  #pragma unroll
  for(int d0=0;d0<2;++d0){s16x4 lo[4],hi[4];
    #pragma unroll
    for(int ks=0;ks<4;++ks){
      asm volatile("ds_read_b64_tr_b16 %0,%1 offset:%c2":"=&v"(lo[ks]):"v"(vb),"i"(d0*4096+ks*1024):"memory");
      asm volatile("ds_read_b64_tr_b16 %0,%1 offset:%c2":"=&v"(hi[ks]):"v"(vb),"i"(d0*4096+ks*1024+512):"memory");}
    asm volatile("s_waitcnt lgkmcnt(0)":::"memory");SBAR();
    #define PK(k) (bf16x8){lo[k][0],lo[k][1],lo[k][2],lo[k][3],hi[k][0],hi[k][1],hi[k][2],hi[k][3]}
    o[d0]=__builtin_amdgcn_mfma_f32_32x32x16_bf16(pa0,PK(0),o[d0],0,0,0);
    o[d0]=__builtin_amdgcn_mfma_f32_32x32x16_bf16(pa1,PK(1),o[d0],0,0,0);
    o[d0]=__builtin_amdgcn_mfma_f32_32x32x16_bf16(pa2,PK(2),o[d0],0,0,0);
    o[d0]=__builtin_amdgcn_mfma_f32_32x32x16_bf16(pa3,PK(3),o[d0],0,0,0);
    #undef PK
  }
}

#ifndef ATTN_STORE16
#define ATTN_STORE16(p,v) (*(u32x4*)(p)=(v))
#endif
template<int THRL,int PQ,int PKV,bool CAUSAL,bool BIAS> __device__ __forceinline__ void attn_unit(const bf16*Qu,const bf16*__restrict__ Kh,const bf16*__restrict__ Vh,bf16*Ou,const float*cs,const int NT,char*shm){
  const int tid=threadIdx.x,lane=tid&63,r32=lane&31,hi=lane>>5; const int wid=__builtin_amdgcn_readfirstlane(tid>>6);
  const bf16*Qw=Qu+(long)(wid*QBLK)*PQ;
  const unsigned lds0=(unsigned)(uintptr_t)shm;
  float*wsf=(float*)(shm+LDS_WS)+wid*64;
  const bf16*ksrc=Kh+(long)lane*PKV+wid*8;
  const bf16*vsrc=Vh+(long)(16*(wid&3)+(lane>>2))*PKV+(wid>>2)*32+(lane&3)*8;
  const unsigned kdst=lds0+LDS_K+wid*1024, vdst=lds0+LDS_V+wid*1024;
  #define DMA_K(t,slot) glds16(ksrc+(long)(t)*KVBLK*PKV,(unsigned)__builtin_amdgcn_readfirstlane(kdst+(slot)))
  #define DMA_V(t,slot) glds16(vsrc+(long)(t)*KVBLK*PKV,(unsigned)__builtin_amdgcn_readfirstlane(vdst+(slot)))
  const int vb0=(int)(lds0+LDS_V)+((lane>>4)&1)*32+(lane&3)*8+(4*hi+((lane&15)>>2))*64;
  const char*Kbase=shm+LDS_K; bf16x8 kf[8];
  const lds_cptr shm3=(lds_cptr)shm; const lds_cptr kp0=shm3+LDS_K+hi*1024+r32*16; const lds_cptr vp0=shm3+LDS_V+((lane>>4)&1)*32+(lane&3)*8+(4*hi+((lane&15)>>2))*64;
  typedef __attribute__((address_space(3))) float lds_f32; typedef __attribute__((address_space(3))) const f32x4v lds_cf4;
  lds_f32*biasw=(lds_f32*)(shm3+LDS_BIAS);
  { int tb_=tid; asm volatile("":"+v"(tb_));
    if(BIAS){ _Pragma("clang loop vectorize(disable) unroll(disable)") for(int i=tb_;i<NT*KVBLK;i+=NW*64)biasw[i]=-cs[i]; } }
  const lds_cf4*biasr=(const lds_cf4*)(shm3+LDS_BIAS)+hi;
  #define BINIT(C0,C1,t,mh) do{ if(BIAS){ _Pragma("unroll") for(int g_=0;g_<4;++g_){ const f32x4v b0_=biasr[16*(t)+2*g_], b1_=biasr[16*(t)+8+2*g_]; \
      C0[4*g_]=b0_[0]-(mh);C0[4*g_+1]=b0_[1]-(mh);C0[4*g_+2]=b0_[2]-(mh);C0[4*g_+3]=b0_[3]-(mh); C1[4*g_]=b1_[0]-(mh);C1[4*g_+1]=b1_[1]-(mh);C1[4*g_+2]=b1_[2]-(mh);C1[4*g_+3]=b1_[3]-(mh);} } \
    else { const float nm_=-(mh); _Pragma("unroll") for(int r_=0;r_<16;++r_){C0[r_]=nm_;C1[r_]=nm_;} } }while(0)
  DMA_K(0,0);DMA_V(0,0);DMA_K(1,SLOTB);
  bf16x8 qr[4];
  #pragma unroll
  for(int d0=0;d0<4;++d0)qr[d0]=*reinterpret_cast<const bf16x8*>(&Qw[(long)r32*PQ+d0*16+hi*8]);
  float mhat=0.f,l_reg=0.f;f32x16 o[2];o[0]=f32x16{};o[1]=f32x16{};
  const int qrel=wid*QBLK+r32;
  #define CMASK(P0,P1,t) do{ if(CAUSAL){int jb_=(t)-(NT-4); if(jb_>=0)cmask(P0,P1,jb_,qrel,hi);} }while(0)
  bool resc=false;
  #define START(P0,P1) do{ const float rm=rowmax(P0,P1); resc=false; \
    { const float dl=rm; mhat=fadd_s(mhat,dl); \
      _Pragma("unroll") for(int r=0;r<16;++r){P0[r]=fsub_s(P0[r],dl);P1[r]=fsub_s(P1[r],dl);} \
      } \
    _Pragma("unroll") for(int r=0;r<16;++r)P0[r]=__builtin_amdgcn_exp2f(P0[r]); }while(0)
  #define RESC() do{ if(resc){ asm volatile("s_waitcnt lgkmcnt(0)":::"memory"); \
      _Pragma("unroll") for(int d_=0;d_<2;++d_) _Pragma("unroll") for(int r=0;r<16;++r)o[d_][r]*=wsf[crow(r,hi)]; } }while(0)
  f32x16 pA0,pA1,pB0,pB1;
  int sl_prev=0,sl_cur=0,sl_next=SLOTB;
  #define ROT() do{sl_prev=sl_cur;sl_cur=sl_next;sl_next=(sl_next==(NSLOT-1)*SLOTB)?0:sl_next+SLOTB;}while(0)
  DMA_K(2,2*SLOTB);
  WAIT_BAR(3);
  BINIT(pA0,pA1,0,0.f);
  qkt(pA0,pA1,Kbase,qr,pA0,pA1,r32,hi);asm volatile("s_nop 15\n\ts_nop 7":"+v"(pA0),"+v"(pA1));CMASK(pA0,pA1,0);
  START(pA0,pA1);
  _Pragma("unroll") for(int r=0;r<16;++r)pA1[r]=__builtin_amdgcn_exp2f(pA1[r]);
  WAIT_BAR(0);
  DMA_K(3,0);DMA_V(1,SLOTB);
  ROT();
  kload8(kf,kp0+sl_cur);
  WAIT_BAR(2);
  s16x4 vlo[8],vhi[8]; u32x4 pw0,pw1,pw2,pw3;
  #define PKW(P,B) cvtpk_s(P[B],P[B+1])
  #define PAF(k) __builtin_bit_cast(bf16x8,pw##k)
  #define VFR(i) (bf16x8){vlo[i][0],vlo[i][1],vlo[i][2],vlo[i][3],vhi[i][0],vhi[i][1],vhi[i][2],vhi[i][3]}
  #define PIN(x) asm volatile("":"+v"(x))
  #define MX3(a,b,c) __builtin_fmaxf(__builtin_fmaxf((a),(b)),(c))
  #define GAPA(MF,A0,A1,A2,A3,W0,W1,PW) do{ MF; sacc+=A0; sacc+=A1; sacc+=A2; sacc+=A3; PIN(sacc); W0; W1; PIN(PW); SBAR(); }while(0)
  #define EX(v) __builtin_amdgcn_exp2f(v)
  #define GAPB(MF,X,B) do{ MF; X[B]=EX(X[B]); X[B+1]=EX(X[B+1]); X[B+2]=EX(X[B+2]); X[B+3]=EX(X[B+3]); PIN(X); SBAR(); }while(0)
  #define VRD(i) do{ vlo[i]=vtr(vp_+(((i)>>2)*4096+((i)&3)*1024)); vhi[i]=vtr(vp_+(((i)>>2)*4096+((i)&3)*1024+512)); }while(0)
  #define KRD(G,j) do{ if(G){ kload2(kf,kp0+sl_next,j); SBAR(); } }while(0)
  #define STEP(C0,C1,P0,P1,t,GK,GV,GL) do{ SBAR(); \
    BINIT(C0,C1,t,mhat); SBAR(); \
    const lds_cptr vp_=vp0+sl_prev; \
    VRD(0); SBAR(); float sacc=(P0[0]+P0[1]); \
    GAPA(C0=__builtin_amdgcn_mfma_f32_32x32x16_bf16(kf[0],qr[0],C0,0,0,0), P0[2],P0[3],P0[4],P0[5],     pw0[0]=PKW(P0,0), pw0[1]=PKW(P0,2), pw0); \
    VRD(4); SBAR(); GAPA(C1=__builtin_amdgcn_mfma_f32_32x32x16_bf16(kf[1],qr[0],C1,0,0,0), P0[6],P0[7],P0[8],P0[9],     pw0[2]=PKW(P0,4), pw0[3]=PKW(P0,6), pw0); \
    VRD(1); SBAR(); GAPA(C0=__builtin_amdgcn_mfma_f32_32x32x16_bf16(kf[2],qr[1],C0,0,0,0),   P0[10],P0[11],P0[12],P0[13], pw1[0]=PKW(P0,8), pw1[1]=PKW(P0,10), pw1); \
    VRD(5); SBAR(); GAPA(C1=__builtin_amdgcn_mfma_f32_32x32x16_bf16(kf[3],qr[1],C1,0,0,0),   P0[14],P0[15],P1[0],P1[1],   pw1[2]=PKW(P0,12),pw1[3]=PKW(P0,14), pw1); \
    VRD(2); SBAR(); GAPA(C0=__builtin_amdgcn_mfma_f32_32x32x16_bf16(kf[4],qr[2],C0,0,0,0),   P1[2],P1[3],P1[4],P1[5],     pw2[0]=PKW(P1,0), pw2[1]=PKW(P1,2), pw2); \
    VRD(6); SBAR(); GAPA(C1=__builtin_amdgcn_mfma_f32_32x32x16_bf16(kf[5],qr[2],C1,0,0,0),   P1[6],P1[7],P1[8],P1[9],     pw2[2]=PKW(P1,4), pw2[3]=PKW(P1,6), pw2); \
    VRD(3); SBAR(); GAPA(C0=__builtin_amdgcn_mfma_f32_32x32x16_bf16(kf[6],qr[3],C0,0,0,0),   P1[10],P1[11],P1[12],P1[13], pw3[0]=PKW(P1,8), pw3[1]=PKW(P1,10), pw3); \
    VRD(7); SBAR(); GAPA(C1=__builtin_amdgcn_mfma_f32_32x32x16_bf16(kf[7],qr[3],C1,0,0,0),   P1[14],P1[15],0.f,0.f,       pw3[2]=PKW(P1,12),pw3[3]=PKW(P1,14), pw3); \
    l_reg+=sacc; \
    if(GK){DMA_K((t)+3,sl_cur);} if(GV){DMA_V((t)+1,sl_next);} \
    CMASK(C0,C1,t); \
    { float a=MX3(C0[0],C0[1],C1[0]),b=MX3(C0[2],C0[3],C1[1]); a=MX3(a,C1[2],C1[3]); \
      _Pragma("unroll") for(int r=4;r<16;r+=4){a=MX3(a,C0[r],C0[r+1]);b=MX3(b,C0[r+2],C0[r+3]);a=MX3(a,C1[r],C1[r+1]);b=MX3(b,C1[r+2],C1[r+3]);} \
      float rm=__builtin_fmaxf(a,b); { auto rr=__builtin_amdgcn_permlane32_swap(__float_as_uint(rm),__float_as_uint(rm),false,false); rm=__builtin_fmaxf(__uint_as_float(rr[0]),__uint_as_float(rr[1])); } \
      resc=false; \
      if(__builtin_expect(__any(rm>(float)THRL),0)){ const float dl=__builtin_fmaxf(rm,0.f); mhat+=dl; \
        _Pragma("unroll") for(int r=0;r<16;++r){C0[r]-=dl;C1[r]-=dl;} \
        const float f=__builtin_amdgcn_exp2f(-dl); l_reg*=f; if(hi==0)wsf[r32]=f; resc=true; } } \
    SBAR(); \
    GAPB(o[0]=__builtin_amdgcn_mfma_f32_32x32x16_bf16(PAF(0),VFR(0),o[0],0,0,0), C0,0); \
    GAPB(o[1]=__builtin_amdgcn_mfma_f32_32x32x16_bf16(PAF(0),VFR(4),o[1],0,0,0), C0,4); \
    KRD(GL,0); GAPB(o[0]=__builtin_amdgcn_mfma_f32_32x32x16_bf16(PAF(1),VFR(1),o[0],0,0,0), C0,8); \
    KRD(GL,1); GAPB(o[1]=__builtin_amdgcn_mfma_f32_32x32x16_bf16(PAF(1),VFR(5),o[1],0,0,0), C0,12); \
    KRD(GL,2); GAPB(o[0]=__builtin_amdgcn_mfma_f32_32x32x16_bf16(PAF(2),VFR(2),o[0],0,0,0), C1,0); \
    KRD(GL,3); GAPB(o[1]=__builtin_amdgcn_mfma_f32_32x32x16_bf16(PAF(2),VFR(6),o[1],0,0,0), C1,4); \
    GAPB(o[0]=__builtin_amdgcn_mfma_f32_32x32x16_bf16(PAF(3),VFR(3),o[0],0,0,0), C1,8); \
    GAPB(o[1]=__builtin_amdgcn_mfma_f32_32x32x16_bf16(PAF(3),VFR(7),o[1],0,0,0), C1,12); \
    }while(0)
  int t=1;
  #undef CMASK
  #define CMASK(P0,P1,t) do{}while(0)
  for(;t+5<NT;t+=2){
    STEP(pB0,pB1,pA0,pA1,t,true,true,true);     WAIT_BAR(2); RESC(); ROT();
    STEP(pA0,pA1,pB0,pB1,t+1,true,true,true);   WAIT_BAR(2); RESC(); ROT();
  }
  #undef CMASK
  #define CMASK(P0,P1,t) do{ if(CAUSAL){int jb_=(t)-(NT-4); if(jb_>=0)cmask(P0,P1,jb_,qrel,hi);} }while(0)
  #define ENDW(tt) do{ if((tt)+3<NT){WAIT_BAR(2);} else if((tt)+2<NT){WAIT_BAR(1);} else {WAIT_BAR(0);} }while(0)
  for(;t+1<NT;t+=2){
    STEP(pB0,pB1,pA0,pA1,t,(t+3<NT),(t+1<NT),(t+1<NT));       ENDW(t);   RESC(); ROT();
    STEP(pA0,pA1,pB0,pB1,t+1,(t+4<NT),(t+2<NT),(t+2<NT));     ENDW(t+1); RESC(); ROT();
  }
  STEP(pB0,pB1,pA0,pA1,NT-1,false,false,false); RESC();
  { float sacc=pB0[0]+pB0[1]; _Pragma("unroll") for(int r=2;r<16;++r)sacc+=pB0[r]; _Pragma("unroll") for(int r=0;r<16;++r)sacc+=pB1[r]; l_reg+=sacc;
    pw0=(u32x4){PKW(pB0,0),PKW(pB0,2),PKW(pB0,4),PKW(pB0,6)};pw1=(u32x4){PKW(pB0,8),PKW(pB0,10),PKW(pB0,12),PKW(pB0,14)};pw2=(u32x4){PKW(pB1,0),PKW(pB1,2),PKW(pB1,4),PKW(pB1,6)};pw3=(u32x4){PKW(pB1,8),PKW(pB1,10),PKW(pB1,12),PKW(pB1,14)};
    SBAR(); pv(o,vb0+sl_cur,PAF(0),PAF(1),PAF(2),PAF(3)); }
  #undef PKW
  #undef PAF
  #undef VFR
  #undef PIN
  #undef MX3
  #undef GAPA
  #undef GAPB
  #undef EX
  #undef VRD
  #undef KRD
  #undef STEP
  #undef ENDW
  {auto rr=__builtin_amdgcn_permlane32_swap(__float_as_uint(l_reg),__float_as_uint(l_reg),false,false);l_reg=__uint_as_float(rr[0])+__uint_as_float(rr[1]);}
  if(hi==0)wsf[32+r32]=l_reg;asm volatile("s_waitcnt lgkmcnt(0)":::"memory");
  float rli[16];
  #pragma unroll
  for(int r=0;r<16;++r)rli[r]=__builtin_amdgcn_rcpf(wsf[32+crow(r,hi)]);
  bf16*Ow=Ou+(long)(wid*QBLK)*PQ;
  { bf16*stg=(bf16*)(shm+LDS_OST)+wid*2048;
    #pragma unroll
    for(int r=0;r<16;++r){const int orow=crow(r,hi);
      #pragma unroll
      for(int d0=0;d0<2;++d0)stg[orow*64+d0*32+r32]=__float2bfloat16(o[d0][r]*rli[r]);}
    asm volatile("s_waitcnt lgkmcnt(0)":::"memory");
    #pragma unroll
    for(int i=0;i<4;++i){const int row=i*8+(lane>>3),ch=lane&7; const u32x4 v=*(const u32x4*)(stg+row*64+ch*8); ATTN_STORE16(Ow+(long)row*PQ+ch*8,v);} }
  asm volatile("s_waitcnt lgkmcnt(0)\n\ts_barrier":::"memory");
  #undef BINIT
  #undef DMA_K
  #undef DMA_V
  #undef CMASK
  #undef START
  #undef RESC
  #undef ROT
}
constexpr int ATTN_LDS_BYTES=LDS_BYTES;
template<int THRL=8> __device__ __forceinline__ void fox_phase(char*lds,const bf16*PROJ,const float*CS,int grid,int block){
  constexpr int PQ=2816; const int vcu=(block%8)*(grid/8)+block/8;
  for(int i=0;i<6;++i){ const int p=vcu*3+(i>>1), bh=p>>2, x=p&3, qb=(i&1)?7-x:x, b=bh/12, h=bh%12;
    const bf16*rowb=PROJ+(long)b*SEQ*PQ;
    attn_unit<THRL,PQ,PQ,true,true>(rowb+(long)qb*QB*PQ+0+h*D, rowb+1024+h*D, rowb+1792+h*D, (bf16*)(rowb+(long)qb*QB*PQ+0+h*D), CS+(long)bh*SEQ, 4*qb+4, lds); }
}
template<int PQ,int THRL=8> __device__ __forceinline__ void mem_phase(char*lds,const bf16*PROJ,const bf16*MEMKV,int layer,int u0,int ustride){
  for(int u=u0;u<512;u+=ustride){ const int b=u>>5, hm=(u>>3)&3, qb=u&7;
    const bf16*qp=PROJ+((long)b*SEQ+(long)qb*QB)*PQ+768+hm*D; const bf16*kv=MEMKV+(long)b*256*1024+layer*512+hm*D;
    attn_unit<THRL,PQ,1024,false,false>(qp, kv, kv+256, (bf16*)qp, nullptr, 4, lds); }
}
#undef SBAR
#undef WAIT_BAR
}
namespace ret_body {
using attn_body::bf16x8; using attn_body::s16x4; using attn_body::f32x16; using attn_body::u32x4; using attn_body::f32x4v; using attn_body::crow; using attn_body::cvtpk_s;
typedef __attribute__((address_space(3))) unsigned char* lptr;
typedef short v4i16_t __attribute__((ext_vector_type(4)));
constexpr int RP = 3328;
constexpr int KC = 0, KT = 32768, VT = 65536, ST = 98304, PSUM = 131072 + 1024;
__device__ __forceinline__ s16x4 trd(lptr p) { return __builtin_bit_cast(s16x4, __builtin_amdgcn_ds_read_tr16_b64_v4i16((__attribute__((address_space(3))) v4i16_t*)p)); }
__device__ __forceinline__ bf16x8 frag2(lptr p, int off) { const s16x4 lo = trd(p + off), hi = trd(p + off + 512  ); return (bf16x8){lo[0], lo[1], lo[2], lo[3], hi[0], hi[1], hi[2], hi[3]}; }
__device__ __forceinline__ bf16x8 frag2n(lptr p, int off) { const s16x4 lo = trd(p + off), hi = trd(p + off + 256  ); return (bf16x8){lo[0], lo[1], lo[2], lo[3], hi[0], hi[1], hi[2], hi[3]}; }
__device__ __forceinline__ float bfl(unsigned u) { return __builtin_bit_cast(float, u << 16); }
__device__ __forceinline__ float bfh(unsigned u) { return __builtin_bit_cast(float, u & 0xffff0000u); }
__device__ __forceinline__ u32x4 scale8(u32x4 v, float s) { u32x4 r; r.x = cvtpk_s(bfl(v.x) * s, bfh(v.x) * s); r.y = cvtpk_s(bfl(v.y) * s, bfh(v.y) * s); r.z = cvtpk_s(bfl(v.z) * s, bfh(v.z) * s); r.w = cvtpk_s(bfl(v.w) * s, bfh(v.w) * s); return r; }
#define RBAR() asm volatile("s_waitcnt vmcnt(0) lgkmcnt(0)\n\ts_barrier" ::: "memory")
#define RBAR_L() asm volatile("s_waitcnt lgkmcnt(0)\n\ts_barrier" ::: "memory")

__device__ __forceinline__ void ret_unit(int b, int h, unsigned short* PROJ, lptr lds) {
    int tid_ = threadIdx.x; asm volatile("" : "+v"(tid_));
    const int tid = tid_, lane = tid & 63, r32 = lane & 31, hi = lane >> 5; const int wid = __builtin_amdgcn_readfirstlane(tid >> 6), g = wid >> 1, e = wid & 1;
    const float lg = __log2f(1.f - exp2f(-5.f - (float)h));
    const float g128 = exp2f(128.f * lg);
    unsigned short* base = PROJ + (size_t)b * SEQ * RP + h * 128;
    const int tt = tid >> 2, qq = tid & 3;
    const float vsc = exp2f(-(float)(tt + 1) * lg);
    const unsigned short* kg = base + (size_t)tt * RP + C_K + qq * 32; const unsigned short* vg = base + (size_t)tt * RP + C_V + qq * 32;
    lptr kc_w = lds + KC + (4 * qq) * 2048 + tt * 16, kt_w = lds + KT + qq * 8192 + tt * 64, vt_w = lds + VT + qq * 8192 + tt * 64;
    lptr kc_r = lds + KC + hi * 2048 + r32 * 16;
    const int trb = ((lane >> 4) & 1) * 32 + (lane & 3) * 8;
    const int trp = (4 * hi + ((lane & 15) >> 2)) * 64 + trb, trn = (8 * hi + ((lane & 15) >> 2)) * 64 + trb;
    lptr vt_r = lds + VT + (2 * e) * 8192 + trp, kt_r = lds + KT + g * 8192 + trp, st_r = lds + ST + (2 * e) * 8192 + trn;
    lptr st_w = lds + ST + (2 * e) * 8192 + (32 * g) * 64 + r32 * 2;
    __attribute__((address_space(3))) float* psum = (__attribute__((address_space(3))) float*)(lds + PSUM);
    u32x4 kp[4], vp[4];
#pragma unroll
    for (int i = 0; i < 4; ++i) { kp[i] = *(const u32x4*)(kg + i * 8); vp[i] = *(const u32x4*)(vg + i * 8); }
    f32x16 st[2]; st[0] = f32x16{}; st[1] = f32x16{};
#pragma unroll
    for (int d = 0; d < 2; ++d)
#pragma unroll
        for (int r = 0; r < 16; ++r) *(__attribute__((address_space(3))) unsigned short*)(st_w + d * 8192 + crow(r, hi) * 64) = 0;
#pragma unroll
    for (int i = 0; i < 4; ++i) { *(__attribute__((address_space(3))) u32x4*)(kc_w + i * 2048) = kp[i]; *(__attribute__((address_space(3))) u32x4*)(kt_w + i * 16) = kp[i];
        *(__attribute__((address_space(3))) u32x4*)(vt_w + i * 16) = scale8(vp[i], vsc); }
    bf16x8 qr[8];
    { const unsigned short* qg = base + (size_t)(32 * g + r32) * RP + C_Q + hi * 8;
#pragma unroll
      for (int d0 = 0; d0 < 8; ++d0) qr[d0] = *(const bf16x8*)(qg + d0 * 16); }
#pragma unroll
    for (int i = 0; i < 4; ++i) { kp[i] = *(const u32x4*)(kg + (size_t)128 * RP + i * 8); vp[i] = *(const u32x4*)(vg + (size_t)128 * RP + i * 8); }
    RBAR_L();
    for (int c = 0; c < 16; ++c) {
        f32x16 o[2]; o[0] = f32x16{}; o[1] = f32x16{};
#pragma unroll 2
        for (int d0 = 0; d0 < 8; ++d0) { const bf16x8 s0 = frag2n(st_r, d0 * 1024), s1 = frag2n(st_r, d0 * 1024 + 8192);
            o[0] = __builtin_amdgcn_mfma_f32_32x32x16_bf16(qr[d0], s0, o[0], 0, 0, 0); o[1] = __builtin_amdgcn_mfma_f32_32x32x16_bf16(qr[d0], s1, o[1], 0, 0, 0); }
        for (int jb = 0; jb <= g; ++jb) {
            f32x16 p = f32x16{};
#pragma unroll
            for (int d0 = 0; d0 < 8; ++d0) { const bf16x8 kf = *(const __attribute__((address_space(3))) bf16x8*)(kc_r + d0 * 4096 + jb * 512); p = __builtin_amdgcn_mfma_f32_32x32x16_bf16(kf, qr[d0], p, 0, 0, 0); }
            if (jb == g) {
#pragma unroll
                for (int r = 0; r < 16; ++r) if (crow(r, hi) > r32) p[r] = 0.f; }
            u32x4 pw0, pw1; pw0.x = cvtpk_s(p[0], p[1]); pw0.y = cvtpk_s(p[2], p[3]); pw0.z = cvtpk_s(p[4], p[5]); pw0.w = cvtpk_s(p[6], p[7]);
            pw1.x = cvtpk_s(p[8], p[9]); pw1.y = cvtpk_s(p[10], p[11]); pw1.z = cvtpk_s(p[12], p[13]); pw1.w = cvtpk_s(p[14], p[15]);
            const bf16x8 v00 = frag2(vt_r, (2 * jb) * 1024), v01 = frag2(vt_r, (2 * jb) * 1024 + 8192), v10 = frag2(vt_r, (2 * jb + 1) * 1024), v11 = frag2(vt_r, (2 * jb + 1) * 1024 + 8192);
            o[0] = __builtin_amdgcn_mfma_f32_32x32x16_bf16(__builtin_bit_cast(bf16x8, pw0), v00, o[0], 0, 0, 0); o[1] = __builtin_amdgcn_mfma_f32_32x32x16_bf16(__builtin_bit_cast(bf16x8, pw0), v01, o[1], 0, 0, 0);
            o[0] = __builtin_amdgcn_mfma_f32_32x32x16_bf16(__builtin_bit_cast(bf16x8, pw1), v10, o[0], 0, 0, 0); o[1] = __builtin_amdgcn_mfma_f32_32x32x16_bf16(__builtin_bit_cast(bf16x8, pw1), v11, o[1], 0, 0, 0);
        }
        if (c < 15) { const unsigned short* qg = base + (size_t)((c + 1) * 128 + 32 * g + r32) * RP + C_Q + hi * 8;
#pragma unroll
            for (int d0 = 0; d0 < 8; ++d0) qr[d0] = *(const bf16x8*)(qg + d0 * 16); }
#pragma unroll 2
        for (int s = 0; s < 8; ++s) { const bf16x8 ka = frag2(kt_r, s * 1024), v0 = frag2(vt_r, s * 1024), v1 = frag2(vt_r, s * 1024 + 8192);
            st[0] = __builtin_amdgcn_mfma_f32_32x32x16_bf16(ka, v0, st[0], 0, 0, 0); st[1] = __builtin_amdgcn_mfma_f32_32x32x16_bf16(ka, v1, st[1], 0, 0, 0); }
#pragma unroll
        for (int r = 0; r < 16; ++r) { st[0][r] *= g128; st[1][r] *= g128; }
        float tot; int rstar;
        { float a8[8], b4[4], c2[2];
          const int b4_ = (r32 >> 4) & 1, b3_ = (r32 >> 3) & 1, b2_ = (r32 >> 2) & 1, b1_ = (r32 >> 1) & 1;
#pragma unroll
          for (int k = 0; k < 8; ++k) { const float lo = o[0][k] * o[0][k] + o[1][k] * o[1][k], hi_ = o[0][8 + k] * o[0][8 + k] + o[1][8 + k] * o[1][8 + k];
              const float send = b4_ ? lo : hi_, keep = b4_ ? hi_ : lo; a8[k] = keep + __shfl_xor(send, 16); }
#pragma unroll
          for (int k = 0; k < 4; ++k) { const float send = b3_ ? a8[k] : a8[4 + k], keep = b3_ ? a8[4 + k] : a8[k]; b4[k] = keep + __shfl_xor(send, 8); }
#pragma unroll
          for (int k = 0; k < 2; ++k) { const float send = b2_ ? b4[k] : b4[2 + k], keep = b2_ ? b4[2 + k] : b4[k]; c2[k] = keep + __shfl_xor(send, 4); }
          { const float send = b1_ ? c2[0] : c2[1], keep = b1_ ? c2[1] : c2[0]; tot = keep + __shfl_xor(send, 2); }
          tot += __shfl_xor(tot, 1);
          rstar = 8 * b4_ + 4 * b3_ + 2 * b2_ + b1_; }
        if ((r32 & 1) == 0) psum[e * 128 + 32 * g + crow(rstar, hi)] = tot;
        RBAR_L();
        if (c < 15) {
#pragma unroll
            for (int i = 0; i < 4; ++i) { *(__attribute__((address_space(3))) u32x4*)(kc_w + i * 2048) = kp[i]; *(__attribute__((address_space(3))) u32x4*)(kt_w + i * 16) = kp[i];
                *(__attribute__((address_space(3))) u32x4*)(vt_w + i * 16) = scale8(vp[i], vsc); }
#pragma unroll
            for (int d = 0; d < 2; ++d)
#pragma unroll
                for (int r = 0; r < 16; ++r) { const unsigned w = cvtpk_s(st[d][r], 0.f); *(__attribute__((address_space(3))) unsigned short*)(st_w + d * 8192 + crow(r, hi) * 64) = (unsigned short)w; }
            if (c < 14) {
#pragma unroll
                for (int i = 0; i < 4; ++i) { kp[i] = *(const u32x4*)(kg + (size_t)(c + 2) * 128 * RP + i * 8); vp[i] = *(const u32x4*)(vg + (size_t)(c + 2) * 128 * RP + i * 8); } }
        }
        { unsigned short* og = base + (size_t)(c * 128 + 32 * g) * RP + C_Q + 64 * e + r32; const unsigned short* gg = base + (size_t)(c * 128 + 32 * g) * RP + C_G + 64 * e + r32;
          const __attribute__((address_space(3))) f32x4v* ps4 = (const __attribute__((address_space(3))) f32x4v*)(psum + 32 * g) + hi;
#pragma unroll
          for (int q4 = 0; q4 < 4; ++q4) { const f32x4v s0 = ps4[2 * q4], s1 = ps4[32 + 2 * q4];
#pragma unroll
              for (int k = 0; k < 4; ++k) { const int r = 4 * q4 + k; const float sc = __builtin_amdgcn_exp2f((float)(32 * g + crow(r, hi) + 1) * lg);     const float ss = (s0[k] + s1[k]) * sc * sc;
                  const float f = sc / sqrtf(ss * (1.f / 128.f) + EPS); const int row = crow(r, hi);
                  const float g0 = bfl((unsigned)gg[(size_t)row * RP]), g1 = bfl((unsigned)gg[(size_t)row * RP + 32]);
                  og[(size_t)row * RP] = (unsigned short)cvtpk_s(o[0][r] * f * g0, 0.f); og[(size_t)row * RP + 32] = (unsigned short)cvtpk_s(o[1][r] * f * g1, 0.f); } } }
        RBAR_L();
    }
    asm volatile("s_waitcnt vmcnt(0)" ::: "memory");
}
#undef RBAR
#undef RBAR_L
}
#define XB_TMO      128
#define XB_XCNT(j)  (256  + 64 * (j))
#define XB_XSUB(j)  (1280 + 64 * (j))
#define XB_XGEN(j)  (2304 + 64 * (j))
#define XB_TOP      3328
#define XB_TOPGEN   3392
#define XCD_BAR_WORDS 3456
#define XB_SPIN_CAP (1u << 18)

__device__ __forceinline__ unsigned xb_ld(unsigned* p)              { return __hip_atomic_load(p, __ATOMIC_RELAXED, __HIP_MEMORY_SCOPE_AGENT); }
__device__ __forceinline__ unsigned xb_add(unsigned* p, unsigned v) { return __hip_atomic_fetch_add(p, v, __ATOMIC_RELAXED, __HIP_MEMORY_SCOPE_AGENT); }
__device__ __forceinline__ unsigned xb_xcc_id() { return (unsigned)__builtin_amdgcn_s_getreg((3 << 11) | 20) & 0xFu; }
#define XB_SPIN(cond, bar) do { unsigned _sp = 0; while (cond) { __builtin_amdgcn_s_sleep(1); \
    if ((++_sp & 255u) == 0u) { if (xb_ld(&(bar)[XB_TMO])) break; if (_sp > XB_SPIN_CAP) { atomicAdd(&(bar)[XB_TMO], 1u); break; } } } } while (0)

struct XcdBarrier {
    unsigned* bar; unsigned x;
    volatile LAS unsigned* st;
};

__device__ __forceinline__ XcdBarrier xcd_barrier_post(unsigned* bar, volatile LAS unsigned* st) {
    XcdBarrier b; b.bar = bar; b.x = xb_xcc_id(); b.st = st;
    if (threadIdx.x == 0) (void)xb_add(&bar[XB_XCNT(b.x)], 1u);
    return b;
}
__device__ __forceinline__ void xcd_barrier_complete(unsigned* bar, unsigned x, unsigned& nloc, unsigned& nx) {
    const unsigned G = gridDim.x * gridDim.y * gridDim.z;
    unsigned sum, cnt, mine, sp = 0u;
    for (;;) {
        sum = 0u; cnt = 0u; mine = 0u;
#pragma unroll
        for (unsigned j = 0; j < 16; ++j) { const unsigned c = xb_ld(&bar[XB_XCNT(j)]); sum += c; cnt += (c > 0u) ? 1u : 0u; mine = (j == x) ? c : mine; }
        if (sum == G) break;
        __builtin_amdgcn_s_sleep(1);
        if ((++sp & 255u) == 0u) { if (xb_ld(&bar[XB_TMO])) break; if (sp > XB_SPIN_CAP) { atomicAdd(&bar[XB_TMO], 1u); break; } }
    }
    nloc = mine > 0u ? mine : 1u; nx = cnt > 0u ? cnt : 1u;
}

__device__ __forceinline__ void xcd_barrier(const XcdBarrier& b) {
    asm volatile("s_waitcnt vmcnt(0)" ::: "memory");
    __syncthreads();
    if (threadIdx.x == 0) {
        unsigned* bar = b.bar;
        __builtin_amdgcn_s_waitcnt(0);
        unsigned nloc = b.st[0], nx = b.st[1];
        if (nloc == 0u) { xcd_barrier_complete(bar, b.x, nloc, nx); b.st[0] = nloc; b.st[1] = nx; }
        const unsigned old = xb_add(&bar[XB_XSUB(b.x)], 1u);
        const unsigned gen = old / nloc;
        if (old + 1u == (gen + 1u) * nloc) {
            __builtin_amdgcn_fence(__ATOMIC_RELEASE, "agent");
            asm volatile("s_waitcnt vmcnt(0)" ::: "memory");
            const unsigned og = xb_add(&bar[XB_TOP], 1u);
            const unsigned tg = og / nx;
            if (og + 1u == (tg + 1u) * nx) xb_add(&bar[XB_TOPGEN], 1u);
            else XB_SPIN(xb_ld(&bar[XB_TOPGEN]) == tg, bar);
            __builtin_amdgcn_fence(__ATOMIC_ACQUIRE, "agent");
            xb_add(&bar[XB_XGEN(b.x)], 1u);
            asm volatile("s_waitcnt vmcnt(0)" ::: "memory");
        } else {
            XB_SPIN(xb_ld(&bar[XB_XGEN(b.x)]) == gen, bar);
            __builtin_amdgcn_fence(__ATOMIC_ACQUIRE, "agent");
            asm volatile("s_waitcnt vmcnt(0)" ::: "memory");
        }
    }
    __syncthreads();
}

struct Args { const float* in[15]; float* out; unsigned char* ws; int ph_lo, ph_hi; };
typedef const __attribute__((address_space(4))) Args* KArgs;
#define KA_GET() ({ KArgs k_ = (KArgs)__builtin_amdgcn_kernarg_segment_ptr(); asm volatile("" : "+s"(k_)); k_; })
#define WSP(T, off) ((T*)(ka->ws + (off)))
struct Frame {
    LAS unsigned char* lds;
    int tid, lane, wave, gw;
    int G;
};
__device__ __forceinline__ float wave_sum(float v) {
#pragma unroll
    for (int o = 1; o < 64; o <<= 1) v += __shfl_xor(v, o);
    return v;
}

__device__ __forceinline__ int dst_row(int mode, int n) {
    if (mode == 0) return n;
    if (mode == 1) {
        if (n < 768) { const int h = n >> 7, d = n & 127; return C_Q + h * 128 + ((d & 63) << 1) + (d >> 6); }
        if (n < 1536) { const int m = n - 768, h = m >> 7, d = m & 127; return C_K + h * 128 + ((d & 63) << 1) + (d >> 6); }
        if (n < 2304) return C_V + (n - 1536);
        if (n < 3072) return C_G + (n - 2304);
        return C_MQ + (n - 3072);
    }
    if (n < 768) return C_Q + n;
    if (n < 1536) return C_K + (n - 768);
    if (n < 2304) return C_V + (n - 1536);
    if (n < 2316) return C_G + (n - 2304);
    return C_MQ + (n - 2316);
}
__device__ __forceinline__ void p0_transpose_item(const float* W, int K, int N, bf16* WT, int mode, int row_off, const float* gain, LAS float* scr, int item, int lane) {
    const int nblk = (N + 31) / 32, kb = item / nblk, nb = item % nblk, k0 = 64 * kb, n0 = 32 * nb;
    const int nn = n0 + (lane & 31);
#pragma unroll 8
    for (int i = 0; i < 32; ++i) { const int kk = 2 * i + (lane >> 5);
        float v = 0.f; if (nn < N) { v = W[(size_t)(k0 + kk) * N + nn]; if (gain) v *= gain[k0 + kk]; }
        scr[kk * 33 + (lane & 31)] = v; }
    LDS_WAIT(); asm volatile("" ::: "memory");
    const int c = lane & 7;
#pragma unroll
    for (int j = 0; j < 4; ++j) { const int nl = (lane >> 3) + 8 * j; const int n = n0 + nl;
        if (n < N) { const LAS float* s = scr + (8 * c) * 33 + nl;
            v4u o; o.x = pk2(s[0 * 33], s[1 * 33]); o.y = pk2(s[2 * 33], s[3 * 33]); o.z = pk2(s[4 * 33], s[5 * 33]); o.w = pk2(s[6 * 33], s[7 * 33]);
            *(GAS v4u*)(WT + (size_t)(row_off + dst_row(mode, n)) * K + k0 + 8 * c) = o; } }
    LDS_WAIT(); asm volatile("" ::: "memory");
}
__device__ __forceinline__ void rms_row_to_bf16(const float* xrow, bf16* orow, int lane) {
    const GAS f32x4* xr = (const GAS f32x4*)xrow + lane;
    f32x4 v[4]; float s = 0.f;
#pragma unroll
    for (int j = 0; j < 4; ++j) { v[j] = xr[64 * j]; s += (v[j].x * v[j].x + v[j].y * v[j].y) + (v[j].z * v[j].z + v[j].w * v[j].w); }
    const float rstd = 1.0f / sqrtf(wave_sum(s) * (1.f / DM) + EPS);
    GAS unsigned long long* o8 = (GAS unsigned long long*)orow + lane;
#pragma unroll
    for (int j = 0; j < 4; ++j) o8[64 * j] = (unsigned long long)pk2(v[j].x * rstd, v[j].y * rstd) | ((unsigned long long)pk2(v[j].z * rstd, v[j].w * rstd) << 32);
}
__device__ __forceinline__ void p0_prologue(Frame& F, KArgs ka) {
    const float *w_in_ret = ka->in[3], *w_in_fox = ka->in[4], *w_mem_kv = ka->in[6], *w_out = ka->in[7], *w_up = ka->in[8], *w_down = ka->in[9];
    const float *g_pre_mix = ka->in[10], *g_pre_mlp = ka->in[12], *g_mem = ka->in[14];
    bf16 *Win0 = WSP(bf16, WS_WIN0), *Win1 = WSP(bf16, WS_WIN1), *Wmem = WSP(bf16, WS_WMEM), *Wout = WSP(bf16, WS_WOUT), *Wup = WSP(bf16, WS_WUP), *Wdn = WSP(bf16, WS_WDN);
    LAS float* scr = (LAS float*)(F.lds + RING_OFF + F.wave * 16384);
    const int gw = F.gw, NGW = F.G * NWAVES;
    constexpr int KB = DM / 64;
    constexpr int I_IN0 = KB * (3328 / 32), I_IN1 = KB * ((2572 + 31) / 32), I_MEM = KB * (512 / 32), I_OUT = KB * (DM / 32), I_UP = KB * (FF / 32), I_DN = (FF / 64) * (DM / 32);
    constexpr int NITEMS = I_IN0 + I_IN1 + 2 * I_MEM + 2 * I_OUT + 2 * I_UP + 2 * I_DN;
    for (int it = gw; it < NITEMS; it += NGW) {
        int r = it;
        if (r < I_IN0) { p0_transpose_item(w_in_ret, DM, 3328, Win0, 1, 0, g_pre_mix, scr, r, F.lane); continue; } r -= I_IN0;
        if (r < I_IN1) { p0_transpose_item(w_in_fox, DM, 2572, Win1, 2, 0, g_pre_mix + DM, scr, r, F.lane); continue; } r -= I_IN1;
        if (r < 2 * I_MEM) { const int l = r / I_MEM; p0_transpose_item(w_mem_kv + (size_t)l * DM * 512, DM, 512, Wmem, 0, l * 512, g_mem + l * DM, scr, r % I_MEM, F.lane); continue; } r -= 2 * I_MEM;
        if (r < 2 * I_OUT) { const int l = r / I_OUT; p0_transpose_item(w_out + (size_t)l * DM * DM, DM, DM, Wout + (size_t)l * DM * DM, 0, 0, nullptr, scr, r % I_OUT, F.lane); continue; } r -= 2 * I_OUT;
        if (r < 2 * I_UP) { const int l = r / I_UP; p0_transpose_item(w_up + (size_t)l * DM * FF, DM, FF, Wup + (size_t)l * DM * FF, 0, 0, g_pre_mlp + l * DM, scr, r % I_UP, F.lane); continue; } r -= 2 * I_UP;
        { const int l = r / I_DN; p0_transpose_item(w_down + (size_t)l * DM * FF, FF, DM, Wdn + (size_t)l * DM * FF, 0, 0, nullptr, scr, r % I_DN, F.lane); }
    }
    { GAS v4u* z = (GAS v4u*)(Win1 + (size_t)(C_G + 12) * DM); const int n16 = (NP1 - C_G - 12) * DM * 2 / 16;
      for (int i = gw * 64 + F.lane; i < n16; i += NGW * 64) z[i] = (v4u){0u, 0u, 0u, 0u}; }
    for (int m = gw; m < MTOK; m += NGW) rms_row_to_bf16(ka->in[0] + (size_t)m * DM, WSP(bf16, WS_XN) + (size_t)m * DM, F.lane);
    for (int m = gw; m < MMEM; m += NGW) rms_row_to_bf16(ka->in[1] + (size_t)m * DM, WSP(bf16, WS_MEMN) + (size_t)m * DM, F.lane);
}

__device__ __forceinline__ void row_pass(Frame& F, const float* y, const float* base, const float* gain, float* xo, bf16* xn) {
    const int NGW = F.G * NWAVES;
    f32x4 g[4];
#pragma unroll
    for (int j = 0; j < 4; ++j) g[j] = ((const GAS f32x4*)gain)[F.lane + 64 * j];
    for (int m = F.gw; m < MTOK; m += NGW) {
        const GAS f32x4* yr = (const GAS f32x4*)(y + (size_t)m * DM) + F.lane; const GAS f32x4* br = (const GAS f32x4*)(base + (size_t)m * DM) + F.lane;
        f32x4 v[4], b[4]; float s = 0.f;
#pragma unroll
        for (int j = 0; j < 4; ++j) { v[j] = yr[64 * j]; b[j] = br[64 * j]; s += (v[j].x * v[j].x + v[j].y * v[j].y) + (v[j].z * v[j].z + v[j].w * v[j].w); }
        const float rstd = 1.0f / sqrtf(wave_sum(s) * (1.f / DM) + EPS);
        float s2 = 0.f;
#pragma unroll
        for (int j = 0; j < 4; ++j) { v[j] = b[j] + v[j] * rstd * g[j]; s2 += (v[j].x * v[j].x + v[j].y * v[j].y) + (v[j].z * v[j].z + v[j].w * v[j].w); }
        GAS f32x4* o = (GAS f32x4*)(xo + (size_t)m * DM) + F.lane;
#pragma unroll
        for (int j = 0; j < 4; ++j) o[64 * j] = v[j];
        if (xn) {
            const float r2 = 1.0f / sqrtf(wave_sum(s2) * (1.f / DM) + EPS);
            GAS unsigned long long* o8 = (GAS unsigned long long*)(xn + (size_t)m * DM) + F.lane;
#pragma unroll
            for (int j = 0; j < 4; ++j) o8[64 * j] = (unsigned long long)pk2(v[j].x * r2, v[j].y * r2) | ((unsigned long long)pk2(v[j].z * r2, v[j].w * r2) << 32);
        }
    }
}

__device__ __forceinline__ void scan_phase(Frame& F, KArgs ka) {
    if (F.gw >= BATCH * 12) return;
    const int b = F.gw / 12, h = F.gw % 12;
    const float* src = WSP(float, WS_LOGF) + ((size_t)b * SEQ + F.lane * 32) * 16 + h;
    float s = 0.f;
    for (int i = 0; i < 32; ++i) s += src[(size_t)i * 16];
    float incl = s;
#pragma unroll
    for (int o = 1; o < 64; o <<= 1) { const float v = __shfl_up(incl, o); if (F.lane >= o) incl += v; }
    float run = incl - s;
    float* dst = WSP(float, WS_CS) + (size_t)(b * 12 + h) * SEQ + F.lane * 32;
    for (int i = 0; i < 32; ++i) { run += src[(size_t)i * 16]; dst[i] = run; }
}

#define RUN() (lo <= ph && ph < hi)
#define SEAM() do { if (lo <= ph && ph + 1 < hi) xcd_barrier(bar); ++ph; } while (0)
#define RELANE() do { int t_ = threadIdx.x; asm volatile("" : "+v"(t_)); F.tid = t_; F.lane = t_ & 63; F.wave = __builtin_amdgcn_readfirstlane(t_ >> 6); F.gw = blockIdx.x * NWAVES + F.wave; } while (0)
template <int layer> __device__ __forceinline__ void run_layer(Frame& F, const XcdBarrier& bar, const int lo, const int hi, int& ph, LAS unsigned char* ring, unsigned char* lds, const int G, const int c) {
        const int NP = layer ? NP1 : NP0;
        if (RUN()) {
            KArgs ka = KA_GET();
            pg8::Gemm g{WSP(bf16, WS_XN), layer ? WSP(bf16, WS_WIN1) : WSP(bf16, WS_WIN0), MTOK, NP, DM, DM}; pg8::StaticOrder S; S.init(MTOK, NP, G, c);
            pg8::EpiProj E{WSP(bf16, WS_PROJ), NP, layer, (const int*)ka->in[2], WSP(float, WS_LOGF), ka->in[5]};
            pg8::gemm_phase<pg8::EpiProj, pg8::StaticOrder, true, true>(ring, g, S, E);
            if (layer == 0) {
                pg8::Gemm g2{WSP(bf16, WS_MEMN), WSP(bf16, WS_WMEM), MMEM, DM, DM, DM}; pg8::OneUnit S2; const int idx = c - 128; S2.has = (idx >= 0 && idx < 64); S2.u0.pm = idx >> 2; S2.u0.pn = idx & 3;
                pg8::EpiBf16<0> E2{WSP(bf16, WS_MEMKV), DM};
                pg8::gemm_phase<pg8::EpiBf16<0>, pg8::OneUnit, true, true>(ring, g2, S2, E2);
            }
        }
        SEAM();
        if (RUN()) { RELANE(); if (layer == 1) scan_phase(F, KA_GET()); }
        SEAM();
        if (RUN()) { RELANE(); KArgs ka = KA_GET();
            static_assert(attn_body::ATTN_LDS_BYTES <= RING_BYTES, "attention LDS");
            if (layer == 0) {
                if (c < 96) ret_body::ret_unit(c / 6, c % 6, WSP(bf16, WS_PROJ), F.lds);
                else attn_body::mem_phase<NP0, 8>((char*)lds + RING_OFF, (const attn_body::bf16*)WSP(bf16, WS_PROJ), (const attn_body::bf16*)WSP(bf16, WS_MEMKV), 0, c - 96, 160);
            } else {
                attn_body::fox_phase<8>((char*)lds + RING_OFF, (const attn_body::bf16*)WSP(bf16, WS_PROJ), WSP(float, WS_CS), (int)F.G, (int)blockIdx.x);
                attn_body::mem_phase<NP1, 8>((char*)lds + RING_OFF, (const attn_body::bf16*)WSP(bf16, WS_PROJ), (const attn_body::bf16*)WSP(bf16, WS_MEMKV), 1, c, 256);
            }
        }
        SEAM();
        if (RUN()) {
            KArgs ka = KA_GET();
            pg8::Gemm g{WSP(bf16, WS_PROJ), WSP(bf16, WS_WOUT) + (size_t)layer * DM * DM, MTOK, DM, DM, NP}; pg8::StaticOrder S; S.init(MTOK, DM, G, c);
            pg8::EpiF32 E{ka->out, DM};
            pg8::gemm_phase<pg8::EpiF32, pg8::StaticOrder, true, true>(ring, g, S, E);
        }
        SEAM();
        if (RUN()) { RELANE(); KArgs ka = KA_GET(); row_pass(F, ka->out, layer ? WSP(float, WS_R1) : ka->in[0], ka->in[11] + layer * DM, WSP(float, WS_R1), WSP(bf16, WS_XN)); }
        SEAM();
        if (RUN()) {
            KArgs ka = KA_GET();
            pg8::Gemm g{WSP(bf16, WS_XN), WSP(bf16, WS_WUP) + (size_t)layer * DM * FF, MTOK, FF, DM, DM}; pg8::StaticOrder S; S.init(MTOK, FF, G, c);
            pg8::EpiBf16<1> E{WSP(bf16, WS_H), FF};
            pg8::gemm_phase<pg8::EpiBf16<1>, pg8::StaticOrder, true, true>(ring, g, S, E);
        }
        SEAM();
        if (RUN()) {
            KArgs ka = KA_GET();
            pg8::Gemm g{WSP(bf16, WS_H), WSP(bf16, WS_WDN) + (size_t)layer * DM * FF, MTOK, DM, FF, FF}; pg8::StaticOrder S; S.init(MTOK, DM, G, c);
            pg8::EpiF32 E{ka->out, DM};
            pg8::gemm_phase<pg8::EpiF32, pg8::StaticOrder, true, true>(ring, g, S, E);
        }
        SEAM();
        if (RUN()) { RELANE(); KArgs ka = KA_GET(); row_pass(F, ka->out, WSP(float, WS_R1), ka->in[13] + layer * DM, layer ? ka->out : WSP(float, WS_R1), layer ? nullptr : WSP(bf16, WS_XN)); }
        SEAM();
    }
__global__ void __launch_bounds__(NWAVES * 64, 2) fwd_kernel(Args args) {
    extern __shared__ __attribute__((aligned(16))) unsigned char lds[];
    Frame F;
    F.lds = (LAS unsigned char*)lds;
    F.tid = threadIdx.x; F.lane = F.tid & 63; F.wave = __builtin_amdgcn_readfirstlane(F.tid >> 6);
    F.G = gridDim.x; F.gw = blockIdx.x * NWAVES + F.wave;
    for (int u = F.tid; u < (LDS_BYTES - LDSCTL_OFF) / 4; u += NWAVES * 64) ((LAS unsigned*)(F.lds + LDSCTL_OFF))[u] = 0u;
    __syncthreads();
    volatile LAS unsigned* MISC = (volatile LAS unsigned*)(F.lds + MISC_OFF);
    XcdBarrier bar = xcd_barrier_post((unsigned*)(args.ws + WS_CTL) + CW_BAR, MISC + 8);
    const int lo = args.ph_lo, hi = args.ph_hi;
    int ph = 0;
    LAS unsigned char* ring = F.lds + RING_OFF;
    const int G = F.G, c = (int)blockIdx.x;

    if (RUN()) { RELANE(); p0_prologue(F, KA_GET()); }
    SEAM();
    run_layer<0>(F, bar, lo, hi, ph, ring, lds, G, c);
    run_layer<1>(F, bar, lo, hi, ph, ring, lds, G, c);
#undef RUN
#undef SEAM
}

#ifndef MK_MULTI
#define MK_MULTI 0
#endif
constexpr int N_PHASES = 1 + 2 * 8;
extern "C" void kernel_launch(void* const* d_in, const int* in_sizes, int n_in, void* d_out, int out_size, void* d_ws, size_t ws_size, hipStream_t stream) {
    static int grid = 0;
    if (grid == 0) {
        if (n_in != 15 || in_sizes[0] != MTOK * DM || out_size != MTOK * DM || ws_size < WS_END) { fprintf(stderr, "kernel_launch: unexpected shapes (n_in %d, in0 %d, out %d, ws %zu); nothing launched\n", n_in, n_in > 0 ? in_sizes[0] : -1, out_size, ws_size); grid = -1; return; }
        int dev = 0, cus = 0, per_cu = 0;
        if (hipGetDevice(&dev) != hipSuccess || hipDeviceGetAttribute(&cus, hipDeviceAttributeMultiprocessorCount, dev) != hipSuccess) { grid = -1; return; }
        if (hipFuncSetAttribute((const void*)fwd_kernel, hipFuncAttributeMaxDynamicSharedMemorySize, LDS_BYTES) != hipSuccess) { fprintf(stderr, "kernel_launch: hipFuncSetAttribute failed\n"); grid = -1; return; }
        if (hipOccupancyMaxActiveBlocksPerMultiprocessor(&per_cu, (const void*)fwd_kernel, NWAVES * 64, LDS_BYTES) != hipSuccess || per_cu < 1)
            fprintf(stderr, "kernel_launch: occupancy query reports %d workgroups per CU\n", per_cu);
        (void)hipGetLastError();
        grid = cus;
    }
    if (grid < 0) return;
    if (hipMemsetAsync((char*)d_ws + WS_CTL, 0, CTL_ZERO_BYTES, stream) != hipSuccess) return;
    Args a{};
    for (int i = 0; i < 15; ++i) a.in[i] = (const float*)d_in[i];
    a.out = (float*)d_out; a.ws = (unsigned char*)d_ws;
#if MK_MULTI
    for (int p = 0; p < N_PHASES; ++p) { a.ph_lo = p; a.ph_hi = p + 1; hipLaunchKernelGGL(fwd_kernel, dim3(grid), dim3(NWAVES * 64), LDS_BYTES, stream, a); }
#else
    a.ph_lo = 0; a.ph_hi = N_PHASES;
    hipLaunchKernelGGL(fwd_kernel, dim3(grid), dim3(NWAVES * 64), LDS_BYTES, stream, a);
#endif
}
```

```cpp
#include <hip/hip_runtime.h>
#include <hip/hip_bf16.h>
#include <cmath>
#include <cstdio>
#include <cstdint>

constexpr int BATCH = 16, SEQ = 2048, DM = 1024, MTOK = BATCH * SEQ, MEML = 256, MMEM = BATCH * MEML, FF = 4096;
constexpr int NP0 = 3328, NP1 = 2816;
constexpr int C_Q = 0, C_MQ = 768, C_K = 1024, C_V = 1792, C_G = 2560;
constexpr float EPS = 1e-6f;
constexpr float LOG2E = 1.4426950408889634f;
constexpr float QSCALE = 0.125f * LOG2E;

namespace pg8 {
#define PG8_LAS __attribute__((address_space(3)))
typedef unsigned short bf16_t;
typedef short bf16x8 __attribute__((ext_vector_type(8)));
typedef float f32x4 __attribute__((ext_vector_type(4)));
typedef unsigned u32x4 __attribute__((ext_vector_type(4)));
constexpr int BM = 256, BK = 64, HALF = 128, HTB = HALF * BK * 2  , STAGE_BYTES = 8 * HTB, NXCD = 8, WGM = 8;

__host__ __device__ __forceinline__ int lds_byte(int r, int c) { const int st = (r >> 4) * 2 + (c >> 5), rr = r & 15, cc = c & 31, ob = rr * 64 + cc * 2; return st * 1024 + (ob ^ (((ob >> 9) & 1) << 5)); }
__host__ __device__ __forceinline__ void stage_rc(int b, int& R, int& C) { const int st = b / 1024, sb = b % 1024, swz = sb ^ (((sb >> 9) & 1) << 5); R = (st >> 1) * 16 + swz / 64; C = (st & 1) * 32 + (swz % 64) / 2; }
__host__ __device__ __forceinline__ int perm32(int rho) { const int n = rho >> 4, i = rho & 15; return 8 * (i >> 2) + 4 * n + (i & 3); }

struct Unit { int pm, pn; };
struct Gemm { const bf16_t* A; const bf16_t* Bt; int M, N, K, lda; };

struct StaticOrder {
    int nM, nN, nwg, G, c;
    __host__ __device__ void init(int M, int N, int G_, int c_) { nM = M / BM; nN = N / BM; nwg = nM * nN; G = G_; c = c_; }
    __host__ __device__ bool next(int i, Unit& u) const {
        const long L = (long)i * G + c; if (L >= nwg) return false;
        int wgid = (int)L; { const int q = nwg / NXCD, r = nwg % NXCD, xcd = wgid % NXCD, off = wgid / NXCD; wgid = (xcd < r ? xcd * (q + 1) : r * (q + 1) + (xcd - r) * q) + off; }
        const int nig = WGM * nN, gid = wgid / nig, fm = gid * WGM, gsz = (nM - fm) < WGM ? (nM - fm) : WGM;
        u.pm = fm + ((wgid % nig) % gsz); u.pn = (wgid % nig) / gsz; return true;
    }
    __device__ __forceinline__ void a_ready(const Unit&) const {}
    __device__ __forceinline__ void done(const Unit&) const {}
};
struct OneUnit {
    Unit u0; bool has;
    __device__ __forceinline__ bool next(int i, Unit& u) const { if (i != 0 || !has) return false; u = u0; return true; }
    __device__ __forceinline__ void a_ready(const Unit&) const {}
    __device__ __forceinline__ void done(const Unit&) const {}
};

typedef float f32x2_t __attribute__((ext_vector_type(2))); typedef __bf16 bf16x2_t __attribute__((ext_vector_type(2)));
__device__ __forceinline__ unsigned cvt_pk_bf16(float lo, float hi) { f32x2_t v = {lo, hi}; bf16x2_t b = __builtin_convertvector(v, bf16x2_t); return __builtin_bit_cast(unsigned, b); }

template <int ACT> struct EpiBf16 {
    static constexpr bool PERM = true, AFTER_DRAIN = false;
    bf16_t* O; int ldc;
    __device__ __forceinline__ void operator()(const f32x4 (&acc)[2][2][4][2], const Unit& u, int wr, int wc, int fr, int fq) const {
        const int row0 = u.pm * BM + wr * 64 + fr, col0 = u.pn * BM + wc * 32 + 8 * fq;
#pragma unroll
        for (int ai = 0; ai < 2; ++ai)
#pragma unroll
            for (int m = 0; m < 4; ++m) { bf16_t* rowp = O + (size_t)(row0 + ai * HALF + m * 16) * ldc + col0;
#pragma unroll
                for (int bj = 0; bj < 2; ++bj) { f32x4 v0 = acc[ai][bj][m][0], v1 = acc[ai][bj][m][1];
                    if (ACT == 1) {
#pragma unroll
                        for (int e = 0; e < 4; ++e) { const float a = fmaxf(v0[e], 0.f), b = fmaxf(v1[e], 0.f); v0[e] = a * a; v1[e] = b * b; } }
                    u32x4 w; w.x = cvt_pk_bf16(v0[0], v0[1]); w.y = cvt_pk_bf16(v0[2], v0[3]); w.z = cvt_pk_bf16(v1[0], v1[1]); w.w = cvt_pk_bf16(v1[2], v1[3]);
                    *(u32x4*)(rowp + bj * HALF) = w; } }
    }
};
struct EpiF32 {
    static constexpr bool PERM = false, AFTER_DRAIN = false;
    float* O; int ldc;
    __device__ __forceinline__ void operator()(const f32x4 (&acc)[2][2][4][2], const Unit& u, int wr, int wc, int fr, int fq) const {
        const int row0 = u.pm * BM + wr * 64 + fr, col0 = u.pn * BM + wc * 32 + 4 * fq;
#pragma unroll
        for (int ai = 0; ai < 2; ++ai)
#pragma unroll
            for (int m = 0; m < 4; ++m) { float* rowp = O + (size_t)(row0 + ai * HALF + m * 16) * ldc + col0;
#pragma unroll
                for (int bj = 0; bj < 2; ++bj)
#pragma unroll
                    for (int n = 0; n < 2; ++n) *(f32x4*)(rowp + bj * HALF + n * 16) = acc[ai][bj][m][n]; }
    }
};
struct EpiProj {
    static constexpr bool PERM = true, AFTER_DRAIN = false;
    bf16_t* O; int ldc; int layer; const int* pos; float* logf; const float* bfg;
    __device__ __forceinline__ void operator()(const f32x4 (&acc)[2][2][4][2], const Unit& u, int wr, int wc, int fr, int fq) const {
        const int row0 = u.pm * BM + wr * 64 + fr, cw = wc * 32 + 8 * fq, col0 = u.pn * BM + cw;
        int mode; float sc = 1.f;
        if (layer == 0) { if (u.pn < 3) mode = 1; else if (u.pn == 3) { mode = 0; sc = QSCALE; } else if (u.pn < 7) { mode = 1; sc = 0.08838834764831845f; } else if (u.pn < 10) mode = 0; else mode = 4; }
        else { if (u.pn < 4) { mode = 0; sc = QSCALE; } else if (u.pn < 10) mode = 0; else mode = 5; }
        if (mode == 5) {
            if (wc == 0 && fq < 2) {
#pragma unroll
                for (int ai = 0; ai < 2; ++ai)
#pragma unroll
                    for (int m = 0; m < 4; ++m) { const int row = row0 + ai * HALF + m * 16;
#pragma unroll
                        for (int n = 0; n < 2; ++n)
#pragma unroll
                            for (int e = 0; e < 4; ++e) { const int c = 8 * fq + 4 * n + e;
                                if (c < 12) { const float z = acc[ai][0][m][n][e] + bfg[c]; const float az = fabsf(z);
                                    logf[(size_t)row * 16 + c] = fminf(z, 0.f) * LOG2E - __log2f(1.f + exp2f(-az * LOG2E)); } } }
            }
            return;
        }
        float invf[4];
        if (mode == 1) {
#pragma unroll
            for (int p = 0; p < 4; ++p) invf[p] = exp2f(-(float)((cw >> 1) + p) * (13.287712379549449f / 64.f)) * 0.15915494309189535f;
        }
#pragma unroll
        for (int ai = 0; ai < 2; ++ai)
#pragma unroll
            for (int m = 0; m < 4; ++m) { const int row = row0 + ai * HALF + m * 16; bf16_t* rowp = O + (size_t)row * ldc + col0;
                float cs[4], sn[4];
                if (mode == 1) { const float ps = (float)pos[row];
#pragma unroll
                    for (int p = 0; p < 4; ++p) { float rev = ps * invf[p]; rev = rev - floorf(rev); sn[p] = __builtin_amdgcn_sinf(rev); cs[p] = __builtin_amdgcn_cosf(rev); } }
#pragma unroll
                for (int bj = 0; bj < 2; ++bj) { f32x4 v0 = acc[ai][bj][m][0], v1 = acc[ai][bj][m][1];
                    if (mode == 1) {
                        const float a0 = v0[0] * cs[0] - v0[1] * sn[0], b0 = v0[0] * sn[0] + v0[1] * cs[0];
                        const float a1 = v0[2] * cs[1] - v0[3] * sn[1], b1 = v0[2] * sn[1] + v0[3] * cs[1];
                        const float a2 = v1[0] * cs[2] - v1[1] * sn[2], b2 = v1[0] * sn[2] + v1[1] * cs[2];
                        const float a3 = v1[2] * cs[3] - v1[3] * sn[3], b3 = v1[2] * sn[3] + v1[3] * cs[3];
                        v0 = (f32x4){a0, b0, a1, b1}; v1 = (f32x4){a2, b2, a3, b3};
                    } else if (mode == 4) {
#pragma unroll
                        for (int e = 0; e < 4; ++e) { v0[e] = v0[e] / (1.f + exp2f(-v0[e] * LOG2E)); v1[e] = v1[e] / (1.f + exp2f(-v1[e] * LOG2E)); }
                    }
                    v0 = v0 * sc; v1 = v1 * sc;
                    u32x4 w; w.x = cvt_pk_bf16(v0[0], v0[1]); w.y = cvt_pk_bf16(v0[2], v0[3]); w.z = cvt_pk_bf16(v1[0], v1[1]); w.w = cvt_pk_bf16(v1[2], v1[3]);
                    *(u32x4*)(rowp + bj * HALF) = w; } }
    }
};

template <class Epi, class Sched, bool ALIGN_EPI = false, bool SP2 = false>
__device__ __forceinline__ void gemm_phase(PG8_LAS unsigned char* lds, const Gemm g, const Sched& S, const Epi& E) {
    int tid_ = threadIdx.x; asm volatile("" : "+v"(tid_));
    const int tid = tid_, wid = __builtin_amdgcn_readfirstlane(tid >> 6), lane = tid & 63, wr = wid >> 2, wc = wid & 3, fr = lane & 15, fq = lane >> 4;
    const int K = g.K, nt = K / BK;
    unsigned voffA[2], voffB[2];
#pragma unroll
    for (int i = 0; i < 2; ++i) { int R, C; stage_rc(tid * 16 + i * 8192, R, C); const int Rb = Epi::PERM ? ((R & ~31) + perm32(R & 31)) : R;
        voffA[i] = (unsigned)(R * g.lda + C) * 2u; voffB[i] = (unsigned)(Rb * K + C) * 2u; }
    const size_t kstep = (size_t)(BK * 2);
    const size_t hstepA = (size_t)HALF * g.lda * 2, hstepB = (size_t)HALF * K * 2;
    const size_t tstepA = 2 * hstepA, tstepB = 2 * hstepB;
    const unsigned ldsw = (unsigned)wid * 1024u;
    const int aoff = lds_byte(wr * 64 + fr, fq * 8), boff = lds_byte(wc * 32 + fr, fq * 8);
#define PG8_SA(b, h) (((b) * 2 + (h)) * HTB)
#define PG8_SB(b, h) ((4 + (b) * 2 + (h)) * HTB)
#define PG8_STAGE(bufoff, gbase, voff) do { _Pragma("unroll") for (int _i = 0; _i < 2; ++_i) \
        __builtin_amdgcn_global_load_lds((const unsigned*)((const char*)(gbase) + (voff)[_i]), (PG8_LAS unsigned*)(lds + (bufoff) + ldsw + _i * 8192), 16, 0, 0); } while (0)
#define PG8_LDA(dst, b, h) do { _Pragma("unroll") for (int m = 0; m < 4; ++m) _Pragma("unroll") for (int k = 0; k < 2; ++k) dst[m][k] = *(const PG8_LAS bf16x8*)(lds + PG8_SA(b, h) + aoff + m * 2048 + k * 1024); } while (0)
#define PG8_LDB(dst, b, h) do { _Pragma("unroll") for (int n = 0; n < 2; ++n) _Pragma("unroll") for (int k = 0; k < 2; ++k) dst[n][k] = *(const PG8_LAS bf16x8*)(lds + PG8_SB(b, h) + boff + n * 2048 + k * 1024); } while (0)
#define PG8_MMA(ai, bj, At, Bt) do { __builtin_amdgcn_s_setprio(1); _Pragma("unroll") for (int m = 0; m < 4; ++m) _Pragma("unroll") for (int n = 0; n < 2; ++n) _Pragma("unroll") for (int k = 0; k < 2; ++k) \
        acc[ai][bj][m][n] = __builtin_amdgcn_mfma_f32_16x16x32_bf16(Bt[n][k], At[m][k], acc[ai][bj][m][n], 0, 0, 0); __builtin_amdgcn_s_setprio(0); } while (0)
#define PG8_WAIT_V(n) asm volatile("s_waitcnt vmcnt(" #n ")" ::: "memory")
#define PG8_WAIT_L(n) asm volatile("s_waitcnt lgkmcnt(" #n ")" ::: "memory")
#define PG8_BAR __builtin_amdgcn_s_barrier()
#define PG8_SCHED __builtin_amdgcn_sched_barrier(0)
    Unit cur, nxt; int ui = 0;
    if (!S.next(0, cur)) return;
    f32x4 acc[2][2][4][2];
#pragma unroll
    for (int a = 0; a < 2; ++a)
#pragma unroll
        for (int b = 0; b < 2; ++b)
#pragma unroll
            for (int m = 0; m < 4; ++m)
#pragma unroll
                for (int n = 0; n < 2; ++n) acc[a][b][m][n] = (f32x4){0.f, 0.f, 0.f, 0.f};
    bf16x8 At[4][2], B0[2][2], B1[2][2];
    const char* cA = (const char*)g.A + (size_t)cur.pm * tstepA; const char* cB = (const char*)g.Bt + (size_t)cur.pn * tstepB;
    S.a_ready(cur);
    if constexpr (SP2) {
        PG8_STAGE(PG8_SB(0, 0), cB, voffB); PG8_STAGE(PG8_SB(0, 1), cB + hstepB, voffB); PG8_STAGE(PG8_SA(0, 0), cA, voffA); PG8_STAGE(PG8_SA(0, 1), cA + hstepA, voffA);
        if (wr == 1) PG8_BAR;
        PG8_WAIT_V(2); PG8_BAR;
        PG8_STAGE(PG8_SB(1, 0), cB + kstep, voffB); PG8_STAGE(PG8_SA(1, 0), cA + kstep, voffA); PG8_STAGE(PG8_SB(1, 1), cB + hstepB + kstep, voffB);
        PG8_WAIT_V(6); PG8_BAR;
    } else {
        PG8_STAGE(PG8_SB(0, 0), cB, voffB); PG8_STAGE(PG8_SA(0, 0), cA, voffA); PG8_STAGE(PG8_SB(0, 1), cB + hstepB, voffB); PG8_STAGE(PG8_SA(0, 1), cA + hstepA, voffA);
        if (wr == 1) PG8_BAR;
        PG8_WAIT_V(4); PG8_BAR;
        PG8_STAGE(PG8_SB(1, 0), cB + kstep, voffB); PG8_STAGE(PG8_SA(1, 0), cA + kstep, voffA); PG8_STAGE(PG8_SB(1, 1), cB + hstepB + kstep, voffB);
        PG8_WAIT_V(6); PG8_BAR;
    }
    for (;;) {
        const bool has_next = S.next(ui + 1, nxt);
        const char* nA = has_next ? (const char*)g.A + (size_t)nxt.pm * tstepA : cA; const char* nB = has_next ? (const char*)g.Bt + (size_t)nxt.pn * tstepB : cB;
        for (int t = 0; t < nt; t += 2) {
            const bool last = (t == nt - 2);
            const char* a1 = cA + (size_t)(t + 1) * kstep;
            const char* a2 = last ? nA : cA + (size_t)(t + 2) * kstep; const char* b2 = last ? nB : cB + (size_t)(t + 2) * kstep;
            const char* a3 = a2 + kstep; const char* b3 = b2 + kstep;
            if (last && has_next) S.a_ready(nxt);
            if constexpr (SP2) {
            PG8_LDB(B0, 0, 0); PG8_LDB(B1, 0, 1); PG8_SCHED; PG8_LDA(At, 0, 0); PG8_STAGE(PG8_SA(1, 1), a1 + hstepA, voffA);
            PG8_WAIT_V(8); PG8_WAIT_L(0); PG8_BAR; PG8_MMA(0, 0, At, B0); PG8_MMA(0, 1, At, B1); PG8_BAR; PG8_SCHED;
            PG8_LDA(At, 0, 1); PG8_STAGE(PG8_SB(0, 0), b2, voffB); PG8_STAGE(PG8_SB(0, 1), b2 + hstepB, voffB); PG8_STAGE(PG8_SA(0, 0), a2, voffA);
            PG8_WAIT_V(8); PG8_WAIT_L(0); PG8_BAR; PG8_MMA(1, 0, At, B0); PG8_MMA(1, 1, At, B1); PG8_BAR; PG8_SCHED;
            PG8_LDB(B0, 1, 0); PG8_LDB(B1, 1, 1); PG8_SCHED; PG8_LDA(At, 1, 0); PG8_STAGE(PG8_SA(0, 1), a2 + hstepA, voffA);
            PG8_WAIT_V(8); PG8_WAIT_L(0); PG8_BAR; PG8_MMA(0, 0, At, B0); PG8_MMA(0, 1, At, B1); PG8_BAR; PG8_SCHED;
            PG8_LDA(At, 1, 1); PG8_STAGE(PG8_SB(1, 0), b3, voffB); PG8_STAGE(PG8_SB(1, 1), b3 + hstepB, voffB); PG8_STAGE(PG8_SA(1, 0), a3, voffA);
            PG8_WAIT_V(8); PG8_WAIT_L(0); PG8_BAR; PG8_MMA(1, 0, At, B0); PG8_MMA(1, 1, At, B1); PG8_BAR; PG8_SCHED;
            } else {
            PG8_LDB(B0, 0, 0); PG8_SCHED; PG8_LDA(At, 0, 0); PG8_STAGE(PG8_SA(1, 1), a1 + hstepA, voffA);
            PG8_WAIT_L(8); PG8_BAR; PG8_WAIT_L(0); PG8_MMA(0, 0, At, B0); PG8_BAR; PG8_SCHED;
            PG8_LDB(B1, 0, 1); PG8_STAGE(PG8_SB(0, 0), b2, voffB);
            PG8_BAR; PG8_WAIT_L(0); PG8_MMA(0, 1, At, B1); PG8_BAR;
            PG8_LDA(At, 0, 1); PG8_STAGE(PG8_SA(0, 0), a2, voffA);
            PG8_BAR; PG8_WAIT_L(0); PG8_MMA(1, 0, At, B0); PG8_BAR; PG8_SCHED;
            PG8_STAGE(PG8_SB(0, 1), b2 + hstepB, voffB);
            PG8_WAIT_V(6); PG8_BAR; PG8_MMA(1, 1, At, B1); PG8_BAR;
            PG8_LDB(B0, 1, 0); PG8_SCHED; PG8_LDA(At, 1, 0); PG8_STAGE(PG8_SA(0, 1), a2 + hstepA, voffA);
            PG8_WAIT_L(8); PG8_BAR; PG8_WAIT_L(0); PG8_MMA(0, 0, At, B0); PG8_BAR; PG8_SCHED;
            PG8_LDB(B1, 1, 1); PG8_STAGE(PG8_SB(1, 0), b3, voffB);
            PG8_BAR; PG8_WAIT_L(0); PG8_MMA(0, 1, At, B1); PG8_BAR;
            PG8_LDA(At, 1, 1); PG8_STAGE(PG8_SA(1, 0), a3, voffA);
            PG8_BAR; PG8_WAIT_L(0); PG8_MMA(1, 0, At, B0); PG8_BAR; PG8_SCHED;
            PG8_STAGE(PG8_SB(1, 1), b3 + hstepB, voffB);
            PG8_WAIT_V(6); PG8_BAR; PG8_MMA(1, 1, At, B1); PG8_BAR;
            }
        }
        if constexpr (ALIGN_EPI) { if (wr == 0) PG8_BAR; }
        if constexpr (!Epi::AFTER_DRAIN) { E(acc, cur, wr, wc, fr, fq); S.done(cur); }
        if (!has_next) break;
#pragma unroll
        for (int a = 0; a < 2; ++a)
#pragma unroll
            for (int b = 0; b < 2; ++b)
#pragma unroll
                for (int m = 0; m < 4; ++m)
#pragma unroll
                    for (int n = 0; n < 2; ++n) acc[a][b][m][n] = (f32x4){0.f, 0.f, 0.f, 0.f};
        cur = nxt; cA = nA; cB = nB; ++ui;
        if constexpr (ALIGN_EPI) { if (wr == 1) PG8_BAR; }
    }
    PG8_WAIT_V(0);
    if constexpr (!ALIGN_EPI) { if (wr == 0) PG8_BAR; }
    PG8_BAR;
    if constexpr (Epi::AFTER_DRAIN) { E.fused(acc, cur, wr, wc, fr, fq, lds, wid, lane); S.done(cur); }
#undef PG8_SA
#undef PG8_SB
#undef PG8_STAGE
#undef PG8_LDA
#undef PG8_LDB
#undef PG8_MMA
#undef PG8_WAIT_V
#undef PG8_WAIT_L
#undef PG8_BAR
#undef PG8_SCHED
}
}

constexpr size_t MiB = 1u << 20;
constexpr size_t WS_CTL = 0, CTL_ZERO_BYTES = 64 * 1024;
constexpr size_t WS_WIN0 = 1 * MiB;
constexpr size_t WS_WIN1 = WS_WIN0 + (size_t)NP0 * DM * 2;
constexpr size_t WS_WMEM = 13 * MiB;
constexpr size_t WS_WOUT = 15 * MiB;
constexpr size_t WS_WUP = 19 * MiB;
constexpr size_t WS_WDN = 35 * MiB;
constexpr size_t WS_MEMKV = 51 * MiB;
constexpr size_t WS_LOGF = 59 * MiB;
constexpr size_t WS_CS = 61 * MiB;
constexpr size_t WS_XN = 64 * MiB;
constexpr size_t WS_R1 = 128 * MiB;
constexpr size_t WS_H = 256 * MiB;
constexpr size_t WS_PROJ = 256 * MiB;
constexpr size_t WS_MEMN = 464 * MiB;
constexpr size_t WS_END = 512 * MiB;
static_assert(WS_WIN1 + (size_t)NP1 * DM * 2 <= WS_WMEM && WS_PROJ + (size_t)MTOK * NP0 * 2 <= WS_MEMN, "d_ws map");
constexpr int CW_BAR = 4096;

constexpr int RING_OFF = 0, RING_BYTES = 131072;
constexpr int LDSCTL_OFF = RING_BYTES, MISC_OFF = LDSCTL_OFF + 320;
constexpr int LDS_BYTES = 147456;
constexpr int NWAVES = 8;

#define GAS __attribute__((address_space(1)))
#define LAS __attribute__((address_space(3)))
typedef unsigned short bf16;
typedef unsigned v4u __attribute__((ext_vector_type(4)));
typedef float f32x4 __attribute__((ext_vector_type(4)));
typedef GAS unsigned gu32;
#define LDS_WAIT() asm volatile("s_waitcnt lgkmcnt(0)" ::: "memory")
#define VM_WAIT() asm volatile("s_waitcnt vmcnt(0)" ::: "memory")
__device__ __forceinline__ unsigned f2bf(float f) { unsigned u = __builtin_bit_cast(unsigned, f); return (u + 0x7fffu + ((u >> 16) & 1u)) >> 16; }
__device__ __forceinline__ unsigned pk2(float lo, float hi) { return f2bf(lo) | (f2bf(hi) << 16); }
__device__ __forceinline__ float bflo(unsigned u) { return __builtin_bit_cast(float, u << 16); }
__device__ __forceinline__ float bfhi(unsigned u) { return __builtin_bit_cast(float, u & 0xffff0000u); }

namespace attn_body {
using bf16=__hip_bfloat16;
using bf16x8=__attribute__((ext_vector_type(8)))short;
using s16x4=__attribute__((ext_vector_type(4)))short;
using f32x16=__attribute__((ext_vector_type(16)))float;
using u32x4=__attribute__((ext_vector_type(4)))unsigned;
using f32x4v=__attribute__((ext_vector_type(4)))float;
constexpr int BATCH=16,NHEAD=12,SEQ=2048,D=64,DM=2816;
constexpr int NW=8,QBLK=32,QB=QBLK*NW,KVBLK=64,NQB=SEQ/QB;
constexpr int ATTN_PITCH=DM, ATTN_UNIT_ROWS=QB;
__device__ __forceinline__ int crow(int r,int hi){return (r&3)+8*(r>>2)+4*hi;}
#define SBAR() __builtin_amdgcn_sched_barrier(0)
__device__ __forceinline__ void cmask(f32x16&p0,f32x16&p1,int jb,int qrel,int hi){
  const float NEG=-INFINITY; int kb=64*jb+4*hi;
  #pragma unroll
  for(int r=0;r<16;++r){int kv=kb+(r&3)+8*(r>>2); if(kv>qrel)p0[r]=NEG; if(kv+32>qrel)p1[r]=NEG;}
}

constexpr int NSLOT=3, SLOTB=8192;
constexpr int LDS_K=0, LDS_V=NSLOT*SLOTB, LDS_WS=2*NSLOT*SLOTB, LDS_OST=LDS_WS+NW*64*4, LDS_BIAS=LDS_OST+NW*4096, LDS_BYTES=LDS_BIAS+SEQ*4;
constexpr float C2=0.125f*1.4426950408889634f;
__device__ __forceinline__ void glds16(const void*gsrc,unsigned lds_dst){unsigned keep;
  asm volatile("s_mov_b32 %0, m0\n\ts_mov_b32 m0, %2\n\ts_nop 0\n\tglobal_load_lds_dwordx4 %1, off\n\ts_mov_b32 m0, %0":"=&s"(keep):"v"(gsrc),"s"(lds_dst):"memory");}
__device__ __forceinline__ float max3f(float a,float b,float c){float r;asm("v_max3_f32 %0, %1, %2, %3":"=v"(r):"v"(a),"v"(b),"v"(c));return r;}
__device__ __forceinline__ float max2f(float a,float b){float r;asm("v_max_f32_e32 %0, %1, %2":"=v"(r):"v"(a),"v"(b));return r;}
__device__ __forceinline__ float fadd_s(float a,float b){float r;asm("v_add_f32_e32 %0, %1, %2":"=v"(r):"v"(a),"v"(b));return r;}
__device__ __forceinline__ float fsub_s(float a,float b){float r;asm("v_sub_f32_e32 %0, %1, %2":"=v"(r):"v"(a),"v"(b));return r;}
typedef float f32x2_t __attribute__((ext_vector_type(2))); typedef __bf16 bf16x2_t __attribute__((ext_vector_type(2)));
__device__ __forceinline__ unsigned cvtpk_s(float lo,float hi){f32x2_t v={lo,hi};bf16x2_t b=__builtin_convertvector(v,bf16x2_t);return __builtin_bit_cast(unsigned,b);}
#define WAIT_BAR(N) asm volatile("s_waitcnt vmcnt(" #N ") lgkmcnt(0)\n\ts_barrier":::"memory")

__device__ __forceinline__ void qkt(f32x16&p0,f32x16&p1,const char*Kslot,const bf16x8*qr,const f32x16&c0i,const f32x16&c1i,int r32,int hi){
  const char*kb=Kslot+hi*1024+r32*16;
  #pragma unroll
  for(int d0=0;d0<4;++d0){
    const bf16x8 b0=*reinterpret_cast<const bf16x8*>(kb+d0*2048);
    const bf16x8 b1=*reinterpret_cast<const bf16x8*>(kb+d0*2048+512);
    if(d0==0){p0=__builtin_amdgcn_mfma_f32_32x32x16_bf16(b0,qr[0],c0i,0,0,0);p1=__builtin_amdgcn_mfma_f32_32x32x16_bf16(b1,qr[0],c1i,0,0,0);}
    else{p0=__builtin_amdgcn_mfma_f32_32x32x16_bf16(b0,qr[d0],p0,0,0,0);p1=__builtin_amdgcn_mfma_f32_32x32x16_bf16(b1,qr[d0],p1,0,0,0);}}
}
typedef __attribute__((address_space(3))) const char* lds_cptr;
typedef short v4i16_t __attribute__((ext_vector_type(4)));
__device__ __forceinline__ void kload8(bf16x8*kf,lds_cptr kp){
  kf[0]=*(const __attribute__((address_space(3))) bf16x8*)(kp);      kf[1]=*(const __attribute__((address_space(3))) bf16x8*)(kp+512);
  kf[2]=*(const __attribute__((address_space(3))) bf16x8*)(kp+2048); kf[3]=*(const __attribute__((address_space(3))) bf16x8*)(kp+2560);
  kf[4]=*(const __attribute__((address_space(3))) bf16x8*)(kp+4096); kf[5]=*(const __attribute__((address_space(3))) bf16x8*)(kp+4608);
  kf[6]=*(const __attribute__((address_space(3))) bf16x8*)(kp+6144); kf[7]=*(const __attribute__((address_space(3))) bf16x8*)(kp+6656);
}
__device__ __forceinline__ void kload2(bf16x8*kf,lds_cptr kp,int j){ kf[2*j]=*(const __attribute__((address_space(3))) bf16x8*)(kp+j*2048); kf[2*j+1]=*(const __attribute__((address_space(3))) bf16x8*)(kp+j*2048+512); }
__device__ __forceinline__ s16x4 vtr(lds_cptr p){ return __builtin_bit_cast(s16x4,__builtin_amdgcn_ds_read_tr16_b64_v4i16((__attribute__((address_space(3))) v4i16_t*)p)); }
__device__ __forceinline__ float rowmax(const f32x16&p0,const f32x16&p1){
  float a=max3f(p0[0],p0[1],p1[0]),b=max3f(p0[2],p0[3],p1[1]);a=max3f(a,p1[2],p1[3]);
  #pragma unroll
  for(int r=4;r<16;r+=4){a=max3f(a,p0[r],p0[r+1]);b=max3f(b,p0[r+2],p0[r+3]);a=max3f(a,p1[r],p1[r+1]);b=max3f(b,p1[r+2],p1[r+3]);}
  const float m=max2f(a,b);
  auto rr=__builtin_amdgcn_permlane32_swap(__float_as_uint(m),__float_as_uint(m),false,false);
  return max2f(__uint_as_float(rr[0]),__uint_as_float(rr[1]));
}
__device__ __forceinline__ void pv(f32x16*o,int vb,bf16x8 pa0,bf16x8 pa1,bf16x8 pa2,bf16x8 pa3){
  #pragma unroll
  for(int d0=0;d0<2;++d0){s16x4 lo[4],hi[4];
    #pragma unroll
    for(int ks=0;ks<4;++ks){
      asm volatile("ds_read_b64_tr_b16 %0,%1 offset:%c2":"=&v"(lo[ks]):"v"(vb),"i"(d0*4096+ks*1024):"memory");
      asm volatile("ds_read_b64_tr_b16 %0,%1 offset:%c2":"=&v"(hi[ks]):"v"(vb),"i"(d0*4096+ks*1024+512):"memory");}
    asm volatile("s_waitcnt lgkmcnt(0)":::"memory");SBAR();
    #define PK(k) (bf16x8){lo[k][0],lo[k][1],lo[k][2],lo[k][3],hi[k][0],hi[k][1],hi[k][2],hi[k][3]}
    o[d0]=__builtin_amdgcn_mfma_f32_32x32x16_bf16(pa0,PK(0),o[d0],0,0,0);
    o[d0]=__builtin_amdgcn_mfma_f32_32x32x16_bf16(pa1,PK(1),o[d0],0,0,0);
    o[d0]=__builtin_amdgcn_mfma_f32_32x32x16_bf16(pa2,PK(2),o[d0],0,0,0);
    o[d0]=__builtin_amdgcn_mfma_f32_32x32x16_bf16(pa3,PK(3),o[d0],0,0,0);
    #undef PK
  }
}

#ifndef ATTN_STORE16
#define ATTN_STORE16(p,v) (*(u32x4*)(p)=(v))
#endif
template<int THRL,int PQ,int PKV,bool CAUSAL,bool BIAS> __device__ __forceinline__ void attn_unit(const bf16*Qu,const bf16*__restrict__ Kh,const bf16*__restrict__ Vh,bf16*Ou,const int PO,const float*cs,const int NT,char*shm){
  const int tid=threadIdx.x,lane=tid&63,r32=lane&31,hi=lane>>5; const int wid=__builtin_amdgcn_readfirstlane(tid>>6);
  const bf16*Qw=Qu+(long)(wid*QBLK)*PQ;
  const unsigned lds0=(unsigned)(uintptr_t)shm;
  float*wsf=(float*)(shm+LDS_WS)+wid*64;
  const bf16*ksrc=Kh+(long)lane*PKV+wid*8;
  const bf16*vsrc=Vh+(long)(16*(wid&3)+(lane>>2))*PKV+(wid>>2)*32+(lane&3)*8;
  const unsigned kdst=lds0+LDS_K+wid*1024, vdst=lds0+LDS_V+wid*1024;
  #define DMA_K(t,slot) glds16(ksrc+(long)(t)*KVBLK*PKV,(unsigned)__builtin_amdgcn_readfirstlane(kdst+(slot)))
  #define DMA_V(t,slot) glds16(vsrc+(long)(t)*KVBLK*PKV,(unsigned)__builtin_amdgcn_readfirstlane(vdst+(slot)))
  const int vb0=(int)(lds0+LDS_V)+((lane>>4)&1)*32+(lane&3)*8+(4*hi+((lane&15)>>2))*64;
  const char*Kbase=shm+LDS_K; bf16x8 kf[8];
  const lds_cptr shm3=(lds_cptr)shm; const lds_cptr kp0=shm3+LDS_K+hi*1024+r32*16; const lds_cptr vp0=shm3+LDS_V+((lane>>4)&1)*32+(lane&3)*8+(4*hi+((lane&15)>>2))*64;
  typedef __attribute__((address_space(3))) float lds_f32; typedef __attribute__((address_space(3))) const f32x4v lds_cf4;
  lds_f32*biasw=(lds_f32*)(shm3+LDS_BIAS);
  { int tb_=tid; asm volatile("":"+v"(tb_));
    if(BIAS){ _Pragma("clang loop vectorize(disable) unroll(disable)") for(int i=tb_;i<NT*KVBLK;i+=NW*64)biasw[i]=-cs[i]; } }
  const lds_cf4*biasr=(const lds_cf4*)(shm3+LDS_BIAS)+hi;
  #define BINIT(C0,C1,t,mh) do{ if(BIAS){ _Pragma("unroll") for(int g_=0;g_<4;++g_){ const f32x4v b0_=biasr[16*(t)+2*g_], b1_=biasr[16*(t)+8+2*g_]; \
      C0[4*g_]=b0_[0]-(mh);C0[4*g_+1]=b0_[1]-(mh);C0[4*g_+2]=b0_[2]-(mh);C0[4*g_+3]=b0_[3]-(mh); C1[4*g_]=b1_[0]-(mh);C1[4*g_+1]=b1_[1]-(mh);C1[4*g_+2]=b1_[2]-(mh);C1[4*g_+3]=b1_[3]-(mh);} } \
    else { const float nm_=-(mh); _Pragma("unroll") for(int r_=0;r_<16;++r_){C0[r_]=nm_;C1[r_]=nm_;} } }while(0)
  DMA_K(0,0);DMA_V(0,0);DMA_K(1,SLOTB);
  bf16x8 qr[4];
  #pragma unroll
  for(int d0=0;d0<4;++d0)qr[d0]=*reinterpret_cast<const bf16x8*>(&Qw[(long)r32*PQ+d0*16+hi*8]);
  float mhat=0.f,l_reg=0.f;f32x16 o[2];o[0]=f32x16{};o[1]=f32x16{};
  const int qrel=wid*QBLK+r32;
  #define CMASK(P0,P1,t) do{ if(CAUSAL){int jb_=(t)-(NT-4); if(jb_>=0)cmask(P0,P1,jb_,qrel,hi);} }while(0)
  bool resc=false;
  #define START(P0,P1) do{ const float rm=rowmax(P0,P1); resc=false; \
    { const float dl=rm; mhat=fadd_s(mhat,dl); \
      _Pragma("unroll") for(int r=0;r<16;++r){P0[r]=fsub_s(P0[r],dl);P1[r]=fsub_s(P1[r],dl);} \
      } \
    _Pragma("unroll") for(int r=0;r<16;++r)P0[r]=__builtin_amdgcn_exp2f(P0[r]); }while(0)
  #define RESC() do{ if(resc){ asm volatile("s_waitcnt lgkmcnt(0)":::"memory"); \
      _Pragma("unroll") for(int d_=0;d_<2;++d_) _Pragma("unroll") for(int r=0;r<16;++r)o[d_][r]*=wsf[crow(r,hi)]; } }while(0)
  f32x16 pA0,pA1,pB0,pB1;
  int sl_prev=0,sl_cur=0,sl_next=SLOTB;
  #define ROT() do{sl_prev=sl_cur;sl_cur=sl_next;sl_next=(sl_next==(NSLOT-1)*SLOTB)?0:sl_next+SLOTB;}while(0)
  DMA_K(2,2*SLOTB);
  WAIT_BAR(3);
  BINIT(pA0,pA1,0,0.f);
  qkt(pA0,pA1,Kbase,qr,pA0,pA1,r32,hi);asm volatile("s_nop 15\n\ts_nop 7":"+v"(pA0),"+v"(pA1));CMASK(pA0,pA1,0);
  START(pA0,pA1);
  _Pragma("unroll") for(int r=0;r<16;++r)pA1[r]=__builtin_amdgcn_exp2f(pA1[r]);
  WAIT_BAR(0);
  DMA_K(3,0);DMA_V(1,SLOTB);
  ROT();
  kload8(kf,kp0+sl_cur);
  WAIT_BAR(2);
  s16x4 vlo[8],vhi[8]; u32x4 pw0,pw1,pw2,pw3;
  #define PKW(P,B) cvtpk_s(P[B],P[B+1])
  #define PAF(k) __builtin_bit_cast(bf16x8,pw##k)
  #define VFR(i) (bf16x8){vlo[i][0],vlo[i][1],vlo[i][2],vlo[i][3],vhi[i][0],vhi[i][1],vhi[i][2],vhi[i][3]}
  #define PIN(x) asm volatile("":"+v"(x))
  #define MX3(a,b,c) __builtin_fmaxf(__builtin_fmaxf((a),(b)),(c))
  #define GAPA(MF,A0,A1,A2,A3,W0,W1,PW) do{ MF; sacc+=A0; sacc+=A1; sacc+=A2; sacc+=A3; PIN(sacc); W0; W1; PIN(PW); SBAR(); }while(0)
  #define EX(v) __builtin_amdgcn_exp2f(v)
  #define GAPB(MF,X,B) do{ MF; X[B]=EX(X[B]); X[B+1]=EX(X[B+1]); X[B+2]=EX(X[B+2]); X[B+3]=EX(X[B+3]); PIN(X); SBAR(); }while(0)
  #define VRD(i) do{ vlo[i]=vtr(vp_+(((i)>>2)*4096+((i)&3)*1024)); vhi[i]=vtr(vp_+(((i)>>2)*4096+((i)&3)*1024+512)); }while(0)
  #define KRD(G,j) do{ if(G){ kload2(kf,kp0+sl_next,j); SBAR(); } }while(0)
  #define STEP(C0,C1,P0,P1,t,GK,GV,GL) do{ SBAR(); \
    BINIT(C0,C1,t,mhat); SBAR(); \
    const lds_cptr vp_=vp0+sl_prev; \
    VRD(0); SBAR(); float sacc=(P0[0]+P0[1]); \
    GAPA(C0=__builtin_amdgcn_mfma_f32_32x32x16_bf16(kf[0],qr[0],C0,0,0,0), P0[2],P0[3],P0[4],P0[5],     pw0[0]=PKW(P0,0), pw0[1]=PKW(P0,2), pw0); \
    VRD(4); SBAR(); GAPA(C1=__builtin_amdgcn_mfma_f32_32x32x16_bf16(kf[1],qr[0],C1,0,0,0), P0[6],P0[7],P0[8],P0[9],     pw0[2]=PKW(P0,4), pw0[3]=PKW(P0,6), pw0); \
    VRD(1); SBAR(); GAPA(C0=__builtin_amdgcn_mfma_f32_32x32x16_bf16(kf[2],qr[1],C0,0,0,0),   P0[10],P0[11],P0[12],P0[13], pw1[0]=PKW(P0,8), pw1[1]=PKW(P0,10), pw1); \
    VRD(5); SBAR(); GAPA(C1=__builtin_amdgcn_mfma_f32_32x32x16_bf16(kf[3],qr[1],C1,0,0,0),   P0[14],P0[15],P1[0],P1[1],   pw1[2]=PKW(P0,12),pw1[3]=PKW(P0,14), pw1); \
    VRD(2); SBAR(); GAPA(C0=__builtin_amdgcn_mfma_f32_32x32x16_bf16(kf[4],qr[2],C0,0,0,0),   P1[2],P1[3],P1[4],P1[5],     pw2[0]=PKW(P1,0), pw2[1]=PKW(P1,2), pw2); \
    VRD(6); SBAR(); GAPA(C1=__builtin_amdgcn_mfma_f32_32x32x16_bf16(kf[5],qr[2],C1,0,0,0),   P1[6],P1[7],P1[8],P1[9],     pw2[2]=PKW(P1,4), pw2[3]=PKW(P1,6), pw2); \
    VRD(3); SBAR(); GAPA(C0=__builtin_amdgcn_mfma_f32_32x32x16_bf16(kf[6],qr[3],C0,0,0,0),   P1[10],P1[11],P1[12],P1[13], pw3[0]=PKW(P1,8), pw3[1]=PKW(P1,10), pw3); \
    VRD(7); SBAR(); GAPA(C1=__builtin_amdgcn_mfma_f32_32x32x16_bf16(kf[7],qr[3],C1,0,0,0),   P1[14],P1[15],0.f,0.f,       pw3[2]=PKW(P1,12),pw3[3]=PKW(P1,14), pw3); \
    l_reg+=sacc; \
    if(GK){DMA_K((t)+3,sl_cur);} if(GV){DMA_V((t)+1,sl_next);} \
    CMASK(C0,C1,t); \
    { float a=MX3(C0[0],C0[1],C1[0]),b=MX3(C0[2],C0[3],C1[1]); a=MX3(a,C1[2],C1[3]); \
      _Pragma("unroll") for(int r=4;r<16;r+=4){a=MX3(a,C0[r],C0[r+1]);b=MX3(b,C0[r+2],C0[r+3]);a=MX3(a,C1[r],C1[r+1]);b=MX3(b,C1[r+2],C1[r+3]);} \
      float rm=__builtin_fmaxf(a,b); { auto rr=__builtin_amdgcn_permlane32_swap(__float_as_uint(rm),__float_as_uint(rm),false,false); rm=__builtin_fmaxf(__uint_as_float(rr[0]),__uint_as_float(rr[1])); } \
      resc=false; \
      if(__builtin_expect(__any(rm>(float)THRL),0)){ const float dl=__builtin_fmaxf(rm,0.f); mhat+=dl; \
        _Pragma("unroll") for(int r=0;r<16;++r){C0[r]-=dl;C1[r]-=dl;} \
        const float f=__builtin_amdgcn_exp2f(-dl); l_reg*=f; if(hi==0)wsf[r32]=f; resc=true; } } \
    SBAR(); \
    GAPB(o[0]=__builtin_amdgcn_mfma_f32_32x32x16_bf16(PAF(0),VFR(0),o[0],0,0,0), C0,0); \
    GAPB(o[1]=__builtin_amdgcn_mfma_f32_32x32x16_bf16(PAF(0),VFR(4),o[1],0,0,0), C0,4); \
    KRD(GL,0); GAPB(o[0]=__builtin_amdgcn_mfma_f32_32x32x16_bf16(PAF(1),VFR(1),o[0],0,0,0), C0,8); \
    KRD(GL,1); GAPB(o[1]=__builtin_amdgcn_mfma_f32_32x32x16_bf16(PAF(1),VFR(5),o[1],0,0,0), C0,12); \
    KRD(GL,2); GAPB(o[0]=__builtin_amdgcn_mfma_f32_32x32x16_bf16(PAF(2),VFR(2),o[0],0,0,0), C1,0); \
    KRD(GL,3); GAPB(o[1]=__builtin_amdgcn_mfma_f32_32x32x16_bf16(PAF(2),VFR(6),o[1],0,0,0), C1,4); \
    GAPB(o[0]=__builtin_amdgcn_mfma_f32_32x32x16_bf16(PAF(3),VFR(3),o[0],0,0,0), C1,8); \
    GAPB(o[1]=__builtin_amdgcn_mfma_f32_32x32x16_bf16(PAF(3),VFR(7),o[1],0,0,0), C1,12); \
    }while(0)
  int t=1;
  #undef CMASK
  #define CMASK(P0,P1,t) do{}while(0)
  for(;t+5<NT;t+=2){
    STEP(pB0,pB1,pA0,pA1,t,true,true,true);     WAIT_BAR(2); RESC(); ROT();
    STEP(pA0,pA1,pB0,pB1,t+1,true,true,true);   WAIT_BAR(2); RESC(); ROT();
  }
  #undef CMASK
  #define CMASK(P0,P1,t) do{ if(CAUSAL){int jb_=(t)-(NT-4); if(jb_>=0)cmask(P0,P1,jb_,qrel,hi);} }while(0)
  #define ENDW(tt) do{ if((tt)+3<NT){WAIT_BAR(2);} else if((tt)+2<NT){WAIT_BAR(1);} else {WAIT_BAR(0);} }while(0)
  for(;t+1<NT;t+=2){
    STEP(pB0,pB1,pA0,pA1,t,(t+3<NT),(t+1<NT),(t+1<NT));       ENDW(t);   RESC(); ROT();
    STEP(pA0,pA1,pB0,pB1,t+1,(t+4<NT),(t+2<NT),(t+2<NT));     ENDW(t+1); RESC(); ROT();
  }
  STEP(pB0,pB1,pA0,pA1,NT-1,false,false,false); RESC();
  { float sacc=pB0[0]+pB0[1]; _Pragma("unroll") for(int r=2;r<16;++r)sacc+=pB0[r]; _Pragma("unroll") for(int r=0;r<16;++r)sacc+=pB1[r]; l_reg+=sacc;
    pw0=(u32x4){PKW(pB0,0),PKW(pB0,2),PKW(pB0,4),PKW(pB0,6)};pw1=(u32x4){PKW(pB0,8),PKW(pB0,10),PKW(pB0,12),PKW(pB0,14)};pw2=(u32x4){PKW(pB1,0),PKW(pB1,2),PKW(pB1,4),PKW(pB1,6)};pw3=(u32x4){PKW(pB1,8),PKW(pB1,10),PKW(pB1,12),PKW(pB1,14)};
    SBAR(); pv(o,vb0+sl_cur,PAF(0),PAF(1),PAF(2),PAF(3)); }
  #undef PKW
  #undef PAF
  #undef VFR
  #undef PIN
  #undef MX3
  #undef GAPA
  #undef GAPB
  #undef EX
  #undef VRD
  #undef KRD
  #undef STEP
  #undef ENDW
  {auto rr=__builtin_amdgcn_permlane32_swap(__float_as_uint(l_reg),__float_as_uint(l_reg),false,false);l_reg=__uint_as_float(rr[0])+__uint_as_float(rr[1]);}
  if(hi==0)wsf[32+r32]=l_reg;asm volatile("s_waitcnt lgkmcnt(0)":::"memory");
  float rli[16];
  #pragma unroll
  for(int r=0;r<16;++r)rli[r]=__builtin_amdgcn_rcpf(wsf[32+crow(r,hi)]);
  bf16*Ow=Ou+(long)(wid*QBLK)*PO;
  { bf16*stg=(bf16*)(shm+LDS_OST)+wid*2048;
    #pragma unroll
    for(int r=0;r<16;++r){const int orow=crow(r,hi);
      #pragma unroll
      for(int d0=0;d0<2;++d0)stg[orow*64+d0*32+r32]=__float2bfloat16(o[d0][r]*rli[r]);}
    asm volatile("s_waitcnt lgkmcnt(0)":::"memory");
    #pragma unroll
    for(int i=0;i<4;++i){const int row=i*8+(lane>>3),ch=lane&7; const u32x4 v=*(const u32x4*)(stg+row*64+ch*8); ATTN_STORE16(Ow+(long)row*PO+ch*8,v);} }
  asm volatile("s_waitcnt lgkmcnt(0)\n\ts_barrier":::"memory");
  #undef BINIT
  #undef DMA_K
  #undef DMA_V
  #undef CMASK
  #undef START
  #undef RESC
  #undef ROT
}
constexpr int ATTN_LDS_BYTES=LDS_BYTES;
template<int THRL=8> __device__ __forceinline__ void fox_phase(char*lds,const bf16*PROJ,const float*CS,bf16*O,const int PO,int grid,int block){
  constexpr int PQ=2816; const int vcu=(block%8)*(grid/8)+block/8;
  for(int i=0;i<6;++i){ const int p=vcu*3+(i>>1), bh=p>>2, x=p&3, qb=(i&1)?7-x:x, b=bh/12, h=bh%12;
    const bf16*rowb=PROJ+(long)b*SEQ*PQ;
    attn_unit<THRL,PQ,PQ,true,true>(rowb+(long)qb*QB*PQ+0+h*D, rowb+1024+h*D, rowb+1792+h*D, O+((long)b*SEQ+(long)qb*QB)*PO+h*D, PO, CS+(long)bh*SEQ, 4*qb+4, lds); }
}
template<int PQ,int THRL=8> __device__ __forceinline__ void mem_phase(char*lds,const bf16*PROJ,const bf16*MEMKV,bf16*O,const int PO,int layer,int u0,int ustride){
  for(int u=u0;u<512;u+=ustride){ const int b=u>>5, hm=(u>>3)&3, qb=u&7;
    const bf16*qp=PROJ+((long)b*SEQ+(long)qb*QB)*PQ+768+hm*D; const bf16*kv=MEMKV+(long)b*256*1024+layer*512+hm*D;
    attn_unit<THRL,PQ,1024,false,false>(qp, kv, kv+256, O+((long)b*SEQ+(long)qb*QB)*PO+hm*D, PO, nullptr, 4, lds); }
}
#undef SBAR
#undef WAIT_BAR
}
namespace ret_body {
using attn_body::bf16x8; using attn_body::s16x4; using attn_body::f32x16; using attn_body::u32x4; using attn_body::f32x4v; using attn_body::crow; using attn_body::cvtpk_s;
typedef __attribute__((address_space(3))) unsigned char* lptr;
typedef short v4i16_t __attribute__((ext_vector_type(4)));
constexpr int RP = 3328;
constexpr int KC = 0, KT = 32768, VT = 65536, ST = 98304, PSUM = 131072 + 1024;
__device__ __forceinline__ s16x4 trd(lptr p) { return __builtin_bit_cast(s16x4, __builtin_amdgcn_ds_read_tr16_b64_v4i16((__attribute__((address_space(3))) v4i16_t*)p)); }
__device__ __forceinline__ bf16x8 frag2(lptr p, int off) { const s16x4 lo = trd(p + off), hi = trd(p + off + 512  ); return (bf16x8){lo[0], lo[1], lo[2], lo[3], hi[0], hi[1], hi[2], hi[3]}; }
__device__ __forceinline__ bf16x8 frag2n(lptr p, int off) { const s16x4 lo = trd(p + off), hi = trd(p + off + 256  ); return (bf16x8){lo[0], lo[1], lo[2], lo[3], hi[0], hi[1], hi[2], hi[3]}; }
__device__ __forceinline__ float bfl(unsigned u) { return __builtin_bit_cast(float, u << 16); }
__device__ __forceinline__ float bfh(unsigned u) { return __builtin_bit_cast(float, u & 0xffff0000u); }
__device__ __forceinline__ u32x4 scale8(u32x4 v, float s) { u32x4 r; r.x = cvtpk_s(bfl(v.x) * s, bfh(v.x) * s); r.y = cvtpk_s(bfl(v.y) * s, bfh(v.y) * s); r.z = cvtpk_s(bfl(v.z) * s, bfh(v.z) * s); r.w = cvtpk_s(bfl(v.w) * s, bfh(v.w) * s); return r; }
#define RBAR() asm volatile("s_waitcnt vmcnt(0) lgkmcnt(0)\n\ts_barrier" ::: "memory")
#define RBAR_L() asm volatile("s_waitcnt lgkmcnt(0)\n\ts_barrier" ::: "memory")

__device__ __forceinline__ void ret_unit(int b, int h, unsigned short* PROJ, unsigned short* O, const int OP, lptr lds) {
    int tid_ = threadIdx.x; asm volatile("" : "+v"(tid_));
    const int tid = tid_, lane = tid & 63, r32 = lane & 31, hi = lane >> 5; const int wid = __builtin_amdgcn_readfirstlane(tid >> 6), g = wid >> 1, e = wid & 1;
    const float lg = __log2f(1.f - exp2f(-5.f - (float)h));
    const float g128 = exp2f(128.f * lg);
    unsigned short* base = PROJ + (size_t)b * SEQ * RP + h * 128;
    const int tt = tid >> 2, qq = tid & 3;
    const float vsc = exp2f(-(float)(tt + 1) * lg);
    const unsigned short* kg = base + (size_t)tt * RP + C_K + qq * 32; const unsigned short* vg = base + (size_t)tt * RP + C_V + qq * 32;
    lptr kc_w = lds + KC + (4 * qq) * 2048 + tt * 16, kt_w = lds + KT + qq * 8192 + tt * 64, vt_w = lds + VT + qq * 8192 + tt * 64;
    lptr kc_r = lds + KC + hi * 2048 + r32 * 16;
    const int trb = ((lane >> 4) & 1) * 32 + (lane & 3) * 8;
    const int trp = (4 * hi + ((lane & 15) >> 2)) * 64 + trb, trn = (8 * hi + ((lane & 15) >> 2)) * 64 + trb;
    lptr vt_r = lds + VT + (2 * e) * 8192 + trp, kt_r = lds + KT + g * 8192 + trp, st_r = lds + ST + (2 * e) * 8192 + trn;
    lptr st_w = lds + ST + (2 * e) * 8192 + (32 * g) * 64 + r32 * 2;
    __attribute__((address_space(3))) float* psum = (__attribute__((address_space(3))) float*)(lds + PSUM);
    u32x4 kp[4], vp[4];
#pragma unroll
    for (int i = 0; i < 4; ++i) { kp[i] = *(const u32x4*)(kg + i * 8); vp[i] = *(const u32x4*)(vg + i * 8); }
    f32x16 st[2]; st[0] = f32x16{}; st[1] = f32x16{};
#pragma unroll
    for (int d = 0; d < 2; ++d)
#pragma unroll
        for (int r = 0; r < 16; ++r) *(__attribute__((address_space(3))) unsigned short*)(st_w + d * 8192 + crow(r, hi) * 64) = 0;
#pragma unroll
    for (int i = 0; i < 4; ++i) { *(__attribute__((address_space(3))) u32x4*)(kc_w + i * 2048) = kp[i]; *(__attribute__((address_space(3))) u32x4*)(kt_w + i * 16) = kp[i];
        *(__attribute__((address_space(3))) u32x4*)(vt_w + i * 16) = scale8(vp[i], vsc); }
    bf16x8 qr[8];
    { const unsigned short* qg = base + (size_t)(32 * g + r32) * RP + C_Q + hi * 8;
#pragma unroll
      for (int d0 = 0; d0 < 8; ++d0) qr[d0] = *(const bf16x8*)(qg + d0 * 16); }
#pragma unroll
    for (int i = 0; i < 4; ++i) { kp[i] = *(const u32x4*)(kg + (size_t)128 * RP + i * 8); vp[i] = *(const u32x4*)(vg + (size_t)128 * RP + i * 8); }
    RBAR_L();
    for (int c = 0; c < 16; ++c) {
        f32x16 o[2]; o[0] = f32x16{}; o[1] = f32x16{};
#pragma unroll 2
        for (int d0 = 0; d0 < 8; ++d0) { const bf16x8 s0 = frag2n(st_r, d0 * 1024), s1 = frag2n(st_r, d0 * 1024 + 8192);
            o[0] = __builtin_amdgcn_mfma_f32_32x32x16_bf16(qr[d0], s0, o[0], 0, 0, 0); o[1] = __builtin_amdgcn_mfma_f32_32x32x16_bf16(qr[d0], s1, o[1], 0, 0, 0); }
        for (int jb = 0; jb <= g; ++jb) {
            f32x16 p = f32x16{};
#pragma unroll
            for (int d0 = 0; d0 < 8; ++d0) { const bf16x8 kf = *(const __attribute__((address_space(3))) bf16x8*)(kc_r + d0 * 4096 + jb * 512); p = __builtin_amdgcn_mfma_f32_32x32x16_bf16(kf, qr[d0], p, 0, 0, 0); }
            if (jb == g) {
#pragma unroll
                for (int r = 0; r < 16; ++r) if (crow(r, hi) > r32) p[r] = 0.f; }
            u32x4 pw0, pw1; pw0.x = cvtpk_s(p[0], p[1]); pw0.y = cvtpk_s(p[2], p[3]); pw0.z = cvtpk_s(p[4], p[5]); pw0.w = cvtpk_s(p[6], p[7]);
            pw1.x = cvtpk_s(p[8], p[9]); pw1.y = cvtpk_s(p[10], p[11]); pw1.z = cvtpk_s(p[12], p[13]); pw1.w = cvtpk_s(p[14], p[15]);
            const bf16x8 v00 = frag2(vt_r, (2 * jb) * 1024), v01 = frag2(vt_r, (2 * jb) * 1024 + 8192), v10 = frag2(vt_r, (2 * jb + 1) * 1024), v11 = frag2(vt_r, (2 * jb + 1) * 1024 + 8192);
            o[0] = __builtin_amdgcn_mfma_f32_32x32x16_bf16(__builtin_bit_cast(bf16x8, pw0), v00, o[0], 0, 0, 0); o[1] = __builtin_amdgcn_mfma_f32_32x32x16_bf16(__builtin_bit_cast(bf16x8, pw0), v01, o[1], 0, 0, 0);
            o[0] = __builtin_amdgcn_mfma_f32_32x32x16_bf16(__builtin_bit_cast(bf16x8, pw1), v10, o[0], 0, 0, 0); o[1] = __builtin_amdgcn_mfma_f32_32x32x16_bf16(__builtin_bit_cast(bf16x8, pw1), v11, o[1], 0, 0, 0);
        }
        u32x4 gt[4];
        { const unsigned short* gg = base + (size_t)(c * 128 + 32 * g + (lane >> 1)) * RP + C_G + 64 * e + 32 * (lane & 1);
#pragma unroll
          for (int i = 0; i < 4; ++i) gt[i] = *(const u32x4*)(gg + 8 * i); }
        if (c < 15) { const unsigned short* qg = base + (size_t)((c + 1) * 128 + 32 * g + r32) * RP + C_Q + hi * 8;
#pragma unroll
            for (int d0 = 0; d0 < 8; ++d0) qr[d0] = *(const bf16x8*)(qg + d0 * 16); }
#pragma unroll 2
        for (int s = 0; s < 8; ++s) { const bf16x8 ka = frag2(kt_r, s * 1024), v0 = frag2(vt_r, s * 1024), v1 = frag2(vt_r, s * 1024 + 8192);
            st[0] = __builtin_amdgcn_mfma_f32_32x32x16_bf16(ka, v0, st[0], 0, 0, 0); st[1] = __builtin_amdgcn_mfma_f32_32x32x16_bf16(ka, v1, st[1], 0, 0, 0); }
#pragma unroll
        for (int r = 0; r < 16; ++r) { st[0][r] *= g128; st[1][r] *= g128; }
        float tot; int rstar;
        { float a8[8], b4[4], c2[2];
          const int b4_ = (r32 >> 4) & 1, b3_ = (r32 >> 3) & 1, b2_ = (r32 >> 2) & 1, b1_ = (r32 >> 1) & 1;
#pragma unroll
          for (int k = 0; k < 8; ++k) { const float lo = o[0][k] * o[0][k] + o[1][k] * o[1][k], hi_ = o[0][8 + k] * o[0][8 + k] + o[1][8 + k] * o[1][8 + k];
              const float send = b4_ ? lo : hi_, keep = b4_ ? hi_ : lo; a8[k] = keep + __shfl_xor(send, 16); }
#pragma unroll
          for (int k = 0; k < 4; ++k) { const float send = b3_ ? a8[k] : a8[4 + k], keep = b3_ ? a8[4 + k] : a8[k]; b4[k] = keep + __shfl_xor(send, 8); }
#pragma unroll
          for (int k = 0; k < 2; ++k) { const float send = b2_ ? b4[k] : b4[2 + k], keep = b2_ ? b4[2 + k] : b4[k]; c2[k] = keep + __shfl_xor(send, 4); }
          { const float send = b1_ ? c2[0] : c2[1], keep = b1_ ? c2[1] : c2[0]; tot = keep + __shfl_xor(send, 2); }
          tot += __shfl_xor(tot, 1);
          rstar = 8 * b4_ + 4 * b3_ + 2 * b2_ + b1_; }
        if ((r32 & 1) == 0) psum[e * 128 + 32 * g + crow(rstar, hi)] = tot;
        RBAR_L();
        if (c < 15) {
#pragma unroll
            for (int i = 0; i < 4; ++i) { *(__attribute__((address_space(3))) u32x4*)(kc_w + i * 2048) = kp[i]; *(__attribute__((address_space(3))) u32x4*)(kt_w + i * 16) = kp[i];
                *(__attribute__((address_space(3))) u32x4*)(vt_w + i * 16) = scale8(vp[i], vsc); }
        }
        { const __attribute__((address_space(3))) f32x4v* ps4 = (const __attribute__((address_space(3))) f32x4v*)(psum + 32 * g) + hi;
#pragma unroll
          for (int q4 = 0; q4 < 4; ++q4) { const f32x4v s0 = ps4[2 * q4], s1 = ps4[32 + 2 * q4];
#pragma unroll
              for (int k = 0; k < 4; ++k) { const int r = 4 * q4 + k; const float sc = __builtin_amdgcn_exp2f((float)(32 * g + crow(r, hi) + 1) * lg);     const float ss = (s0[k] + s1[k]) * sc * sc;
                  const float f = sc / sqrtf(ss * (1.f / 128.f) + EPS);
                  *(__attribute__((address_space(3))) unsigned short*)(st_w + crow(r, hi) * 64) = (unsigned short)cvtpk_s(o[0][r] * f, 0.f);
                  *(__attribute__((address_space(3))) unsigned short*)(st_w + 8192 + crow(r, hi) * 64) = (unsigned short)cvtpk_s(o[1][r] * f, 0.f); } }
          asm volatile("s_waitcnt lgkmcnt(0)" ::: "memory");
          lptr sp = lds + ST + (2 * e + (lane & 1)) * 8192 + (32 * g + (lane >> 1)) * 64;
          unsigned short* og = O + (size_t)(c * 128 + 32 * g + (lane >> 1)) * OP + 64 * e + 32 * (lane & 1);
#pragma unroll
          for (int i = 0; i < 4; ++i) { const u32x4 ov = *(const __attribute__((address_space(3))) u32x4*)(sp + i * 16); u32x4 w;
              w.x = cvtpk_s(bfl(ov.x) * bfl(gt[i].x), bfh(ov.x) * bfh(gt[i].x)); w.y = cvtpk_s(bfl(ov.y) * bfl(gt[i].y), bfh(ov.y) * bfh(gt[i].y));
              w.z = cvtpk_s(bfl(ov.z) * bfl(gt[i].z), bfh(ov.z) * bfh(gt[i].z)); w.w = cvtpk_s(bfl(ov.w) * bfl(gt[i].w), bfh(ov.w) * bfh(gt[i].w));
              *(u32x4*)(og + 8 * i) = w; }
          asm volatile("s_waitcnt lgkmcnt(0)" ::: "memory"); }
        if (c < 15) {
#pragma unroll
            for (int d = 0; d < 2; ++d)
#pragma unroll
                for (int r = 0; r < 16; ++r) { const unsigned w = cvtpk_s(st[d][r], 0.f); *(__attribute__((address_space(3))) unsigned short*)(st_w + d * 8192 + crow(r, hi) * 64) = (unsigned short)w; }
            if (c < 14) {
#pragma unroll
                for (int i = 0; i < 4; ++i) { kp[i] = *(const u32x4*)(kg + (size_t)(c + 2) * 128 * RP + i * 8); vp[i] = *(const u32x4*)(vg + (size_t)(c + 2) * 128 * RP + i * 8); } }
        }
        RBAR_L();
    }
    asm volatile("s_waitcnt vmcnt(0)" ::: "memory");
}
#undef RBAR
#undef RBAR_L
}
#define XB_TMO      128
#define XB_XCNT(j)  (256  + 64 * (j))
#define XB_XSUB(j)  (1280 + 64 * (j))
#define XB_XGEN(j)  (2304 + 64 * (j))
#define XB_TOP      3328
#define XB_TOPGEN   3392
#define XCD_BAR_WORDS 3456
#define XB_SPIN_CAP (1u << 18)

__device__ __forceinline__ unsigned xb_ld(unsigned* p)              { return __hip_atomic_load(p, __ATOMIC_RELAXED, __HIP_MEMORY_SCOPE_AGENT); }
__device__ __forceinline__ unsigned xb_add(unsigned* p, unsigned v) { return __hip_atomic_fetch_add(p, v, __ATOMIC_RELAXED, __HIP_MEMORY_SCOPE_AGENT); }
__device__ __forceinline__ unsigned xb_xcc_id() { return (unsigned)__builtin_amdgcn_s_getreg((3 << 11) | 20) & 0xFu; }
#define XB_SPIN(cond, bar) do { unsigned _sp = 0; while (cond) { __builtin_amdgcn_s_sleep(1); \
    if ((++_sp & 255u) == 0u) { if (xb_ld(&(bar)[XB_TMO])) break; if (_sp > XB_SPIN_CAP) { atomicAdd(&(bar)[XB_TMO], 1u); break; } } } } while (0)

struct XcdBarrier {
    unsigned* bar; unsigned x;
    volatile LAS unsigned* st;
};

__device__ __forceinline__ XcdBarrier xcd_barrier_post(unsigned* bar, volatile LAS unsigned* st) {
    XcdBarrier b; b.bar = bar; b.x = xb_xcc_id(); b.st = st;
    if (threadIdx.x == 0) (void)xb_add(&bar[XB_XCNT(b.x)], 1u);
    return b;
}
__device__ __forceinline__ void xcd_barrier_complete(unsigned* bar, unsigned x, unsigned& nloc, unsigned& nx) {
    const unsigned G = gridDim.x * gridDim.y * gridDim.z;
    unsigned sum, cnt, mine, sp = 0u;
    for (;;) {
        sum = 0u; cnt = 0u; mine = 0u;
#pragma unroll
        for (unsigned j = 0; j < 16; ++j) { const unsigned c = xb_ld(&bar[XB_XCNT(j)]); sum += c; cnt += (c > 0u) ? 1u : 0u; mine = (j == x) ? c : mine; }
        if (sum == G) break;
        __builtin_amdgcn_s_sleep(1);
        if ((++sp & 255u) == 0u) { if (xb_ld(&bar[XB_TMO])) break; if (sp > XB_SPIN_CAP) { atomicAdd(&bar[XB_TMO], 1u); break; } }
    }
    nloc = mine > 0u ? mine : 1u; nx = cnt > 0u ? cnt : 1u;
}

__device__ __forceinline__ void xcd_barrier(const XcdBarrier& b) {
    asm volatile("s_waitcnt vmcnt(0)" ::: "memory");
    __syncthreads();
    if (threadIdx.x == 0) {
        unsigned* bar = b.bar;
        __builtin_amdgcn_s_waitcnt(0);
        unsigned nloc = b.st[0], nx = b.st[1];
        if (nloc == 0u) { xcd_barrier_complete(bar, b.x, nloc, nx); b.st[0] = nloc; b.st[1] = nx; }
        const unsigned old = xb_add(&bar[XB_XSUB(b.x)], 1u);
        const unsigned gen = old / nloc;
        if (old + 1u == (gen + 1u) * nloc) {
            __builtin_amdgcn_fence(__ATOMIC_RELEASE, "agent");
            asm volatile("s_waitcnt vmcnt(0)" ::: "memory");
            const unsigned og = xb_add(&bar[XB_TOP], 1u);
            const unsigned tg = og / nx;
            if (og + 1u == (tg + 1u) * nx) xb_add(&bar[XB_TOPGEN], 1u);
            else XB_SPIN(xb_ld(&bar[XB_TOPGEN]) == tg, bar);
            __builtin_amdgcn_fence(__ATOMIC_ACQUIRE, "agent");
            xb_add(&bar[XB_XGEN(b.x)], 1u);
            asm volatile("s_waitcnt vmcnt(0)" ::: "memory");
        } else {
            XB_SPIN(xb_ld(&bar[XB_XGEN(b.x)]) == gen, bar);
            __builtin_amdgcn_fence(__ATOMIC_ACQUIRE, "agent");
            asm volatile("s_waitcnt vmcnt(0)" ::: "memory");
        }
    }
    __syncthreads();
}

struct Args { const float* in[15]; float* out; unsigned char* ws; int ph_lo, ph_hi; };
typedef const __attribute__((address_space(4))) Args* KArgs;
#define KA_GET() ({ KArgs k_ = (KArgs)__builtin_amdgcn_kernarg_segment_ptr(); asm volatile("" : "+s"(k_)); k_; })
#define WSP(T, off) ((T*)(ka->ws + (off)))
struct Frame {
    LAS unsigned char* lds;
    int tid, lane, wave, gw;
    int G;
};
__device__ __forceinline__ float wave_sum(float v) {
#pragma unroll
    for (int o = 1; o < 64; o <<= 1) v += __shfl_xor(v, o);
    return v;
}

__device__ __forceinline__ int dst_row(int mode, int n) {
    if (mode == 0) return n;
    if (mode == 1) {
        if (n < 768) { const int h = n >> 7, d = n & 127; return C_Q + h * 128 + ((d & 63) << 1) + (d >> 6); }
        if (n < 1536) { const int m = n - 768, h = m >> 7, d = m & 127; return C_K + h * 128 + ((d & 63) << 1) + (d >> 6); }
        if (n < 2304) return C_V + (n - 1536);
        if (n < 3072) return C_G + (n - 2304);
        return C_MQ + (n - 3072);
    }
    if (n < 768) return C_Q + n;
    if (n < 1536) return C_K + (n - 768);
    if (n < 2304) return C_V + (n - 1536);
    if (n < 2316) return C_G + (n - 2304);
    return C_MQ + (n - 2316);
}
__device__ __forceinline__ void p0_transpose_item(const float* W, int K, int N, bf16* WT, int mode, int row_off, const float* gain, LAS float* scr, int item, int lane) {
    const int nblk = (N + 31) / 32, kb = item / nblk, nb = item % nblk, k0 = 64 * kb, n0 = 32 * nb;
    const int nn = n0 + (lane & 31);
#pragma unroll 8
    for (int i = 0; i < 32; ++i) { const int kk = 2 * i + (lane >> 5);
        float v = 0.f; if (nn < N) { v = W[(size_t)(k0 + kk) * N + nn]; if (gain) v *= gain[k0 + kk]; }
        scr[kk * 33 + (lane & 31)] = v; }
    LDS_WAIT(); asm volatile("" ::: "memory");
    const int c = lane & 7;
#pragma unroll
    for (int j = 0; j < 4; ++j) { const int nl = (lane >> 3) + 8 * j; const int n = n0 + nl;
        if (n < N) { const LAS float* s = scr + (8 * c) * 33 + nl;
            v4u o; o.x = pk2(s[0 * 33], s[1 * 33]); o.y = pk2(s[2 * 33], s[3 * 33]); o.z = pk2(s[4 * 33], s[5 * 33]); o.w = pk2(s[6 * 33], s[7 * 33]);
            *(GAS v4u*)(WT + (size_t)(row_off + dst_row(mode, n)) * K + k0 + 8 * c) = o; } }
    LDS_WAIT(); asm volatile("" ::: "memory");
}
__device__ __forceinline__ void rms_row_to_bf16(const float* xrow, bf16* orow, int lane) {
    const GAS f32x4* xr = (const GAS f32x4*)xrow + lane;
    f32x4 v[4]; float s = 0.f;
#pragma unroll
    for (int j = 0; j < 4; ++j) { v[j] = xr[64 * j]; s += (v[j].x * v[j].x + v[j].y * v[j].y) + (v[j].z * v[j].z + v[j].w * v[j].w); }
    const float rstd = 1.0f / sqrtf(wave_sum(s) * (1.f / DM) + EPS);
    GAS unsigned long long* o8 = (GAS unsigned long long*)orow + lane;
#pragma unroll
    for (int j = 0; j < 4; ++j) o8[64 * j] = (unsigned long long)pk2(v[j].x * rstd, v[j].y * rstd) | ((unsigned long long)pk2(v[j].z * rstd, v[j].w * rstd) << 32);
}
__device__ __forceinline__ void p0_prologue(Frame& F, KArgs ka) {
    const float *w_in_ret = ka->in[3], *w_in_fox = ka->in[4], *w_mem_kv = ka->in[6], *w_out = ka->in[7], *w_up = ka->in[8], *w_down = ka->in[9];
    const float *g_pre_mix = ka->in[10], *g_pre_mlp = ka->in[12], *g_mem = ka->in[14];
    bf16 *Win0 = WSP(bf16, WS_WIN0), *Win1 = WSP(bf16, WS_WIN1), *Wmem = WSP(bf16, WS_WMEM), *Wout = WSP(bf16, WS_WOUT), *Wup = WSP(bf16, WS_WUP), *Wdn = WSP(bf16, WS_WDN);
    LAS float* scr = (LAS float*)(F.lds + RING_OFF + F.wave * 16384);
    const int gw = F.gw, NGW = F.G * NWAVES;
    constexpr int KB = DM / 64;
    constexpr int I_IN0 = KB * (3328 / 32), I_IN1 = KB * ((2572 + 31) / 32), I_MEM = KB * (512 / 32), I_OUT = KB * (DM / 32), I_UP = KB * (FF / 32), I_DN = (FF / 64) * (DM / 32);
    constexpr int NITEMS = I_IN0 + I_IN1 + 2 * I_MEM + 2 * I_OUT + 2 * I_UP + 2 * I_DN;
    for (int it = gw; it < NITEMS; it += NGW) {
        int r = it;
        if (r < I_IN0) { p0_transpose_item(w_in_ret, DM, 3328, Win0, 1, 0, g_pre_mix, scr, r, F.lane); continue; } r -= I_IN0;
        if (r < I_IN1) { p0_transpose_item(w_in_fox, DM, 2572, Win1, 2, 0, g_pre_mix + DM, scr, r, F.lane); continue; } r -= I_IN1;
        if (r < 2 * I_MEM) { const int l = r / I_MEM; p0_transpose_item(w_mem_kv + (size_t)l * DM * 512, DM, 512, Wmem, 0, l * 512, g_mem + l * DM, scr, r % I_MEM, F.lane); continue; } r -= 2 * I_MEM;
        if (r < 2 * I_OUT) { const int l = r / I_OUT; p0_transpose_item(w_out + (size_t)l * DM * DM, DM, DM, Wout + (size_t)l * DM * DM, 0, 0, nullptr, scr, r % I_OUT, F.lane); continue; } r -= 2 * I_OUT;
        if (r < 2 * I_UP) { const int l = r / I_UP; p0_transpose_item(w_up + (size_t)l * DM * FF, DM, FF, Wup + (size_t)l * DM * FF, 0, 0, g_pre_mlp + l * DM, scr, r % I_UP, F.lane); continue; } r -= 2 * I_UP;
        { const int l = r / I_DN; p0_transpose_item(w_down + (size_t)l * DM * FF, FF, DM, Wdn + (size_t)l * DM * FF, 0, 0, nullptr, scr, r % I_DN, F.lane); }
    }
    { GAS v4u* z = (GAS v4u*)(Win1 + (size_t)(C_G + 12) * DM); const int n16 = (NP1 - C_G - 12) * DM * 2 / 16;
      for (int i = gw * 64 + F.lane; i < n16; i += NGW * 64) z[i] = (v4u){0u, 0u, 0u, 0u}; }
    for (int m = gw; m < MTOK; m += NGW) rms_row_to_bf16(ka->in[0] + (size_t)m * DM, WSP(bf16, WS_XN) + (size_t)m * DM, F.lane);
    for (int m = gw; m < MMEM; m += NGW) rms_row_to_bf16(ka->in[1] + (size_t)m * DM, WSP(bf16, WS_MEMN) + (size_t)m * DM, F.lane);
}

__device__ __forceinline__ void row_pass(Frame& F, const float* y, const float* base, const float* gain, float* xo, bf16* xn) {
    const int NGW = F.G * NWAVES;
    f32x4 g[4];
#pragma unroll
    for (int j = 0; j < 4; ++j) g[j] = ((const GAS f32x4*)gain)[F.lane + 64 * j];
    for (int m = F.gw; m < MTOK; m += NGW) {
        const GAS f32x4* yr = (const GAS f32x4*)(y + (size_t)m * DM) + F.lane; const GAS f32x4* br = (const GAS f32x4*)(base + (size_t)m * DM) + F.lane;
        f32x4 v[4], b[4]; float s = 0.f;
#pragma unroll
        for (int j = 0; j < 4; ++j) { v[j] = yr[64 * j]; b[j] = br[64 * j]; s += (v[j].x * v[j].x + v[j].y * v[j].y) + (v[j].z * v[j].z + v[j].w * v[j].w); }
        const float rstd = 1.0f / sqrtf(wave_sum(s) * (1.f / DM) + EPS);
        float s2 = 0.f;
#pragma unroll
        for (int j = 0; j < 4; ++j) { v[j] = b[j] + v[j] * rstd * g[j]; s2 += (v[j].x * v[j].x + v[j].y * v[j].y) + (v[j].z * v[j].z + v[j].w * v[j].w); }
        GAS f32x4* o = (GAS f32x4*)(xo + (size_t)m * DM) + F.lane;
#pragma unroll
        for (int j = 0; j < 4; ++j) o[64 * j] = v[j];
        if (xn) {
            const float r2 = 1.0f / sqrtf(wave_sum(s2) * (1.f / DM) + EPS);
            GAS unsigned long long* o8 = (GAS unsigned long long*)(xn + (size_t)m * DM) + F.lane;
#pragma unroll
            for (int j = 0; j < 4; ++j) o8[64 * j] = (unsigned long long)pk2(v[j].x * r2, v[j].y * r2) | ((unsigned long long)pk2(v[j].z * r2, v[j].w * r2) << 32);
        }
    }
}

__device__ __forceinline__ void scan_phase(Frame& F, KArgs ka) {
    if (F.gw >= BATCH * 12) return;
    const int b = F.gw / 12, h = F.gw % 12;
    const float* src = WSP(float, WS_LOGF) + ((size_t)b * SEQ + F.lane * 32) * 16 + h;
    float s = 0.f;
    for (int i = 0; i < 32; ++i) s += src[(size_t)i * 16];
    float incl = s;
#pragma unroll
    for (int o = 1; o < 64; o <<= 1) { const float v = __shfl_up(incl, o); if (F.lane >= o) incl += v; }
    float run = incl - s;
    float* dst = WSP(float, WS_CS) + (size_t)(b * 12 + h) * SEQ + F.lane * 32;
    for (int i = 0; i < 32; ++i) { run += src[(size_t)i * 16]; dst[i] = run; }
}

#ifndef DBL_MASK
#define DBL_MASK 0
#endif
#define REP(bit) for (int rep_ = 0; rep_ < (int)((DBL_MASK >> (bit)) & 1) + 1; ++rep_)
#define RUN() (lo <= ph && ph < hi)
#ifdef TS_A
#define TS_STAMP() do { if (blockIdx.x == 0 && threadIdx.x == 0) ((volatile unsigned long long*)(((KArgs)__builtin_amdgcn_kernarg_segment_ptr())->ws + 32768))[ph] = __builtin_amdgcn_s_memrealtime(); } while (0)
#else
#define TS_STAMP() do {} while (0)
#endif
#define SEAM() do { if (lo <= ph && ph + 1 < hi) xcd_barrier(bar); ++ph; TS_STAMP(); } while (0)
#define RELANE() do { int t_ = threadIdx.x; asm volatile("" : "+v"(t_)); F.tid = t_; F.lane = t_ & 63; F.wave = __builtin_amdgcn_readfirstlane(t_ >> 6); F.gw = blockIdx.x * NWAVES + F.wave; } while (0)
template <int layer> __device__ __forceinline__ void run_layer(Frame& F, const XcdBarrier& bar, const int lo, const int hi, int& ph, LAS unsigned char* ring, unsigned char* lds, const int G, const int c) {
        const int NP = layer ? NP1 : NP0;
        if (RUN()) {
            KArgs ka = KA_GET();
            pg8::Gemm g{WSP(bf16, WS_XN), layer ? WSP(bf16, WS_WIN1) : WSP(bf16, WS_WIN0), MTOK, NP, DM, DM}; pg8::StaticOrder S; S.init(MTOK, NP, G, c);
            pg8::EpiProj E{WSP(bf16, WS_PROJ), NP, layer, (const int*)ka->in[2], WSP(float, WS_LOGF), ka->in[5]};
            REP(0) pg8::gemm_phase<pg8::EpiProj, pg8::StaticOrder, true, true>(ring, g, S, E);
            if (layer == 0) {
                pg8::Gemm g2{WSP(bf16, WS_MEMN), WSP(bf16, WS_WMEM), MMEM, DM, DM, DM}; pg8::OneUnit S2; const int idx = c - 128; S2.has = (idx >= 0 && idx < 64); S2.u0.pm = idx >> 2; S2.u0.pn = idx & 3;
                pg8::EpiBf16<0> E2{WSP(bf16, WS_MEMKV), DM};
                pg8::gemm_phase<pg8::EpiBf16<0>, pg8::OneUnit, true, true>(ring, g2, S2, E2);
            }
        }
        SEAM();
        if (RUN()) { RELANE(); if (layer == 1) scan_phase(F, KA_GET()); }
        SEAM();
        if (RUN()) { RELANE(); KArgs ka = KA_GET();
            static_assert(attn_body::ATTN_LDS_BYTES <= RING_BYTES, "attention LDS");
            bf16* PR = WSP(bf16, WS_PROJ);
            if (layer == 0) {
                REP(6) { const bool dry = ((DBL_MASK >> 6) & 1) && rep_ == 0; const int op = dry ? 768 : NP0, opm = dry ? 256 : NP0;
                    bf16* ob = dry ? (bf16*)ka->out : PR + C_Q; bf16* obm = dry ? (bf16*)ka->out + (size_t)MTOK * 768 : PR + C_MQ;
                    if (c < 96) ret_body::ret_unit(c / 6, c % 6, PR, ob + (size_t)(c / 6) * SEQ * op + (c % 6) * 128, op, F.lds);
                    else attn_body::mem_phase<NP0, 8>((char*)lds + RING_OFF, (const attn_body::bf16*)PR, (const attn_body::bf16*)WSP(bf16, WS_MEMKV), (attn_body::bf16*)obm, opm, 0, c - 96, 160); }
            } else {
                REP(7) { const bool dry = ((DBL_MASK >> 7) & 1) && rep_ == 0; const int op = dry ? 768 : NP1, opm = dry ? 256 : NP1;
                    bf16* ob = dry ? (bf16*)ka->out : PR + C_Q; bf16* obm = dry ? (bf16*)ka->out + (size_t)MTOK * 768 : PR + C_MQ;
                    attn_body::fox_phase<8>((char*)lds + RING_OFF, (const attn_body::bf16*)PR, WSP(float, WS_CS), (attn_body::bf16*)ob, op, (int)F.G, (int)blockIdx.x);
                    attn_body::mem_phase<NP1, 8>((char*)lds + RING_OFF, (const attn_body::bf16*)PR, (const attn_body::bf16*)WSP(bf16, WS_MEMKV), (attn_body::bf16*)obm, opm, 1, c, 256); }
            }
        }
        SEAM();
        if (RUN()) {
            KArgs ka = KA_GET();
            pg8::Gemm g{WSP(bf16, WS_PROJ), WSP(bf16, WS_WOUT) + (size_t)layer * DM * DM, MTOK, DM, DM, NP}; pg8::StaticOrder S; S.init(MTOK, DM, G, c);
            pg8::EpiF32 E{ka->out, DM};
            REP(1) pg8::gemm_phase<pg8::EpiF32, pg8::StaticOrder, true, true>(ring, g, S, E);
        }
        SEAM();
        if (RUN()) { REP((layer == 0 ? 5 : 31)) { RELANE(); KArgs ka = KA_GET(); row_pass(F, ka->out, layer ? WSP(float, WS_R1) : ka->in[0], ka->in[11] + layer * DM, WSP(float, WS_R1), WSP(bf16, WS_XN)); } }
        SEAM();
        if (RUN()) {
            KArgs ka = KA_GET();
            pg8::Gemm g{WSP(bf16, WS_XN), WSP(bf16, WS_WUP) + (size_t)layer * DM * FF, MTOK, FF, DM, DM}; pg8::StaticOrder S; S.init(MTOK, FF, G, c);
            pg8::EpiBf16<1> E{WSP(bf16, WS_H), FF};
            REP(2) pg8::gemm_phase<pg8::EpiBf16<1>, pg8::StaticOrder, true, true>(ring, g, S, E);
        }
        SEAM();
        if (RUN()) {
            KArgs ka = KA_GET();
            pg8::Gemm g{WSP(bf16, WS_H), WSP(bf16, WS_WDN) + (size_t)layer * DM * FF, MTOK, DM, FF, FF}; pg8::StaticOrder S; S.init(MTOK, DM, G, c);
            pg8::EpiF32 E{ka->out, DM};
            REP(3) pg8::gemm_phase<pg8::EpiF32, pg8::StaticOrder, true, true>(ring, g, S, E);
        }
        SEAM();
        if (RUN()) { RELANE(); KArgs ka = KA_GET(); row_pass(F, ka->out, WSP(float, WS_R1), ka->in[13] + layer * DM, layer ? ka->out : WSP(float, WS_R1), layer ? nullptr : WSP(bf16, WS_XN)); }
        SEAM();
    }
__global__ void __launch_bounds__(NWAVES * 64, 2) fwd_kernel(Args args) {
    extern __shared__ __attribute__((aligned(16))) unsigned char lds[];
    Frame F;
    F.lds = (LAS unsigned char*)lds;
    F.tid = threadIdx.x; F.lane = F.tid & 63; F.wave = __builtin_amdgcn_readfirstlane(F.tid >> 6);
    F.G = gridDim.x; F.gw = blockIdx.x * NWAVES + F.wave;
    for (int u = F.tid; u < (LDS_BYTES - LDSCTL_OFF) / 4; u += NWAVES * 64) ((LAS unsigned*)(F.lds + LDSCTL_OFF))[u] = 0u;
    __syncthreads();
    volatile LAS unsigned* MISC = (volatile LAS unsigned*)(F.lds + MISC_OFF);
    XcdBarrier bar = xcd_barrier_post((unsigned*)(args.ws + WS_CTL) + CW_BAR, MISC + 8);
    const int lo = args.ph_lo, hi = args.ph_hi;
    int ph = 0;
    LAS unsigned char* ring = F.lds + RING_OFF;
    const int G = F.G, c = (int)blockIdx.x;

    TS_STAMP();
    if (RUN()) { REP(4) { RELANE(); p0_prologue(F, KA_GET()); } }
    SEAM();
    run_layer<0>(F, bar, lo, hi, ph, ring, lds, G, c);
    run_layer<1>(F, bar, lo, hi, ph, ring, lds, G, c);
#ifdef TS_A
    if (blockIdx.x == 0 && threadIdx.x == 0) { asm volatile("s_waitcnt vmcnt(0)" ::: "memory"); volatile unsigned long long* ts = (volatile unsigned long long*)(args.ws + 32768);
        args.out[0] = (float)(long long)(ts[TS_B] - ts[TS_A]) * 0.01f; }
#endif
#undef RUN
#undef SEAM
}

#ifndef MK_MULTI
#define MK_MULTI 0
#endif
constexpr int N_PHASES = 1 + 2 * 8;
extern "C" void kernel_launch(void* const* d_in, const int* in_sizes, int n_in, void* d_out, int out_size, void* d_ws, size_t ws_size, hipStream_t stream) {
    static int grid = 0;
    if (grid == 0) {
        if (n_in != 15 || in_sizes[0] != MTOK * DM || out_size != MTOK * DM || ws_size < WS_END) { fprintf(stderr, "kernel_launch: unexpected shapes (n_in %d, in0 %d, out %d, ws %zu); nothing launched\n", n_in, n_in > 0 ? in_sizes[0] : -1, out_size, ws_size); grid = -1; return; }
        int dev = 0, cus = 0, per_cu = 0;
        if (hipGetDevice(&dev) != hipSuccess || hipDeviceGetAttribute(&cus, hipDeviceAttributeMultiprocessorCount, dev) != hipSuccess) { grid = -1; return; }
        if (hipFuncSetAttribute((const void*)fwd_kernel, hipFuncAttributeMaxDynamicSharedMemorySize, LDS_BYTES) != hipSuccess) { fprintf(stderr, "kernel_launch: hipFuncSetAttribute failed\n"); grid = -1; return; }
        if (hipOccupancyMaxActiveBlocksPerMultiprocessor(&per_cu, (const void*)fwd_kernel, NWAVES * 64, LDS_BYTES) != hipSuccess || per_cu < 1)
            fprintf(stderr, "kernel_launch: occupancy query reports %d workgroups per CU\n", per_cu);
        (void)hipGetLastError();
        grid = cus;
    }
    if (grid < 0) return;
    if (hipMemsetAsync((char*)d_ws + WS_CTL, 0, CTL_ZERO_BYTES, stream) != hipSuccess) return;
    Args a{};
    for (int i = 0; i < 15; ++i) a.in[i] = (const float*)d_in[i];
    a.out = (float*)d_out; a.ws = (unsigned char*)d_ws;
#if MK_MULTI
    for (int p = 0; p < N_PHASES; ++p) { a.ph_lo = p; a.ph_hi = p + 1; hipLaunchKernelGGL(fwd_kernel, dim3(grid), dim3(NWAVES * 64), LDS_BYTES, stream, a); }
#else
    a.ph_lo = 0; a.ph_hi = N_PHASES;
    hipLaunchKernelGGL(fwd_kernel, dim3(grid), dim3(NWAVES * 64), LDS_BYTES, stream, a);
#endif
}
```

```cpp
#include <hip/hip_runtime.h>
#include <hip/hip_bf16.h>
#include <cmath>
#include <cstdio>
#include <cstdint>

constexpr int BATCH = 16, SEQ = 2048, DM = 1024, MTOK = BATCH * SEQ, MEML = 256, MMEM = BATCH * MEML, FF = 4096;
constexpr int NP0 = 3328, NP1 = 2816;
constexpr int C_Q = 0, C_MQ = 768, C_K = 1024, C_V = 1792, C_G = 2560;
constexpr float EPS = 1e-6f;
constexpr float LOG2E = 1.4426950408889634f;
constexpr float QSCALE = 0.125f * LOG2E;

namespace pg8 {
#define PG8_LAS __attribute__((address_space(3)))
typedef unsigned short bf16_t;
typedef short bf16x8 __attribute__((ext_vector_type(8)));
typedef float f32x4 __attribute__((ext_vector_type(4)));
typedef unsigned u32x4 __attribute__((ext_vector_type(4)));
constexpr int BM = 256, BK = 64, HALF = 128, HTB = HALF * BK * 2  , STAGE_BYTES = 8 * HTB, NXCD = 8, WGM = 8;

__host__ __device__ __forceinline__ int lds_byte(int r, int c) { const int st = (r >> 4) * 2 + (c >> 5), rr = r & 15, cc = c & 31, ob = rr * 64 + cc * 2; return st * 1024 + (ob ^ (((ob >> 9) & 1) << 5)); }
__host__ __device__ __forceinline__ void stage_rc(int b, int& R, int& C) { const int st = b / 1024, sb = b % 1024, swz = sb ^ (((sb >> 9) & 1) << 5); R = (st >> 1) * 16 + swz / 64; C = (st & 1) * 32 + (swz % 64) / 2; }
__host__ __device__ __forceinline__ int perm32(int rho) { const int n = rho >> 4, i = rho & 15; return 8 * (i >> 2) + 4 * n + (i & 3); }

struct Unit { int pm, pn; };
struct Gemm { const bf16_t* A; const bf16_t* Bt; int M, N, K, lda; };

struct StaticOrder {
    int nM, nN, nwg, G, c;
    __host__ __device__ void init(int M, int N, int G_, int c_) { nM = M / BM; nN = N / BM; nwg = nM * nN; G = G_; c = c_; }
    __host__ __device__ bool next(int i, Unit& u) const {
        const long L = (long)i * G + c; if (L >= nwg) return false;
        int wgid = (int)L; { const int q = nwg / NXCD, r = nwg % NXCD, xcd = wgid % NXCD, off = wgid / NXCD; wgid = (xcd < r ? xcd * (q + 1) : r * (q + 1) + (xcd - r) * q) + off; }
        const int nig = WGM * nN, gid = wgid / nig, fm = gid * WGM, gsz = (nM - fm) < WGM ? (nM - fm) : WGM;
        u.pm = fm + ((wgid % nig) % gsz); u.pn = (wgid % nig) / gsz; return true;
    }
    __device__ __forceinline__ void a_ready(const Unit&) const {}
    __device__ __forceinline__ void done(const Unit&) const {}
};
struct OneUnit {
    Unit u0; bool has;
    __device__ __forceinline__ bool next(int i, Unit& u) const { if (i != 0 || !has) return false; u = u0; return true; }
    __device__ __forceinline__ void a_ready(const Unit&) const {}
    __device__ __forceinline__ void done(const Unit&) const {}
};

typedef float f32x2_t __attribute__((ext_vector_type(2))); typedef __bf16 bf16x2_t __attribute__((ext_vector_type(2)));
__device__ __forceinline__ unsigned cvt_pk_bf16(float lo, float hi) { f32x2_t v = {lo, hi}; bf16x2_t b = __builtin_convertvector(v, bf16x2_t); return __builtin_bit_cast(unsigned, b); }

template <int ACT> struct EpiBf16 {
    static constexpr bool PERM = true, AFTER_DRAIN = false;
    bf16_t* O; int ldc;
    __device__ __forceinline__ void operator()(const f32x4 (&acc)[2][2][4][2], const Unit& u, int wr, int wc, int fr, int fq) const {
        const int row0 = u.pm * BM + wr * 64 + fr, col0 = u.pn * BM + wc * 32 + 8 * fq;
#pragma unroll
        for (int ai = 0; ai < 2; ++ai)
#pragma unroll
            for (int m = 0; m < 4; ++m) { bf16_t* rowp = O + (size_t)(row0 + ai * HALF + m * 16) * ldc + col0;
#pragma unroll
                for (int bj = 0; bj < 2; ++bj) { f32x4 v0 = acc[ai][bj][m][0], v1 = acc[ai][bj][m][1];
                    if (ACT == 1) {
#pragma unroll
                        for (int e = 0; e < 4; ++e) { const float a = fmaxf(v0[e], 0.f), b = fmaxf(v1[e], 0.f); v0[e] = a * a; v1[e] = b * b; } }
                    u32x4 w; w.x = cvt_pk_bf16(v0[0], v0[1]); w.y = cvt_pk_bf16(v0[2], v0[3]); w.z = cvt_pk_bf16(v1[0], v1[1]); w.w = cvt_pk_bf16(v1[2], v1[3]);
                    *(u32x4*)(rowp + bj * HALF) = w; } }
    }
};
struct EpiF32 {
    static constexpr bool PERM = false, AFTER_DRAIN = false;
    float* O; int ldc;
    __device__ __forceinline__ void operator()(const f32x4 (&acc)[2][2][4][2], const Unit& u, int wr, int wc, int fr, int fq) const {
        const int row0 = u.pm * BM + wr * 64 + fr, col0 = u.pn * BM + wc * 32 + 4 * fq;
#pragma unroll
        for (int ai = 0; ai < 2; ++ai)
#pragma unroll
            for (int m = 0; m < 4; ++m) { float* rowp = O + (size_t)(row0 + ai * HALF + m * 16) * ldc + col0;
#pragma unroll
                for (int bj = 0; bj < 2; ++bj)
#pragma unroll
                    for (int n = 0; n < 2; ++n) *(f32x4*)(rowp + bj * HALF + n * 16) = acc[ai][bj][m][n]; }
    }
};
struct EpiProj {
    static constexpr bool PERM = true, AFTER_DRAIN = false;
    bf16_t* O; int ldc; int layer; const int* pos; float* logf; const float* bfg;
    __device__ __forceinline__ void operator()(const f32x4 (&acc)[2][2][4][2], const Unit& u, int wr, int wc, int fr, int fq) const {
        const int row0 = u.pm * BM + wr * 64 + fr, cw = wc * 32 + 8 * fq, col0 = u.pn * BM + cw;
        int mode; float sc = 1.f;
        if (layer == 0) { if (u.pn < 3) mode = 1; else if (u.pn == 3) { mode = 0; sc = QSCALE; } else if (u.pn < 7) { mode = 1; sc = 0.08838834764831845f; } else if (u.pn < 10) mode = 0; else mode = 4; }
        else { if (u.pn < 4) { mode = 0; sc = QSCALE; } else if (u.pn < 10) mode = 0; else mode = 5; }
        if (mode == 5) {
            if (wc == 0 && fq < 2) {
#pragma unroll
                for (int ai = 0; ai < 2; ++ai)
#pragma unroll
                    for (int m = 0; m < 4; ++m) { const int row = row0 + ai * HALF + m * 16;
#pragma unroll
                        for (int n = 0; n < 2; ++n)
#pragma unroll
                            for (int e = 0; e < 4; ++e) { const int c = 8 * fq + 4 * n + e;
                                if (c < 12) { const float z = acc[ai][0][m][n][e] + bfg[c]; const float az = fabsf(z);
                                    logf[(size_t)row * 16 + c] = fminf(z, 0.f) * LOG2E - __log2f(1.f + exp2f(-az * LOG2E)); } } }
            }
            return;
        }
        float invf[4];
        if (mode == 1) {
#pragma unroll
            for (int p = 0; p < 4; ++p) invf[p] = exp2f(-(float)((cw >> 1) + p) * (13.287712379549449f / 64.f)) * 0.15915494309189535f;
        }
#pragma unroll
        for (int ai = 0; ai < 2; ++ai)
#pragma unroll
            for (int m = 0; m < 4; ++m) { const int row = row0 + ai * HALF + m * 16; bf16_t* rowp = O + (size_t)row * ldc + col0;
                float cs[4], sn[4];
                if (mode == 1) { const float ps = (float)pos[row];
#pragma unroll
                    for (int p = 0; p < 4; ++p) { float rev = ps * invf[p]; rev = rev - floorf(rev); sn[p] = __builtin_amdgcn_sinf(rev); cs[p] = __builtin_amdgcn_cosf(rev); } }
#pragma unroll
                for (int bj = 0; bj < 2; ++bj) { f32x4 v0 = acc[ai][bj][m][0], v1 = acc[ai][bj][m][1];
                    if (mode == 1) {
                        const float a0 = v0[0] * cs[0] - v0[1] * sn[0], b0 = v0[0] * sn[0] + v0[1] * cs[0];
                        const float a1 = v0[2] * cs[1] - v0[3] * sn[1], b1 = v0[2] * sn[1] + v0[3] * cs[1];
                        const float a2 = v1[0] * cs[2] - v1[1] * sn[2], b2 = v1[0] * sn[2] + v1[1] * cs[2];
                        const float a3 = v1[2] * cs[3] - v1[3] * sn[3], b3 = v1[2] * sn[3] + v1[3] * cs[3];
                        v0 = (f32x4){a0, b0, a1, b1}; v1 = (f32x4){a2, b2, a3, b3};
                    } else if (mode == 4) {
#pragma unroll
                        for (int e = 0; e < 4; ++e) { v0[e] = v0[e] / (1.f + exp2f(-v0[e] * LOG2E)); v1[e] = v1[e] / (1.f + exp2f(-v1[e] * LOG2E)); }
                    }
                    v0 = v0 * sc; v1 = v1 * sc;
                    u32x4 w; w.x = cvt_pk_bf16(v0[0], v0[1]); w.y = cvt_pk_bf16(v0[2], v0[3]); w.z = cvt_pk_bf16(v1[0], v1[1]); w.w = cvt_pk_bf16(v1[2], v1[3]);
                    *(u32x4*)(rowp + bj * HALF) = w; } }
    }
};

template <class Epi, class Sched, bool ALIGN_EPI = false, bool SP2 = false>
__device__ __forceinline__ void gemm_phase(PG8_LAS unsigned char* lds, const Gemm g, const Sched& S, const Epi& E) {
    int tid_ = threadIdx.x; asm volatile("" : "+v"(tid_));
    const int tid = tid_, wid = __builtin_amdgcn_readfirstlane(tid >> 6), lane = tid & 63, wr = wid >> 2, wc = wid & 3, fr = lane & 15, fq = lane >> 4;
    const int K = g.K, nt = K / BK;
    unsigned voffA[2], voffB[2];
#pragma unroll
    for (int i = 0; i < 2; ++i) { int R, C; stage_rc(tid * 16 + i * 8192, R, C); const int Rb = Epi::PERM ? ((R & ~31) + perm32(R & 31)) : R;
        voffA[i] = (unsigned)(R * g.lda + C) * 2u; voffB[i] = (unsigned)(Rb * K + C) * 2u; }
    const size_t kstep = (size_t)(BK * 2);
    const size_t hstepA = (size_t)HALF * g.lda * 2, hstepB = (size_t)HALF * K * 2;
    const size_t tstepA = 2 * hstepA, tstepB = 2 * hstepB;
    const unsigned ldsw = (unsigned)wid * 1024u;
    const int aoff = lds_byte(wr * 64 + fr, fq * 8), boff = lds_byte(wc * 32 + fr, fq * 8);
#define PG8_SA(b, h) (((b) * 2 + (h)) * HTB)
#define PG8_SB(b, h) ((4 + (b) * 2 + (h)) * HTB)
#define PG8_STAGE(bufoff, gbase, voff) do { _Pragma("unroll") for (int _i = 0; _i < 2; ++_i) \
        __builtin_amdgcn_global_load_lds((const unsigned*)((const char*)(gbase) + (voff)[_i]), (PG8_LAS unsigned*)(lds + (bufoff) + ldsw + _i * 8192), 16, 0, 0); } while (0)
#define PG8_LDA(dst, b, h) do { _Pragma("unroll") for (int m = 0; m < 4; ++m) _Pragma("unroll") for (int k = 0; k < 2; ++k) dst[m][k] = *(const PG8_LAS bf16x8*)(lds + PG8_SA(b, h) + aoff + m * 2048 + k * 1024); } while (0)
#define PG8_LDB(dst, b, h) do { _Pragma("unroll") for (int n = 0; n < 2; ++n) _Pragma("unroll") for (int k = 0; k < 2; ++k) dst[n][k] = *(const PG8_LAS bf16x8*)(lds + PG8_SB(b, h) + boff + n * 2048 + k * 1024); } while (0)
#define PG8_MMA(ai, bj, At, Bt) do { __builtin_amdgcn_s_setprio(1); _Pragma("unroll") for (int m = 0; m < 4; ++m) _Pragma("unroll") for (int n = 0; n < 2; ++n) _Pragma("unroll") for (int k = 0; k < 2; ++k) \
        acc[ai][bj][m][n] = __builtin_amdgcn_mfma_f32_16x16x32_bf16(Bt[n][k], At[m][k], acc[ai][bj][m][n], 0, 0, 0); __builtin_amdgcn_s_setprio(0); } while (0)
#define PG8_WAIT_V(n) asm volatile("s_waitcnt vmcnt(" #n ")" ::: "memory")
#define PG8_WAIT_L(n) asm volatile("s_waitcnt lgkmcnt(" #n ")" ::: "memory")
#define PG8_BAR __builtin_amdgcn_s_barrier()
#define PG8_SCHED __builtin_amdgcn_sched_barrier(0)
    Unit cur, nxt; int ui = 0;
    if (!S.next(0, cur)) return;
    f32x4 acc[2][2][4][2];
#pragma unroll
    for (int a = 0; a < 2; ++a)
#pragma unroll
        for (int b = 0; b < 2; ++b)
#pragma unroll
            for (int m = 0; m < 4; ++m)
#pragma unroll
                for (int n = 0; n < 2; ++n) acc[a][b][m][n] = (f32x4){0.f, 0.f, 0.f, 0.f};
    bf16x8 At[4][2], B0[2][2], B1[2][2];
    const char* cA = (const char*)g.A + (size_t)cur.pm * tstepA; const char* cB = (const char*)g.Bt + (size_t)cur.pn * tstepB;
    S.a_ready(cur);
    if constexpr (SP2) {
        PG8_STAGE(PG8_SB(0, 0), cB, voffB); PG8_STAGE(PG8_SB(0, 1), cB + hstepB, voffB); PG8_STAGE(PG8_SA(0, 0), cA, voffA); PG8_STAGE(PG8_SA(0, 1), cA + hstepA, voffA);
        if (wr == 1) PG8_BAR;
        PG8_WAIT_V(2); PG8_BAR;
        PG8_STAGE(PG8_SB(1, 0), cB + kstep, voffB); PG8_STAGE(PG8_SA(1, 0), cA + kstep, voffA); PG8_STAGE(PG8_SB(1, 1), cB + hstepB + kstep, voffB);
        PG8_WAIT_V(6); PG8_BAR;
    } else {
        PG8_STAGE(PG8_SB(0, 0), cB, voffB); PG8_STAGE(PG8_SA(0, 0), cA, voffA); PG8_STAGE(PG8_SB(0, 1), cB + hstepB, voffB); PG8_STAGE(PG8_SA(0, 1), cA + hstepA, voffA);
        if (wr == 1) PG8_BAR;
        PG8_WAIT_V(4); PG8_BAR;
        PG8_STAGE(PG8_SB(1, 0), cB + kstep, voffB); PG8_STAGE(PG8_SA(1, 0), cA + kstep, voffA); PG8_STAGE(PG8_SB(1, 1), cB + hstepB + kstep, voffB);
        PG8_WAIT_V(6); PG8_BAR;
    }
    for (;;) {
        const bool has_next = S.next(ui + 1, nxt);
        const char* nA = has_next ? (const char*)g.A + (size_t)nxt.pm * tstepA : cA; const char* nB = has_next ? (const char*)g.Bt + (size_t)nxt.pn * tstepB : cB;
        for (int t = 0; t < nt; t += 2) {
            const bool last = (t == nt - 2);
            const char* a1 = cA + (size_t)(t + 1) * kstep;
            const char* a2 = last ? nA : cA + (size_t)(t + 2) * kstep; const char* b2 = last ? nB : cB + (size_t)(t + 2) * kstep;
            const char* a3 = a2 + kstep; const char* b3 = b2 + kstep;
            if (last && has_next) S.a_ready(nxt);
            if constexpr (SP2) {
            PG8_LDB(B0, 0, 0); PG8_LDB(B1, 0, 1); PG8_SCHED; PG8_LDA(At, 0, 0); PG8_STAGE(PG8_SA(1, 1), a1 + hstepA, voffA);
            PG8_WAIT_V(8); PG8_WAIT_L(0); PG8_BAR; PG8_MMA(0, 0, At, B0); PG8_MMA(0, 1, At, B1); PG8_BAR; PG8_SCHED;
            PG8_LDA(At, 0, 1); PG8_STAGE(PG8_SB(0, 0), b2, voffB); PG8_STAGE(PG8_SB(0, 1), b2 + hstepB, voffB); PG8_STAGE(PG8_SA(0, 0), a2, voffA);
            PG8_WAIT_V(8); PG8_WAIT_L(0); PG8_BAR; PG8_MMA(1, 0, At, B0); PG8_MMA(1, 1, At, B1); PG8_BAR; PG8_SCHED;
            PG8_LDB(B0, 1, 0); PG8_LDB(B1, 1, 1); PG8_SCHED; PG8_LDA(At, 1, 0); PG8_STAGE(PG8_SA(0, 1), a2 + hstepA, voffA);
            PG8_WAIT_V(8); PG8_WAIT_L(0); PG8_BAR; PG8_MMA(0, 0, At, B0); PG8_MMA(0, 1, At, B1); PG8_BAR; PG8_SCHED;
            PG8_LDA(At, 1, 1); PG8_STAGE(PG8_SB(1, 0), b3, voffB); PG8_STAGE(PG8_SB(1, 1), b3 + hstepB, voffB); PG8_STAGE(PG8_SA(1, 0), a3, voffA);
            PG8_WAIT_V(8); PG8_WAIT_L(0); PG8_BAR; PG8_MMA(1, 0, At, B0); PG8_MMA(1, 1, At, B1); PG8_BAR; PG8_SCHED;
            } else {
            PG8_LDB(B0, 0, 0); PG8_SCHED; PG8_LDA(At, 0, 0); PG8_STAGE(PG8_SA(1, 1), a1 + hstepA, voffA);
            PG8_WAIT_L(8); PG8_BAR; PG8_WAIT_L(0); PG8_MMA(0, 0, At, B0); PG8_BAR; PG8_SCHED;
            PG8_LDB(B1, 0, 1); PG8_STAGE(PG8_SB(0, 0), b2, voffB);
            PG8_BAR; PG8_WAIT_L(0); PG8_MMA(0, 1, At, B1); PG8_BAR;
            PG8_LDA(At, 0, 1); PG8_STAGE(PG8_SA(0, 0), a2, voffA);
            PG8_BAR; PG8_WAIT_L(0); PG8_MMA(1, 0, At, B0); PG8_BAR; PG8_SCHED;
            PG8_STAGE(PG8_SB(0, 1), b2 + hstepB, voffB);
            PG8_WAIT_V(6); PG8_BAR; PG8_MMA(1, 1, At, B1); PG8_BAR;
            PG8_LDB(B0, 1, 0); PG8_SCHED; PG8_LDA(At, 1, 0); PG8_STAGE(PG8_SA(0, 1), a2 + hstepA, voffA);
            PG8_WAIT_L(8); PG8_BAR; PG8_WAIT_L(0); PG8_MMA(0, 0, At, B0); PG8_BAR; PG8_SCHED;
            PG8_LDB(B1, 1, 1); PG8_STAGE(PG8_SB(1, 0), b3, voffB);
            PG8_BAR; PG8_WAIT_L(0); PG8_MMA(0, 1, At, B1); PG8_BAR;
            PG8_LDA(At, 1, 1); PG8_STAGE(PG8_SA(1, 0), a3, voffA);
            PG8_BAR; PG8_WAIT_L(0); PG8_MMA(1, 0, At, B0); PG8_BAR; PG8_SCHED;
            PG8_STAGE(PG8_SB(1, 1), b3 + hstepB, voffB);
            PG8_WAIT_V(6); PG8_BAR; PG8_MMA(1, 1, At, B1); PG8_BAR;
            }
        }
        if constexpr (ALIGN_EPI) { if (wr == 0) PG8_BAR; }
        if constexpr (!Epi::AFTER_DRAIN) { E(acc, cur, wr, wc, fr, fq); S.done(cur); }
        if (!has_next) break;
#pragma unroll
        for (int a = 0; a < 2; ++a)
#pragma unroll
            for (int b = 0; b < 2; ++b)
#pragma unroll
                for (int m = 0; m < 4; ++m)
#pragma unroll
                    for (int n = 0; n < 2; ++n) acc[a][b][m][n] = (f32x4){0.f, 0.f, 0.f, 0.f};
        cur = nxt; cA = nA; cB = nB; ++ui;
        if constexpr (ALIGN_EPI) { if (wr == 1) PG8_BAR; }
    }
    PG8_WAIT_V(0);
    if constexpr (!ALIGN_EPI) { if (wr == 0) PG8_BAR; }
    PG8_BAR;
    if constexpr (Epi::AFTER_DRAIN) { E.fused(acc, cur, wr, wc, fr, fq, lds, wid, lane); S.done(cur); }
#undef PG8_SA
#undef PG8_SB
#undef PG8_STAGE
#undef PG8_LDA
#undef PG8_LDB
#undef PG8_MMA
#undef PG8_WAIT_V
#undef PG8_WAIT_L
#undef PG8_BAR
#undef PG8_SCHED
}
}

constexpr size_t MiB = 1u << 20;
constexpr size_t WS_CTL = 0, CTL_ZERO_BYTES = 64 * 1024;
constexpr size_t WS_WIN0 = 1 * MiB;
constexpr size_t WS_WIN1 = WS_WIN0 + (size_t)NP0 * DM * 2;
constexpr size_t WS_WMEM = 13 * MiB;
constexpr size_t WS_WOUT = 15 * MiB;
constexpr size_t WS_WUP = 19 * MiB;
constexpr size_t WS_WDN = 35 * MiB;
constexpr size_t WS_MEMKV = 51 * MiB;
constexpr size_t WS_LOGF = 59 * MiB;
constexpr size_t WS_CS = 61 * MiB;
constexpr size_t WS_XN = 64 * MiB;
constexpr size_t WS_R1 = 128 * MiB;
constexpr size_t WS_H = 256 * MiB;
constexpr size_t WS_PROJ = 256 * MiB;
constexpr size_t WS_MEMN = 464 * MiB;
constexpr size_t WS_END = 512 * MiB;
static_assert(WS_WIN1 + (size_t)NP1 * DM * 2 <= WS_WMEM && WS_PROJ + (size_t)MTOK * NP0 * 2 <= WS_MEMN, "d_ws map");
constexpr int CW_BAR = 4096;

constexpr int RING_OFF = 0, RING_BYTES = 131072;
constexpr int LDSCTL_OFF = RING_BYTES, MISC_OFF = LDSCTL_OFF + 320;
constexpr int LDS_BYTES = 147456;
constexpr int NWAVES = 8;

#define GAS __attribute__((address_space(1)))
#define LAS __attribute__((address_space(3)))
typedef unsigned short bf16;
typedef unsigned v4u __attribute__((ext_vector_type(4)));
typedef float f32x4 __attribute__((ext_vector_type(4)));
typedef GAS unsigned gu32;
#define LDS_WAIT() asm volatile("s_waitcnt lgkmcnt(0)" ::: "memory")
#define VM_WAIT() asm volatile("s_waitcnt vmcnt(0)" ::: "memory")
__device__ __forceinline__ unsigned f2bf(float f) { unsigned u = __builtin_bit_cast(unsigned, f); return (u + 0x7fffu + ((u >> 16) & 1u)) >> 16; }
__device__ __forceinline__ unsigned pk2(float lo, float hi) { return f2bf(lo) | (f2bf(hi) << 16); }
__device__ __forceinline__ float bflo(unsigned u) { return __builtin_bit_cast(float, u << 16); }
__device__ __forceinline__ float bfhi(unsigned u) { return __builtin_bit_cast(float, u & 0xffff0000u); }

namespace attn_body {
using bf16=__hip_bfloat16;
using bf16x8=__attribute__((ext_vector_type(8)))short;
using s16x4=__attribute__((ext_vector_type(4)))short;
using f32x16=__attribute__((ext_vector_type(16)))float;
using u32x4=__attribute__((ext_vector_type(4)))unsigned;
using f32x4v=__attribute__((ext_vector_type(4)))float;
constexpr int BATCH=16,NHEAD=12,SEQ=2048,D=64,DM=2816;
constexpr int NW=8,QBLK=32,QB=QBLK*NW,KVBLK=64,NQB=SEQ/QB;
constexpr int ATTN_PITCH=DM, ATTN_UNIT_ROWS=QB;
__device__ __forceinline__ int crow(int r,int hi){return (r&3)+8*(r>>2)+4*hi;}
#define SBAR() __builtin_amdgcn_sched_barrier(0)
__device__ __forceinline__ void cmask(f32x16&p0,f32x16&p1,int jb,int qrel,int hi){
  const float NEG=-INFINITY; int kb=64*jb+4*hi;
  #pragma unroll
  for(int r=0;r<16;++r){int kv=kb+(r&3)+8*(r>>2); if(kv>qrel)p0[r]=NEG; if(kv+32>qrel)p1[r]=NEG;}
}

constexpr int NSLOT=3, SLOTB=8192;
constexpr int LDS_K=0, LDS_V=NSLOT*SLOTB, LDS_WS=2*NSLOT*SLOTB, LDS_OST=LDS_WS+NW*64*4, LDS_BIAS=LDS_OST+NW*4096, LDS_BYTES=LDS_BIAS+SEQ*4;
constexpr float C2=0.125f*1.4426950408889634f;
__device__ __forceinline__ void glds16(const void*gsrc,unsigned lds_dst){unsigned keep;
  asm volatile("s_mov_b32 %0, m0\n\ts_mov_b32 m0, %2\n\ts_nop 0\n\tglobal_load_lds_dwordx4 %1, off\n\ts_mov_b32 m0, %0":"=&s"(keep):"v"(gsrc),"s"(lds_dst):"memory");}
__device__ __forceinline__ float max3f(float a,float b,float c){float r;asm("v_max3_f32 %0, %1, %2, %3":"=v"(r):"v"(a),"v"(b),"v"(c));return r;}
__device__ __forceinline__ float max2f(float a,float b){float r;asm("v_max_f32_e32 %0, %1, %2":"=v"(r):"v"(a),"v"(b));return r;}
__device__ __forceinline__ float fadd_s(float a,float b){float r;asm("v_add_f32_e32 %0, %1, %2":"=v"(r):"v"(a),"v"(b));return r;}
__device__ __forceinline__ float fsub_s(float a,float b){float r;asm("v_sub_f32_e32 %0, %1, %2":"=v"(r):"v"(a),"v"(b));return r;}
typedef float f32x2_t __attribute__((ext_vector_type(2))); typedef __bf16 bf16x2_t __attribute__((ext_vector_type(2)));
__device__ __forceinline__ unsigned cvtpk_s(float lo,float hi){f32x2_t v={lo,hi};bf16x2_t b=__builtin_convertvector(v,bf16x2_t);return __builtin_bit_cast(unsigned,b);}
#define WAIT_BAR(N) asm volatile("s_waitcnt vmcnt(" #N ") lgkmcnt(0)\n\ts_barrier":::"memory")

__device__ __forceinline__ void qkt(f32x16&p0,f32x16&p1,const char*Kslot,const bf16x8*qr,const f32x16&c0i,const f32x16&c1i,int r32,int hi){
  const char*kb=Kslot+hi*1024+r32*16;
  #pragma unroll
  for(int d0=0;d0<4;++d0){
    const bf16x8 b0=*reinterpret_cast<const bf16x8*>(kb+d0*2048);
    const bf16x8 b1=*reinterpret_cast<const bf16x8*>(kb+d0*2048+512);
    if(d0==0){p0=__builtin_amdgcn_mfma_f32_32x32x16_bf16(b0,qr[0],c0i,0,0,0);p1=__builtin_amdgcn_mfma_f32_32x32x16_bf16(b1,qr[0],c1i,0,0,0);}
    else{p0=__builtin_amdgcn_mfma_f32_32x32x16_bf16(b0,qr[d0],p0,0,0,0);p1=__builtin_amdgcn_mfma_f32_32x32x16_bf16(b1,qr[d0],p1,0,0,0);}}
}
typedef __attribute__((address_space(3))) const char* lds_cptr;
typedef short v4i16_t __attribute__((ext_vector_type(4)));
__device__ __forceinline__ void kload8(bf16x8*kf,lds_cptr kp){
  kf[0]=*(const __attribute__((address_space(3))) bf16x8*)(kp);      kf[1]=*(const __attribute__((address_space(3))) bf16x8*)(kp+512);
  kf[2]=*(const __attribute__((address_space(3))) bf16x8*)(kp+2048); kf[3]=*(const __attribute__((address_space(3))) bf16x8*)(kp+2560);
  kf[4]=*(const __attribute__((address_space(3))) bf16x8*)(kp+4096); kf[5]=*(const __attribute__((address_space(3))) bf16x8*)(kp+4608);
  kf[6]=*(const __attribute__((address_space(3))) bf16x8*)(kp+6144); kf[7]=*(const __attribute__((address_space(3))) bf16x8*)(kp+6656);
}
__device__ __forceinline__ void kload2(bf16x8*kf,lds_cptr kp,int j){ kf[2*j]=*(const __attribute__((address_space(3))) bf16x8*)(kp+j*2048); kf[2*j+1]=*(const __attribute__((address_space(3))) bf16x8*)(kp+j*2048+512); }
__device__ __forceinline__ s16x4 vtr(lds_cptr p){ return __builtin_bit_cast(s16x4,__builtin_amdgcn_ds_read_tr16_b64_v4i16((__attribute__((address_space(3))) v4i16_t*)p)); }
__device__ __forceinline__ float rowmax(const f32x16&p0,const f32x16&p1){
  float a=max3f(p0[0],p0[1],p1[0]),b=max3f(p0[2],p0[3],p1[1]);a=max3f(a,p1[2],p1[3]);
  #pragma unroll
  for(int r=4;r<16;r+=4){a=max3f(a,p0[r],p0[r+1]);b=max3f(b,p0[r+2],p0[r+3]);a=max3f(a,p1[r],p1[r+1]);b=max3f(b,p1[r+2],p1[r+3]);}
  const float m=max2f(a,b);
  auto rr=__builtin_amdgcn_permlane32_swap(__float_as_uint(m),__float_as_uint(m),false,false);
  return max2f(__uint_as_float(rr[0]),__uint_as_float(rr[1]));
}
__device__ __forceinline__ void pv(f32x16*o,int vb,bf16x8 pa0,bf16x8 pa1,bf16x8 pa2,bf16x8 pa3){
  #pragma unroll
  for(int d0=0;d0<2;++d0){s16x4 lo[4],hi[4];
    #pragma unroll
    for(int ks=0;ks<4;++ks){
      asm volatile("ds_read_b64_tr_b16 %0,%1 offset:%c2":"=&v"(lo[ks]):"v"(vb),"i"(d0*4096+ks*1024):"memory");
      asm volatile("ds_read_b64_tr_b16 %0,%1 offset:%c2":"=&v"(hi[ks]):"v"(vb),"i"(d0*4096+ks*1024+512):"memory");}
    asm volatile("s_waitcnt lgkmcnt(0)":::"memory");SBAR();
    #define PK(k) (bf16x8){lo[k][0],lo[k][1],lo[k][2],lo[k][3],hi[k][0],hi[k][1],hi[k][2],hi[k][3]}
    o[d0]=__builtin_amdgcn_mfma_f32_32x32x16_bf16(pa0,PK(0),o[d0],0,0,0);
    o[d0]=__builtin_amdgcn_mfma_f32_32x32x16_bf16(pa1,PK(1),o[d0],0,0,0);
    o[d0]=__builtin_amdgcn_mfma_f32_32x32x16_bf16(pa2,PK(2),o[d0],0,0,0);
    o[d0]=__builtin_amdgcn_mfma_f32_32x32x16_bf16(pa3,PK(3),o[d0],0,0,0);
    #undef PK
  }
}

#ifndef ATTN_STORE16
#define ATTN_STORE16(p,v) (*(u32x4*)(p)=(v))
#endif
template<int THRL,int PQ,int PKV,bool CAUSAL,bool BIAS> __device__ __forceinline__ void attn_unit(const bf16*Qu,const bf16*__restrict__ Kh,const bf16*__restrict__ Vh,bf16*Ou,const int PO,const float*cs,const int NT,char*shm){
  const int tid=threadIdx.x,lane=tid&63,r32=lane&31,hi=lane>>5; const int wid=__builtin_amdgcn_readfirstlane(tid>>6);
  const bf16*Qw=Qu+(long)(wid*QBLK)*PQ;
  const unsigned lds0=(unsigned)(uintptr_t)shm;
  float*wsf=(float*)(shm+LDS_WS)+wid*64;
  const bf16*ksrc=Kh+(long)lane*PKV+wid*8;
  const bf16*vsrc=Vh+(long)(16*(wid&3)+(lane>>2))*PKV+(wid>>2)*32+(lane&3)*8;
  const unsigned kdst=lds0+LDS_K+wid*1024, vdst=lds0+LDS_V+wid*1024;
  #define DMA_K(t,slot) glds16(ksrc+(long)(t)*KVBLK*PKV,(unsigned)__builtin_amdgcn_readfirstlane(kdst+(slot)))
  #define DMA_V(t,slot) glds16(vsrc+(long)(t)*KVBLK*PKV,(unsigned)__builtin_amdgcn_readfirstlane(vdst+(slot)))
  const int vb0=(int)(lds0+LDS_V)+((lane>>4)&1)*32+(lane&3)*8+(4*hi+((lane&15)>>2))*64;
  const char*Kbase=shm+LDS_K; bf16x8 kf[8];
  const lds_cptr shm3=(lds_cptr)shm; const lds_cptr kp0=shm3+LDS_K+hi*1024+r32*16; const lds_cptr vp0=shm3+LDS_V+((lane>>4)&1)*32+(lane&3)*8+(4*hi+((lane&15)>>2))*64;
  typedef __attribute__((address_space(3))) float lds_f32; typedef __attribute__((address_space(3))) const f32x4v lds_cf4;
  lds_f32*biasw=(lds_f32*)(shm3+LDS_BIAS);
  { int tb_=tid; asm volatile("":"+v"(tb_));
    if(BIAS){ _Pragma("clang loop vectorize(disable) unroll(disable)") for(int i=tb_;i<NT*KVBLK;i+=NW*64)biasw[i]=-cs[i]; } }
  const lds_cf4*biasr=(const lds_cf4*)(shm3+LDS_BIAS)+hi;
  #define BINIT(C0,C1,t,mh) do{ if(BIAS){ _Pragma("unroll") for(int g_=0;g_<4;++g_){ const f32x4v b0_=biasr[16*(t)+2*g_], b1_=biasr[16*(t)+8+2*g_]; \
      C0[4*g_]=b0_[0]-(mh);C0[4*g_+1]=b0_[1]-(mh);C0[4*g_+2]=b0_[2]-(mh);C0[4*g_+3]=b0_[3]-(mh); C1[4*g_]=b1_[0]-(mh);C1[4*g_+1]=b1_[1]-(mh);C1[4*g_+2]=b1_[2]-(mh);C1[4*g_+3]=b1_[3]-(mh);} } \
    else { const float nm_=-(mh); _Pragma("unroll") for(int r_=0;r_<16;++r_){C0[r_]=nm_;C1[r_]=nm_;} } }while(0)
  DMA_K(0,0);DMA_V(0,0);DMA_K(1,SLOTB);
  bf16x8 qr[4];
  #pragma unroll
  for(int d0=0;d0<4;++d0)qr[d0]=*reinterpret_cast<const bf16x8*>(&Qw[(long)r32*PQ+d0*16+hi*8]);
  float mhat=0.f,l_reg=0.f;f32x16 o[2];o[0]=f32x16{};o[1]=f32x16{};
  const int qrel=wid*QBLK+r32;
  #define CMASK(P0,P1,t) do{ if(CAUSAL){int jb_=(t)-(NT-4); if(jb_>=0)cmask(P0,P1,jb_,qrel,hi);} }while(0)
  bool resc=false;
  #define START(P0,P1) do{ const float rm=rowmax(P0,P1); resc=false; \
    { const float dl=rm; mhat=fadd_s(mhat,dl); \
      _Pragma("unroll") for(int r=0;r<16;++r){P0[r]=fsub_s(P0[r],dl);P1[r]=fsub_s(P1[r],dl);} \
      } \
    _Pragma("unroll") for(int r=0;r<16;++r)P0[r]=__builtin_amdgcn_exp2f(P0[r]); }while(0)
  #define RESC() do{ if(resc){ asm volatile("s_waitcnt lgkmcnt(0)":::"memory"); \
      _Pragma("unroll") for(int d_=0;d_<2;++d_) _Pragma("unroll") for(int r=0;r<16;++r)o[d_][r]*=wsf[crow(r,hi)]; } }while(0)
  f32x16 pA0,pA1,pB0,pB1;
  int sl_prev=0,sl_cur=0,sl_next=SLOTB;
  #define ROT() do{sl_prev=sl_cur;sl_cur=sl_next;sl_next=(sl_next==(NSLOT-1)*SLOTB)?0:sl_next+SLOTB;}while(0)
  DMA_K(2,2*SLOTB);
  WAIT_BAR(3);
  BINIT(pA0,pA1,0,0.f);
  qkt(pA0,pA1,Kbase,qr,pA0,pA1,r32,hi);asm volatile("s_nop 15\n\ts_nop 7":"+v"(pA0),"+v"(pA1));CMASK(pA0,pA1,0);
  START(pA0,pA1);
  _Pragma("unroll") for(int r=0;r<16;++r)pA1[r]=__builtin_amdgcn_exp2f(pA1[r]);
  WAIT_BAR(0);
  DMA_K(3,0);DMA_V(1,SLOTB);
  ROT();
  kload8(kf,kp0+sl_cur);
  WAIT_BAR(2);
  s16x4 vlo[8],vhi[8]; u32x4 pw0,pw1,pw2,pw3;
  #define PKW(P,B) cvtpk_s(P[B],P[B+1])
  #define PAF(k) __builtin_bit_cast(bf16x8,pw##k)
  #define VFR(i) (bf16x8){vlo[i][0],vlo[i][1],vlo[i][2],vlo[i][3],vhi[i][0],vhi[i][1],vhi[i][2],vhi[i][3]}
  #define PIN(x) asm volatile("":"+v"(x))
  #define MX3(a,b,c) __builtin_fmaxf(__builtin_fmaxf((a),(b)),(c))
  #define GAPA(MF,A0,A1,A2,A3,W0,W1,PW) do{ MF; sacc+=A0; sacc+=A1; sacc+=A2; sacc+=A3; PIN(sacc); W0; W1; PIN(PW); SBAR(); }while(0)
  #define EX(v) __builtin_amdgcn_exp2f(v)
  #define GAPB(MF,X,B) do{ MF; X[B]=EX(X[B]); X[B+1]=EX(X[B+1]); X[B+2]=EX(X[B+2]); X[B+3]=EX(X[B+3]); PIN(X); SBAR(); }while(0)
  #define VRD(i) do{ vlo[i]=vtr(vp_+(((i)>>2)*4096+((i)&3)*1024)); vhi[i]=vtr(vp_+(((i)>>2)*4096+((i)&3)*1024+512)); }while(0)
  #define KRD(G,j) do{ if(G){ kload2(kf,kp0+sl_next,j); SBAR(); } }while(0)
  #define STEP(C0,C1,P0,P1,t,GK,GV,GL) do{ SBAR(); \
    BINIT(C0,C1,t,mhat); SBAR(); \
    const lds_cptr vp_=vp0+sl_prev; \
    VRD(0); SBAR(); float sacc=(P0[0]+P0[1]); \
    GAPA(C0=__builtin_amdgcn_mfma_f32_32x32x16_bf16(kf[0],qr[0],C0,0,0,0), P0[2],P0[3],P0[4],P0[5],     pw0[0]=PKW(P0,0), pw0[1]=PKW(P0,2), pw0); \
    VRD(4); SBAR(); GAPA(C1=__builtin_amdgcn_mfma_f32_32x32x16_bf16(kf[1],qr[0],C1,0,0,0), P0[6],P0[7],P0[8],P0[9],     pw0[2]=PKW(P0,4), pw0[3]=PKW(P0,6), pw0); \
    VRD(1); SBAR(); GAPA(C0=__builtin_amdgcn_mfma_f32_32x32x16_bf16(kf[2],qr[1],C0,0,0,0),   P0[10],P0[11],P0[12],P0[13], pw1[0]=PKW(P0,8), pw1[1]=PKW(P0,10), pw1); \
    VRD(5); SBAR(); GAPA(C1=__builtin_amdgcn_mfma_f32_32x32x16_bf16(kf[3],qr[1],C1,0,0,0),   P0[14],P0[15],P1[0],P1[1],   pw1[2]=PKW(P0,12),pw1[3]=PKW(P0,14), pw1); \
    VRD(2); SBAR(); GAPA(C0=__builtin_amdgcn_mfma_f32_32x32x16_bf16(kf[4],qr[2],C0,0,0,0),   P1[2],P1[3],P1[4],P1[5],     pw2[0]=PKW(P1,0), pw2[1]=PKW(P1,2), pw2); \
    VRD(6); SBAR(); GAPA(C1=__builtin_amdgcn_mfma_f32_32x32x16_bf16(kf[5],qr[2],C1,0,0,0),   P1[6],P1[7],P1[8],P1[9],     pw2[2]=PKW(P1,4), pw2[3]=PKW(P1,6), pw2); \
    VRD(3); SBAR(); GAPA(C0=__builtin_amdgcn_mfma_f32_32x32x16_bf16(kf[6],qr[3],C0,0,0,0),   P1[10],P1[11],P1[12],P1[13], pw3[0]=PKW(P1,8), pw3[1]=PKW(P1,10), pw3); \
    VRD(7); SBAR(); GAPA(C1=__builtin_amdgcn_mfma_f32_32x32x16_bf16(kf[7],qr[3],C1,0,0,0),   P1[14],P1[15],0.f,0.f,       pw3[2]=PKW(P1,12),pw3[3]=PKW(P1,14), pw3); \
    l_reg+=sacc; \
    if(GK){DMA_K((t)+3,sl_cur);} if(GV){DMA_V((t)+1,sl_next);} \
    CMASK(C0,C1,t); \
    { float a=MX3(C0[0],C0[1],C1[0]),b=MX3(C0[2],C0[3],C1[1]); a=MX3(a,C1[2],C1[3]); \
      _Pragma("unroll") for(int r=4;r<16;r+=4){a=MX3(a,C0[r],C0[r+1]);b=MX3(b,C0[r+2],C0[r+3]);a=MX3(a,C1[r],C1[r+1]);b=MX3(b,C1[r+2],C1[r+3]);} \
      float rm=__builtin_fmaxf(a,b); { auto rr=__builtin_amdgcn_permlane32_swap(__float_as_uint(rm),__float_as_uint(rm),false,false); rm=__builtin_fmaxf(__uint_as_float(rr[0]),__uint_as_float(rr[1])); } \
      resc=false; \
      if(__builtin_expect(__any(rm>(float)THRL),0)){ const float dl=__builtin_fmaxf(rm,0.f); mhat+=dl; \
        _Pragma("unroll") for(int r=0;r<16;++r){C0[r]-=dl;C1[r]-=dl;} \
        const float f=__builtin_amdgcn_exp2f(-dl); l_reg*=f; if(hi==0)wsf[r32]=f; resc=true; } } \
    SBAR(); \
    GAPB(o[0]=__builtin_amdgcn_mfma_f32_32x32x16_bf16(PAF(0),VFR(0),o[0],0,0,0), C0,0); \
    GAPB(o[1]=__builtin_amdgcn_mfma_f32_32x32x16_bf16(PAF(0),VFR(4),o[1],0,0,0), C0,4); \
    KRD(GL,0); GAPB(o[0]=__builtin_amdgcn_mfma_f32_32x32x16_bf16(PAF(1),VFR(1),o[0],0,0,0), C0,8); \
    KRD(GL,1); GAPB(o[1]=__builtin_amdgcn_mfma_f32_32x32x16_bf16(PAF(1),VFR(5),o[1],0,0,0), C0,12); \
    KRD(GL,2); GAPB(o[0]=__builtin_amdgcn_mfma_f32_32x32x16_bf16(PAF(2),VFR(2),o[0],0,0,0), C1,0); \
    KRD(GL,3); GAPB(o[1]=__builtin_amdgcn_mfma_f32_32x32x16_bf16(PAF(2),VFR(6),o[1],0,0,0), C1,4); \
    GAPB(o[0]=__builtin_amdgcn_mfma_f32_32x32x16_bf16(PAF(3),VFR(3),o[0],0,0,0), C1,8); \
    GAPB(o[1]=__builtin_amdgcn_mfma_f32_32x32x16_bf16(PAF(3),VFR(7),o[1],0,0,0), C1,12); \
    }while(0)
  int t=1;
  #undef CMASK
  #define CMASK(P0,P1,t) do{}while(0)
  for(;t+5<NT;t+=2){
    STEP(pB0,pB1,pA0,pA1,t,true,true,true);     WAIT_BAR(2); RESC(); ROT();
    STEP(pA0,pA1,pB0,pB1,t+1,true,true,true);   WAIT_BAR(2); RESC(); ROT();
  }
  #undef CMASK
  #define CMASK(P0,P1,t) do{ if(CAUSAL){int jb_=(t)-(NT-4); if(jb_>=0)cmask(P0,P1,jb_,qrel,hi);} }while(0)
  #define ENDW(tt) do{ if((tt)+3<NT){WAIT_BAR(2);} else if((tt)+2<NT){WAIT_BAR(1);} else {WAIT_BAR(0);} }while(0)
  for(;t+1<NT;t+=2){
    STEP(pB0,pB1,pA0,pA1,t,(t+3<NT),(t+1<NT),(t+1<NT));       ENDW(t);   RESC(); ROT();
    STEP(pA0,pA1,pB0,pB1,t+1,(t+4<NT),(t+2<NT),(t+2<NT));     ENDW(t+1); RESC(); ROT();
  }
  STEP(pB0,pB1,pA0,pA1,NT-1,false,false,false); RESC();
  { float sacc=pB0[0]+pB0[1]; _Pragma("unroll") for(int r=2;r<16;++r)sacc+=pB0[r]; _Pragma("unroll") for(int r=0;r<16;++r)sacc+=pB1[r]; l_reg+=sacc;
    pw0=(u32x4){PKW(pB0,0),PKW(pB0,2),PKW(pB0,4),PKW(pB0,6)};pw1=(u32x4){PKW(pB0,8),PKW(pB0,10),PKW(pB0,12),PKW(pB0,14)};pw2=(u32x4){PKW(pB1,0),PKW(pB1,2),PKW(pB1,4),PKW(pB1,6)};pw3=(u32x4){PKW(pB1,8),PKW(pB1,10),PKW(pB1,12),PKW(pB1,14)};
    SBAR(); pv(o,vb0+sl_cur,PAF(0),PAF(1),PAF(2),PAF(3)); }
  #undef PKW
  #undef PAF
  #undef VFR
  #undef PIN
  #undef MX3
  #undef GAPA
  #undef GAPB
  #undef EX
  #undef VRD
  #undef KRD
  #undef STEP
  #undef ENDW
  {auto rr=__builtin_amdgcn_permlane32_swap(__float_as_uint(l_reg),__float_as_uint(l_reg),false,false);l_reg=__uint_as_float(rr[0])+__uint_as_float(rr[1]);}
  if(hi==0)wsf[32+r32]=l_reg;asm volatile("s_waitcnt lgkmcnt(0)":::"memory");
  float rli[16];
  #pragma unroll
  for(int r=0;r<16;++r)rli[r]=__builtin_amdgcn_rcpf(wsf[32+crow(r,hi)]);
  bf16*Ow=Ou+(long)(wid*QBLK)*PO;
  { bf16*stg=(bf16*)(shm+LDS_OST)+wid*2048;
    #pragma unroll
    for(int r=0;r<16;++r){const int orow=crow(r,hi);
      #pragma unroll
      for(int d0=0;d0<2;++d0)stg[orow*64+d0*32+r32]=__float2bfloat16(o[d0][r]*rli[r]);}
    asm volatile("s_waitcnt lgkmcnt(0)":::"memory");
    #pragma unroll
    for(int i=0;i<4;++i){const int row=i*8+(lane>>3),ch=lane&7; const u32x4 v=*(const u32x4*)(stg+row*64+ch*8); ATTN_STORE16(Ow+(long)row*PO+ch*8,v);} }
  asm volatile("s_waitcnt lgkmcnt(0)\n\ts_barrier":::"memory");
  #undef BINIT
  #undef DMA_K
  #undef DMA_V
  #undef CMASK
  #undef START
  #undef RESC
  #undef ROT
}
constexpr int ATTN_LDS_BYTES=LDS_BYTES;
template<int THRL=8> __device__ __forceinline__ void fox_phase(char*lds,const bf16*PROJ,const float*CS,bf16*O,const int PO,int grid,int block){
  constexpr int PQ=2816; const int vcu=(block%8)*(grid/8)+block/8;
  for(int i=0;i<6;++i){ const int p=vcu*3+(i>>1), bh=p>>2, x=p&3, qb=(i&1)?7-x:x, b=bh/12, h=bh%12;
    const bf16*rowb=PROJ+(long)b*SEQ*PQ;
    attn_unit<THRL,PQ,PQ,true,true>(rowb+(long)qb*QB*PQ+0+h*D, rowb+1024+h*D, rowb+1792+h*D, O+((long)b*SEQ+(long)qb*QB)*PO+h*D, PO, CS+(long)bh*SEQ, 4*qb+4, lds); }
}
template<int PQ,int THRL=8> __device__ __forceinline__ void mem_phase(char*lds,const bf16*PROJ,const bf16*MEMKV,bf16*O,const int PO,int layer,int u0,int ustride){
  for(int u=u0;u<512;u+=ustride){ const int b=u>>5, hm=(u>>3)&3, qb=u&7;
    const bf16*qp=PROJ+((long)b*SEQ+(long)qb*QB)*PQ+768+hm*D; const bf16*kv=MEMKV+(long)b*256*1024+layer*512+hm*D;
    attn_unit<THRL,PQ,1024,false,false>(qp, kv, kv+256, O+((long)b*SEQ+(long)qb*QB)*PO+hm*D, PO, nullptr, 4, lds); }
}
#undef SBAR
#undef WAIT_BAR
}
namespace ret_body {
using attn_body::bf16x8; using attn_body::s16x4; using attn_body::f32x16; using attn_body::u32x4; using attn_body::f32x4v; using attn_body::crow; using attn_body::cvtpk_s;
typedef __attribute__((address_space(3))) unsigned char* lptr;
typedef short v4i16_t __attribute__((ext_vector_type(4)));
constexpr int RP = 3328;
constexpr int KC = 0, KT = 32768, VT = 65536, ST = 98304, PSUM = 131072 + 1024;
__device__ __forceinline__ s16x4 trd(lptr p) { return __builtin_bit_cast(s16x4, __builtin_amdgcn_ds_read_tr16_b64_v4i16((__attribute__((address_space(3))) v4i16_t*)p)); }
__device__ __forceinline__ bf16x8 frag2(lptr p, int off) { const s16x4 lo = trd(p + off), hi = trd(p + off + 512  ); return (bf16x8){lo[0], lo[1], lo[2], lo[3], hi[0], hi[1], hi[2], hi[3]}; }
__device__ __forceinline__ bf16x8 frag2n(lptr p, int off) { const s16x4 lo = trd(p + off), hi = trd(p + off + 256  ); return (bf16x8){lo[0], lo[1], lo[2], lo[3], hi[0], hi[1], hi[2], hi[3]}; }
__device__ __forceinline__ float bfl(unsigned u) { return __builtin_bit_cast(float, u << 16); }
__device__ __forceinline__ float bfh(unsigned u) { return __builtin_bit_cast(float, u & 0xffff0000u); }
__device__ __forceinline__ u32x4 scale8(u32x4 v, float s) { u32x4 r; r.x = cvtpk_s(bfl(v.x) * s, bfh(v.x) * s); r.y = cvtpk_s(bfl(v.y) * s, bfh(v.y) * s); r.z = cvtpk_s(bfl(v.z) * s, bfh(v.z) * s); r.w = cvtpk_s(bfl(v.w) * s, bfh(v.w) * s); return r; }
#define RBAR() asm volatile("s_waitcnt vmcnt(0) lgkmcnt(0)\n\ts_barrier" ::: "memory")
#define RBAR_L() asm volatile("s_waitcnt lgkmcnt(0)\n\ts_barrier" ::: "memory")
#ifdef TS_P1
#define TSPT(k) do { if (c == 8 && blockIdx.x == 0 && threadIdx.x == 0) { if ((k) == TS_P1) ((volatile unsigned long long*)TSP)[0] = __builtin_amdgcn_s_memrealtime(); if ((k) == TS_P2) ((volatile unsigned long long*)TSP)[1] = __builtin_amdgcn_s_memrealtime(); } } while (0)
#else
#define TSPT(k) do {} while (0)
#endif

__device__ __forceinline__ void ret_unit(int b, int h, unsigned short* PROJ, unsigned short* O, const int OP, lptr lds, void* TSP = nullptr) {
    int tid_ = threadIdx.x; asm volatile("" : "+v"(tid_));
    const int tid = tid_, lane = tid & 63, r32 = lane & 31, hi = lane >> 5; const int wid = __builtin_amdgcn_readfirstlane(tid >> 6), g = wid >> 1, e = wid & 1;
    const float lg = __log2f(1.f - exp2f(-5.f - (float)h));
    const float g128 = exp2f(128.f * lg);
    unsigned short* base = PROJ + (size_t)b * SEQ * RP + h * 128;
    const int tt = tid >> 2, qq = tid & 3;
    const float vsc = exp2f(-(float)(tt + 1) * lg);
    const unsigned short* kg = base + (size_t)tt * RP + C_K + qq * 32; const unsigned short* vg = base + (size_t)tt * RP + C_V + qq * 32;
    lptr kc_w = lds + KC + (4 * qq) * 2048 + tt * 16, kt_w = lds + KT + qq * 8192 + tt * 64, vt_w = lds + VT + qq * 8192 + tt * 64;
    lptr kc_r = lds + KC + hi * 2048 + r32 * 16;
    const int trb = ((lane >> 4) & 1) * 32 + (lane & 3) * 8;
    const int trp = (4 * hi + ((lane & 15) >> 2)) * 64 + trb, trn = (8 * hi + ((lane & 15) >> 2)) * 64 + trb;
    lptr vt_r = lds + VT + (2 * e) * 8192 + trp, kt_r = lds + KT + g * 8192 + trp, st_r = lds + ST + (2 * e) * 8192 + trn;
    lptr st_w = lds + ST + (2 * e) * 8192 + (32 * g) * 64 + r32 * 2;
    __attribute__((address_space(3))) float* psum = (__attribute__((address_space(3))) float*)(lds + PSUM);
    u32x4 kp[4], vp[4];
#pragma unroll
    for (int i = 0; i < 4; ++i) { kp[i] = *(const u32x4*)(kg + i * 8); vp[i] = *(const u32x4*)(vg + i * 8); }
    f32x16 st[2]; st[0] = f32x16{}; st[1] = f32x16{};
#pragma unroll
    for (int d = 0; d < 2; ++d)
#pragma unroll
        for (int r = 0; r < 16; ++r) *(__attribute__((address_space(3))) unsigned short*)(st_w + d * 8192 + crow(r, hi) * 64) = 0;
#pragma unroll
    for (int i = 0; i < 4; ++i) { *(__attribute__((address_space(3))) u32x4*)(kc_w + i * 2048) = kp[i]; *(__attribute__((address_space(3))) u32x4*)(kt_w + i * 16) = kp[i];
        *(__attribute__((address_space(3))) u32x4*)(vt_w + i * 16) = scale8(vp[i], vsc); }
    bf16x8 qr[8];
    { const unsigned short* qg = base + (size_t)(32 * g + r32) * RP + C_Q + hi * 8;
#pragma unroll
      for (int d0 = 0; d0 < 8; ++d0) qr[d0] = *(const bf16x8*)(qg + d0 * 16); }
#pragma unroll
    for (int i = 0; i < 4; ++i) { kp[i] = *(const u32x4*)(kg + (size_t)128 * RP + i * 8); vp[i] = *(const u32x4*)(vg + (size_t)128 * RP + i * 8); }
    RBAR_L();
    for (int c = 0; c < 16; ++c) {
        TSPT(0);
        f32x16 o[2]; o[0] = f32x16{}; o[1] = f32x16{};
#pragma unroll
        for (int d0 = 0; d0 < 8; ++d0) { const bf16x8 s0 = frag2n(st_r, d0 * 1024), s1 = frag2n(st_r, d0 * 1024 + 8192);
            o[0] = __builtin_amdgcn_mfma_f32_32x32x16_bf16(qr[d0], s0, o[0], 0, 0, 0); o[1] = __builtin_amdgcn_mfma_f32_32x32x16_bf16(qr[d0], s1, o[1], 0, 0, 0);
            if (d0 & 1) __builtin_amdgcn_sched_barrier(0); }
        TSPT(1);
        for (int jb = 0; jb <= g; ++jb) {
            f32x16 p = f32x16{};
#pragma unroll
            for (int d0 = 0; d0 < 8; ++d0) { const bf16x8 kf = *(const __attribute__((address_space(3))) bf16x8*)(kc_r + d0 * 4096 + jb * 512); p = __builtin_amdgcn_mfma_f32_32x32x16_bf16(kf, qr[d0], p, 0, 0, 0); }
            if (jb == g) {
#pragma unroll
                for (int r = 0; r < 16; ++r) if (crow(r, hi) > r32) p[r] = 0.f; }
            u32x4 pw0, pw1; pw0.x = cvtpk_s(p[0], p[1]); pw0.y = cvtpk_s(p[2], p[3]); pw0.z = cvtpk_s(p[4], p[5]); pw0.w = cvtpk_s(p[6], p[7]);
            pw1.x = cvtpk_s(p[8], p[9]); pw1.y = cvtpk_s(p[10], p[11]); pw1.z = cvtpk_s(p[12], p[13]); pw1.w = cvtpk_s(p[14], p[15]);
            const bf16x8 v00 = frag2(vt_r, (2 * jb) * 1024), v01 = frag2(vt_r, (2 * jb) * 1024 + 8192), v10 = frag2(vt_r, (2 * jb + 1) * 1024), v11 = frag2(vt_r, (2 * jb + 1) * 1024 + 8192);
            o[0] = __builtin_amdgcn_mfma_f32_32x32x16_bf16(__builtin_bit_cast(bf16x8, pw0), v00, o[0], 0, 0, 0); o[1] = __builtin_amdgcn_mfma_f32_32x32x16_bf16(__builtin_bit_cast(bf16x8, pw0), v01, o[1], 0, 0, 0);
            o[0] = __builtin_amdgcn_mfma_f32_32x32x16_bf16(__builtin_bit_cast(bf16x8, pw1), v10, o[0], 0, 0, 0); o[1] = __builtin_amdgcn_mfma_f32_32x32x16_bf16(__builtin_bit_cast(bf16x8, pw1), v11, o[1], 0, 0, 0);
        }
        TSPT(2);
        u32x4 gt[4];
        { const unsigned short* gg = base + (size_t)(c * 128 + 32 * g + (lane >> 1)) * RP + C_G + 64 * e + 32 * (lane & 1);
#pragma unroll
          for (int i = 0; i < 4; ++i) gt[i] = *(const u32x4*)(gg + 8 * i); }
        if (c < 15) { const unsigned short* qg = base + (size_t)((c + 1) * 128 + 32 * g + r32) * RP + C_Q + hi * 8;
#pragma unroll
            for (int d0 = 0; d0 < 8; ++d0) qr[d0] = *(const bf16x8*)(qg + d0 * 16); }
#pragma unroll 2
        for (int s = 0; s < 8; ++s) { const bf16x8 ka = frag2(kt_r, s * 1024), v0 = frag2(vt_r, s * 1024), v1 = frag2(vt_r, s * 1024 + 8192);
            st[0] = __builtin_amdgcn_mfma_f32_32x32x16_bf16(ka, v0, st[0], 0, 0, 0); st[1] = __builtin_amdgcn_mfma_f32_32x32x16_bf16(ka, v1, st[1], 0, 0, 0); }
#pragma unroll
        for (int r = 0; r < 16; ++r) { st[0][r] *= g128; st[1][r] *= g128; }
        TSPT(3);
        float tot; int rstar;
        { float a8[8], b4[4], c2[2];
          const int b4_ = (r32 >> 4) & 1, b3_ = (r32 >> 3) & 1, b2_ = (r32 >> 2) & 1, b1_ = (r32 >> 1) & 1;
#pragma unroll
          for (int k = 0; k < 8; ++k) { const float lo = o[0][k] * o[0][k] + o[1][k] * o[1][k], hi_ = o[0][8 + k] * o[0][8 + k] + o[1][8 + k] * o[1][8 + k];
              const float send = b4_ ? lo : hi_, keep = b4_ ? hi_ : lo; a8[k] = keep + __shfl_xor(send, 16); }
#pragma unroll
          for (int k = 0; k < 4; ++k) { const float send = b3_ ? a8[k] : a8[4 + k], keep = b3_ ? a8[4 + k] : a8[k]; b4[k] = keep + __shfl_xor(send, 8); }
#pragma unroll
          for (int k = 0; k < 2; ++k) { const float send = b2_ ? b4[k] : b4[2 + k], keep = b2_ ? b4[2 + k] : b4[k]; c2[k] = keep + __shfl_xor(send, 4); }
          { const float send = b1_ ? c2[0] : c2[1], keep = b1_ ? c2[1] : c2[0]; tot = keep + __shfl_xor(send, 2); }
          tot += __shfl_xor(tot, 1);
          rstar = 8 * b4_ + 4 * b3_ + 2 * b2_ + b1_; }
        if ((r32 & 1) == 0) psum[e * 128 + 32 * g + crow(rstar, hi)] = tot;
        TSPT(4);
        RBAR_L();
        TSPT(5);
        if (c < 15) {
#pragma unroll
            for (int i = 0; i < 4; ++i) { *(__attribute__((address_space(3))) u32x4*)(kc_w + i * 2048) = kp[i]; *(__attribute__((address_space(3))) u32x4*)(kt_w + i * 16) = kp[i];
                *(__attribute__((address_space(3))) u32x4*)(vt_w + i * 16) = scale8(vp[i], vsc); }
        }
        { const __attribute__((address_space(3))) f32x4v* ps4 = (const __attribute__((address_space(3))) f32x4v*)(psum + 32 * g) + hi;
#pragma unroll
          for (int q4 = 0; q4 < 4; ++q4) { const f32x4v s0 = ps4[2 * q4], s1 = ps4[32 + 2 * q4];
#pragma unroll
              for (int k = 0; k < 4; ++k) { const int r = 4 * q4 + k; const float sc = __builtin_amdgcn_exp2f((float)(32 * g + crow(r, hi) + 1) * lg);     const float ss = (s0[k] + s1[k]) * sc * sc;
                  const float f = sc / sqrtf(ss * (1.f / 128.f) + EPS);
                  *(__attribute__((address_space(3))) unsigned short*)(st_w + crow(r, hi) * 64) = (unsigned short)cvtpk_s(o[0][r] * f, 0.f);
                  *(__attribute__((address_space(3))) unsigned short*)(st_w + 8192 + crow(r, hi) * 64) = (unsigned short)cvtpk_s(o[1][r] * f, 0.f); } }
          asm volatile("s_waitcnt lgkmcnt(0)" ::: "memory");
          lptr sp = lds + ST + (2 * e + (lane & 1)) * 8192 + (32 * g + (lane >> 1)) * 64;
          unsigned short* og = O + (size_t)(c * 128 + 32 * g + (lane >> 1)) * OP + 64 * e + 32 * (lane & 1);
#pragma unroll
          for (int i = 0; i < 4; ++i) { const u32x4 ov = *(const __attribute__((address_space(3))) u32x4*)(sp + i * 16); u32x4 w;
              w.x = cvtpk_s(bfl(ov.x) * bfl(gt[i].x), bfh(ov.x) * bfh(gt[i].x)); w.y = cvtpk_s(bfl(ov.y) * bfl(gt[i].y), bfh(ov.y) * bfh(gt[i].y));
              w.z = cvtpk_s(bfl(ov.z) * bfl(gt[i].z), bfh(ov.z) * bfh(gt[i].z)); w.w = cvtpk_s(bfl(ov.w) * bfl(gt[i].w), bfh(ov.w) * bfh(gt[i].w));
              *(u32x4*)(og + 8 * i) = w; }
          asm volatile("s_waitcnt lgkmcnt(0)" ::: "memory"); }
        TSPT(7);
        if (c < 15) {
#pragma unroll
            for (int d = 0; d < 2; ++d)
#pragma unroll
                for (int r = 0; r < 16; ++r) { const unsigned w = cvtpk_s(st[d][r], 0.f); *(__attribute__((address_space(3))) unsigned short*)(st_w + d * 8192 + crow(r, hi) * 64) = (unsigned short)w; }
            if (c < 14) {
#pragma unroll
                for (int i = 0; i < 4; ++i) { kp[i] = *(const u32x4*)(kg + (size_t)(c + 2) * 128 * RP + i * 8); vp[i] = *(const u32x4*)(vg + (size_t)(c + 2) * 128 * RP + i * 8); } }
        }
        TSPT(6);
        RBAR_L();
    }
    asm volatile("s_waitcnt vmcnt(0)" ::: "memory");
}
#undef RBAR
#undef RBAR_L
#undef TSPT
}
#define XB_TMO      128
#define XB_XCNT(j)  (256  + 64 * (j))
#define XB_XSUB(j)  (1280 + 64 * (j))
#define XB_XGEN(j)  (2304 + 64 * (j))
#define XB_TOP      3328
#define XB_TOPGEN   3392
#define XCD_BAR_WORDS 3456
#define XB_SPIN_CAP (1u << 18)

__device__ __forceinline__ unsigned xb_ld(unsigned* p)              { return __hip_atomic_load(p, __ATOMIC_RELAXED, __HIP_MEMORY_SCOPE_AGENT); }
__device__ __forceinline__ unsigned xb_add(unsigned* p, unsigned v) { return __hip_atomic_fetch_add(p, v, __ATOMIC_RELAXED, __HIP_MEMORY_SCOPE_AGENT); }
__device__ __forceinline__ unsigned xb_xcc_id() { return (unsigned)__builtin_amdgcn_s_getreg((3 << 11) | 20) & 0xFu; }
#define XB_SPIN(cond, bar) do { unsigned _sp = 0; while (cond) { __builtin_amdgcn_s_sleep(1); \
    if ((++_sp & 255u) == 0u) { if (xb_ld(&(bar)[XB_TMO])) break; if (_sp > XB_SPIN_CAP) { atomicAdd(&(bar)[XB_TMO], 1u); break; } } } } while (0)

struct XcdBarrier {
    unsigned* bar; unsigned x;
    volatile LAS unsigned* st;
};

__device__ __forceinline__ XcdBarrier xcd_barrier_post(unsigned* bar, volatile LAS unsigned* st) {
    XcdBarrier b; b.bar = bar; b.x = xb_xcc_id(); b.st = st;
    if (threadIdx.x == 0) (void)xb_add(&bar[XB_XCNT(b.x)], 1u);
    return b;
}
__device__ __forceinline__ void xcd_barrier_complete(unsigned* bar, unsigned x, unsigned& nloc, unsigned& nx) {
    const unsigned G = gridDim.x * gridDim.y * gridDim.z;
    unsigned sum, cnt, mine, sp = 0u;
    for (;;) {
        sum = 0u; cnt = 0u; mine = 0u;
#pragma unroll
        for (unsigned j = 0; j < 16; ++j) { const unsigned c = xb_ld(&bar[XB_XCNT(j)]); sum += c; cnt += (c > 0u) ? 1u : 0u; mine = (j == x) ? c : mine; }
        if (sum == G) break;
        __builtin_amdgcn_s_sleep(1);
        if ((++sp & 255u) == 0u) { if (xb_ld(&bar[XB_TMO])) break; if (sp > XB_SPIN_CAP) { atomicAdd(&bar[XB_TMO], 1u); break; } }
    }
    nloc = mine > 0u ? mine : 1u; nx = cnt > 0u ? cnt : 1u;
}

__device__ __forceinline__ void xcd_barrier(const XcdBarrier& b) {
    asm volatile("s_waitcnt vmcnt(0)" ::: "memory");
    __syncthreads();
    if (threadIdx.x == 0) {
        unsigned* bar = b.bar;
        __builtin_amdgcn_s_waitcnt(0);
        unsigned nloc = b.st[0], nx = b.st[1];
        if (nloc == 0u) { xcd_barrier_complete(bar, b.x, nloc, nx); b.st[0] = nloc; b.st[1] = nx; }
        const unsigned old = xb_add(&bar[XB_XSUB(b.x)], 1u);
        const unsigned gen = old / nloc;
        if (old + 1u == (gen + 1u) * nloc) {
            __builtin_amdgcn_fence(__ATOMIC_RELEASE, "agent");
            asm volatile("s_waitcnt vmcnt(0)" ::: "memory");
            const unsigned og = xb_add(&bar[XB_TOP], 1u);
            const unsigned tg = og / nx;
            if (og + 1u == (tg + 1u) * nx) xb_add(&bar[XB_TOPGEN], 1u);
            else XB_SPIN(xb_ld(&bar[XB_TOPGEN]) == tg, bar);
            __builtin_amdgcn_fence(__ATOMIC_ACQUIRE, "agent");
            xb_add(&bar[XB_XGEN(b.x)], 1u);
            asm volatile("s_waitcnt vmcnt(0)" ::: "memory");
        } else {
            XB_SPIN(xb_ld(&bar[XB_XGEN(b.x)]) == gen, bar);
            __builtin_amdgcn_fence(__ATOMIC_ACQUIRE, "agent");
            asm volatile("s_waitcnt vmcnt(0)" ::: "memory");
        }
    }
    __syncthreads();
}

struct Args { const float* in[15]; float* out; unsigned char* ws; int ph_lo, ph_hi; };
typedef const __attribute__((address_space(4))) Args* KArgs;
#define KA_GET() ({ KArgs k_ = (KArgs)__builtin_amdgcn_kernarg_segment_ptr(); asm volatile("" : "+s"(k_)); k_; })
#define WSP(T, off) ((T*)(ka->ws + (off)))
struct Frame {
    LAS unsigned char* lds;
    int tid, lane, wave, gw;
    int G;
};
__device__ __forceinline__ float wave_sum(float v) {
#pragma unroll
    for (int o = 1; o < 64; o <<= 1) v += __shfl_xor(v, o);
    return v;
}

__device__ __forceinline__ int dst_row(int mode, int n) {
    if (mode == 0) return n;
    if (mode == 1) {
        if (n < 768) { const int h = n >> 7, d = n & 127; return C_Q + h * 128 + ((d & 63) << 1) + (d >> 6); }
        if (n < 1536) { const int m = n - 768, h = m >> 7, d = m & 127; return C_K + h * 128 + ((d & 63) << 1) + (d >> 6); }
        if (n < 2304) return C_V + (n - 1536);
        if (n < 3072) return C_G + (n - 2304);
        return C_MQ + (n - 3072);
    }
    if (n < 768) return C_Q + n;
    if (n < 1536) return C_K + (n - 768);
    if (n < 2304) return C_V + (n - 1536);
    if (n < 2316) return C_G + (n - 2304);
    return C_MQ + (n - 2316);
}
__device__ __forceinline__ void p0_transpose_item(const float* W, int K, int N, bf16* WT, int mode, int row_off, const float* gain, LAS float* scr, int item, int lane) {
    const int nblk = (N + 31) / 32, kb = item / nblk, nb = item % nblk, k0 = 64 * kb, n0 = 32 * nb;
    const int nn = n0 + (lane & 31);
#pragma unroll 8
    for (int i = 0; i < 32; ++i) { const int kk = 2 * i + (lane >> 5);
        float v = 0.f; if (nn < N) { v = W[(size_t)(k0 + kk) * N + nn]; if (gain) v *= gain[k0 + kk]; }
        scr[kk * 33 + (lane & 31)] = v; }
    LDS_WAIT(); asm volatile("" ::: "memory");
    const int c = lane & 7;
#pragma unroll
    for (int j = 0; j < 4; ++j) { const int nl = (lane >> 3) + 8 * j; const int n = n0 + nl;
        if (n < N) { const LAS float* s = scr + (8 * c) * 33 + nl;
            v4u o; o.x = pk2(s[0 * 33], s[1 * 33]); o.y = pk2(s[2 * 33], s[3 * 33]); o.z = pk2(s[4 * 33], s[5 * 33]); o.w = pk2(s[6 * 33], s[7 * 33]);
            *(GAS v4u*)(WT + (size_t)(row_off + dst_row(mode, n)) * K + k0 + 8 * c) = o; } }
    LDS_WAIT(); asm volatile("" ::: "memory");
}
__device__ __forceinline__ void rms_row_to_bf16(const float* xrow, bf16* orow, int lane) {
    const GAS f32x4* xr = (const GAS f32x4*)xrow + lane;
    f32x4 v[4]; float s = 0.f;
#pragma unroll
    for (int j = 0; j < 4; ++j) { v[j] = xr[64 * j]; s += (v[j].x * v[j].x + v[j].y * v[j].y) + (v[j].z * v[j].z + v[j].w * v[j].w); }
    const float rstd = 1.0f / sqrtf(wave_sum(s) * (1.f / DM) + EPS);
    GAS unsigned long long* o8 = (GAS unsigned long long*)orow + lane;
#pragma unroll
    for (int j = 0; j < 4; ++j) o8[64 * j] = (unsigned long long)pk2(v[j].x * rstd, v[j].y * rstd) | ((unsigned long long)pk2(v[j].z * rstd, v[j].w * rstd) << 32);
}
__device__ __forceinline__ void p0_prologue(Frame& F, KArgs ka) {
    const float *w_in_ret = ka->in[3], *w_in_fox = ka->in[4], *w_mem_kv = ka->in[6], *w_out = ka->in[7], *w_up = ka->in[8], *w_down = ka->in[9];
    const float *g_pre_mix = ka->in[10], *g_pre_mlp = ka->in[12], *g_mem = ka->in[14];
    bf16 *Win0 = WSP(bf16, WS_WIN0), *Win1 = WSP(bf16, WS_WIN1), *Wmem = WSP(bf16, WS_WMEM), *Wout = WSP(bf16, WS_WOUT), *Wup = WSP(bf16, WS_WUP), *Wdn = WSP(bf16, WS_WDN);
    LAS float* scr = (LAS float*)(F.lds + RING_OFF + F.wave * 16384);
    const int gw = F.gw, NGW = F.G * NWAVES;
    constexpr int KB = DM / 64;
    constexpr int I_IN0 = KB * (3328 / 32), I_IN1 = KB * ((2572 + 31) / 32), I_MEM = KB * (512 / 32), I_OUT = KB * (DM / 32), I_UP = KB * (FF / 32), I_DN = (FF / 64) * (DM / 32);
    constexpr int NITEMS = I_IN0 + I_IN1 + 2 * I_MEM + 2 * I_OUT + 2 * I_UP + 2 * I_DN;
    for (int it = gw; it < NITEMS; it += NGW) {
        int r = it;
        if (r < I_IN0) { p0_transpose_item(w_in_ret, DM, 3328, Win0, 1, 0, g_pre_mix, scr, r, F.lane); continue; } r -= I_IN0;
        if (r < I_IN1) { p0_transpose_item(w_in_fox, DM, 2572, Win1, 2, 0, g_pre_mix + DM, scr, r, F.lane); continue; } r -= I_IN1;
        if (r < 2 * I_MEM) { const int l = r / I_MEM; p0_transpose_item(w_mem_kv + (size_t)l * DM * 512, DM, 512, Wmem, 0, l * 512, g_mem + l * DM, scr, r % I_MEM, F.lane); continue; } r -= 2 * I_MEM;
        if (r < 2 * I_OUT) { const int l = r / I_OUT; p0_transpose_item(w_out + (size_t)l * DM * DM, DM, DM, Wout + (size_t)l * DM * DM, 0, 0, nullptr, scr, r % I_OUT, F.lane); continue; } r -= 2 * I_OUT;
        if (r < 2 * I_UP) { const int l = r / I_UP; p0_transpose_item(w_up + (size_t)l * DM * FF, DM, FF, Wup + (size_t)l * DM * FF, 0, 0, g_pre_mlp + l * DM, scr, r % I_UP, F.lane); continue; } r -= 2 * I_UP;
        { const int l = r / I_DN; p0_transpose_item(w_down + (size_t)l * DM * FF, FF, DM, Wdn + (size_t)l * DM * FF, 0, 0, nullptr, scr, r % I_DN, F.lane); }
    }
    { GAS v4u* z = (GAS v4u*)(Win1 + (size_t)(C_G + 12) * DM); const int n16 = (NP1 - C_G - 12) * DM * 2 / 16;
      for (int i = gw * 64 + F.lane; i < n16; i += NGW * 64) z[i] = (v4u){0u, 0u, 0u, 0u}; }
    for (int m = gw; m < MTOK; m += NGW) rms_row_to_bf16(ka->in[0] + (size_t)m * DM, WSP(bf16, WS_XN) + (size_t)m * DM, F.lane);
    for (int m = gw; m < MMEM; m += NGW) rms_row_to_bf16(ka->in[1] + (size_t)m * DM, WSP(bf16, WS_MEMN) + (size_t)m * DM, F.lane);
}

__device__ __forceinline__ void row_pass(Frame& F, const float* y, const float* base, const float* gain, float* xo, bf16* xn) {
    const int NGW = F.G * NWAVES;
    f32x4 g[4];
#pragma unroll
    for (int j = 0; j < 4; ++j) g[j] = ((const GAS f32x4*)gain)[F.lane + 64 * j];
    for (int m = F.gw; m < MTOK; m += NGW) {
        const GAS f32x4* yr = (const GAS f32x4*)(y + (size_t)m * DM) + F.lane; const GAS f32x4* br = (const GAS f32x4*)(base + (size_t)m * DM) + F.lane;
        f32x4 v[4], b[4]; float s = 0.f;
#pragma unroll
        for (int j = 0; j < 4; ++j) { v[j] = yr[64 * j]; b[j] = br[64 * j]; s += (v[j].x * v[j].x + v[j].y * v[j].y) + (v[j].z * v[j].z + v[j].w * v[j].w); }
        const float rstd = 1.0f / sqrtf(wave_sum(s) * (1.f / DM) + EPS);
        float s2 = 0.f;
#pragma unroll
        for (int j = 0; j < 4; ++j) { v[j] = b[j] + v[j] * rstd * g[j]; s2 += (v[j].x * v[j].x + v[j].y * v[j].y) + (v[j].z * v[j].z + v[j].w * v[j].w); }
        GAS f32x4* o = (GAS f32x4*)(xo + (size_t)m * DM) + F.lane;
#pragma unroll
        for (int j = 0; j < 4; ++j) o[64 * j] = v[j];
        if (xn) {
            const float r2 = 1.0f / sqrtf(wave_sum(s2) * (1.f / DM) + EPS);
            GAS unsigned long long* o8 = (GAS unsigned long long*)(xn + (size_t)m * DM) + F.lane;
#pragma unroll
            for (int j = 0; j < 4; ++j) o8[64 * j] = (unsigned long long)pk2(v[j].x * r2, v[j].y * r2) | ((unsigned long long)pk2(v[j].z * r2, v[j].w * r2) << 32);
        }
    }
}

__device__ __forceinline__ void scan_phase(Frame& F, KArgs ka) {
    if (F.gw >= BATCH * 12) return;
    const int b = F.gw / 12, h = F.gw % 12;
    const float* src = WSP(float, WS_LOGF) + ((size_t)b * SEQ + F.lane * 32) * 16 + h;
    float s = 0.f;
    for (int i = 0; i < 32; ++i) s += src[(size_t)i * 16];
    float incl = s;
#pragma unroll
    for (int o = 1; o < 64; o <<= 1) { const float v = __shfl_up(incl, o); if (F.lane >= o) incl += v; }
    float run = incl - s;
    float* dst = WSP(float, WS_CS) + (size_t)(b * 12 + h) * SEQ + F.lane * 32;
    for (int i = 0; i < 32; ++i) { run += src[(size_t)i * 16]; dst[i] = run; }
}

#ifndef DBL_MASK
#define DBL_MASK 0
#endif
#define REP(bit) for (int rep_ = 0; rep_ < (int)((DBL_MASK >> (bit)) & 1) + 1; ++rep_)
#define RUN() (lo <= ph && ph < hi)
#ifdef TS_A
#define TS_STAMP() do { if (blockIdx.x == 0 && threadIdx.x == 0) ((volatile unsigned long long*)(((KArgs)__builtin_amdgcn_kernarg_segment_ptr())->ws + 32768))[ph] = __builtin_amdgcn_s_memrealtime(); } while (0)
#else
#define TS_STAMP() do {} while (0)
#endif
#define SEAM() do { if (lo <= ph && ph + 1 < hi) xcd_barrier(bar); ++ph; TS_STAMP(); } while (0)
#define RELANE() do { int t_ = threadIdx.x; asm volatile("" : "+v"(t_)); F.tid = t_; F.lane = t_ & 63; F.wave = __builtin_amdgcn_readfirstlane(t_ >> 6); F.gw = blockIdx.x * NWAVES + F.wave; } while (0)
template <int layer> __device__ __forceinline__ void run_layer(Frame& F, const XcdBarrier& bar, const int lo, const int hi, int& ph, LAS unsigned char* ring, unsigned char* lds, const int G, const int c) {
        const int NP = layer ? NP1 : NP0;
        if (RUN()) {
            KArgs ka = KA_GET();
            pg8::Gemm g{WSP(bf16, WS_XN), layer ? WSP(bf16, WS_WIN1) : WSP(bf16, WS_WIN0), MTOK, NP, DM, DM}; pg8::StaticOrder S; S.init(MTOK, NP, G, c);
            pg8::EpiProj E{WSP(bf16, WS_PROJ), NP, layer, (const int*)ka->in[2], WSP(float, WS_LOGF), ka->in[5]};
            REP(0) pg8::gemm_phase<pg8::EpiProj, pg8::StaticOrder, true, true>(ring, g, S, E);
            if (layer == 0) {
                pg8::Gemm g2{WSP(bf16, WS_MEMN), WSP(bf16, WS_WMEM), MMEM, DM, DM, DM}; pg8::OneUnit S2; const int idx = c - 128; S2.has = (idx >= 0 && idx < 64); S2.u0.pm = idx >> 2; S2.u0.pn = idx & 3;
                pg8::EpiBf16<0> E2{WSP(bf16, WS_MEMKV), DM};
                pg8::gemm_phase<pg8::EpiBf16<0>, pg8::OneUnit, true, true>(ring, g2, S2, E2);
            }
        }
        SEAM();
        if (RUN()) { RELANE(); if (layer == 1) scan_phase(F, KA_GET()); }
        SEAM();
        if (RUN()) { RELANE(); KArgs ka = KA_GET();
            static_assert(attn_body::ATTN_LDS_BYTES <= RING_BYTES, "attention LDS");
            bf16* PR = WSP(bf16, WS_PROJ);
            if (layer == 0) {
                REP(6) { const bool dry = ((DBL_MASK >> 6) & 1) && rep_ == 0; const int op = dry ? 768 : NP0, opm = dry ? 256 : NP0;
                    bf16* ob = dry ? (bf16*)ka->out : PR + C_Q; bf16* obm = dry ? (bf16*)ka->out + (size_t)MTOK * 768 : PR + C_MQ;
                    if (c < 96) ret_body::ret_unit(c / 6, c % 6, PR, ob + (size_t)(c / 6) * SEQ * op + (c % 6) * 128, op, F.lds, ka->ws + 36864);
                    else attn_body::mem_phase<NP0, 8>((char*)lds + RING_OFF, (const attn_body::bf16*)PR, (const attn_body::bf16*)WSP(bf16, WS_MEMKV), (attn_body::bf16*)obm, opm, 0, c - 96, 160); }
#if defined(TS_BLK_LO) && !defined(TS_CHUNK)
                if (threadIdx.x == 0) ((volatile unsigned long long*)(ka->ws + 36864))[blockIdx.x] = __builtin_amdgcn_s_memrealtime();
#endif
            } else {
                REP(7) { const bool dry = ((DBL_MASK >> 7) & 1) && rep_ == 0; const int op = dry ? 768 : NP1, opm = dry ? 256 : NP1;
                    bf16* ob = dry ? (bf16*)ka->out : PR + C_Q; bf16* obm = dry ? (bf16*)ka->out + (size_t)MTOK * 768 : PR + C_MQ;
                    attn_body::fox_phase<8>((char*)lds + RING_OFF, (const attn_body::bf16*)PR, WSP(float, WS_CS), (attn_body::bf16*)ob, op, (int)F.G, (int)blockIdx.x);
                    attn_body::mem_phase<NP1, 8>((char*)lds + RING_OFF, (const attn_body::bf16*)PR, (const attn_body::bf16*)WSP(bf16, WS_MEMKV), (attn_body::bf16*)obm, opm, 1, c, 256); }
            }
        }
        SEAM();
        if (RUN()) {
            KArgs ka = KA_GET();
            pg8::Gemm g{WSP(bf16, WS_PROJ), WSP(bf16, WS_WOUT) + (size_t)layer * DM * DM, MTOK, DM, DM, NP}; pg8::StaticOrder S; S.init(MTOK, DM, G, c);
            pg8::EpiF32 E{ka->out, DM};
            REP(1) pg8::gemm_phase<pg8::EpiF32, pg8::StaticOrder, true, true>(ring, g, S, E);
        }
        SEAM();
        if (RUN()) { REP((layer == 0 ? 5 : 31)) { RELANE(); KArgs ka = KA_GET(); row_pass(F, ka->out, layer ? WSP(float, WS_R1) : ka->in[0], ka->in[11] + layer * DM, WSP(float, WS_R1), WSP(bf16, WS_XN)); } }
        SEAM();
        if (RUN()) {
            KArgs ka = KA_GET();
            pg8::Gemm g{WSP(bf16, WS_XN), WSP(bf16, WS_WUP) + (size_t)layer * DM * FF, MTOK, FF, DM, DM}; pg8::StaticOrder S; S.init(MTOK, FF, G, c);
            pg8::EpiBf16<1> E{WSP(bf16, WS_H), FF};
            REP(2) pg8::gemm_phase<pg8::EpiBf16<1>, pg8::StaticOrder, true, true>(ring, g, S, E);
        }
        SEAM();
        if (RUN()) {
            KArgs ka = KA_GET();
            pg8::Gemm g{WSP(bf16, WS_H), WSP(bf16, WS_WDN) + (size_t)layer * DM * FF, MTOK, DM, FF, FF}; pg8::StaticOrder S; S.init(MTOK, DM, G, c);
            pg8::EpiF32 E{ka->out, DM};
            REP(3) pg8::gemm_phase<pg8::EpiF32, pg8::StaticOrder, true, true>(ring, g, S, E);
        }
        SEAM();
        if (RUN()) { RELANE(); KArgs ka = KA_GET(); row_pass(F, ka->out, WSP(float, WS_R1), ka->in[13] + layer * DM, layer ? ka->out : WSP(float, WS_R1), layer ? nullptr : WSP(bf16, WS_XN)); }
        SEAM();
    }
__global__ void __launch_bounds__(NWAVES * 64, 2) fwd_kernel(Args args) {
    extern __shared__ __attribute__((aligned(16))) unsigned char lds[];
    Frame F;
    F.lds = (LAS unsigned char*)lds;
    F.tid = threadIdx.x; F.lane = F.tid & 63; F.wave = __builtin_amdgcn_readfirstlane(F.tid >> 6);
    F.G = gridDim.x; F.gw = blockIdx.x * NWAVES + F.wave;
    for (int u = F.tid; u < (LDS_BYTES - LDSCTL_OFF) / 4; u += NWAVES * 64) ((LAS unsigned*)(F.lds + LDSCTL_OFF))[u] = 0u;
    __syncthreads();
    volatile LAS unsigned* MISC = (volatile LAS unsigned*)(F.lds + MISC_OFF);
    XcdBarrier bar = xcd_barrier_post((unsigned*)(args.ws + WS_CTL) + CW_BAR, MISC + 8);
    const int lo = args.ph_lo, hi = args.ph_hi;
    int ph = 0;
    LAS unsigned char* ring = F.lds + RING_OFF;
    const int G = F.G, c = (int)blockIdx.x;

    TS_STAMP();
    if (RUN()) { REP(4) { RELANE(); p0_prologue(F, KA_GET()); } }
    SEAM();
    run_layer<0>(F, bar, lo, hi, ph, ring, lds, G, c);
    run_layer<1>(F, bar, lo, hi, ph, ring, lds, G, c);
#ifdef TS_A
    if (blockIdx.x == 0 && threadIdx.x == 0) { asm volatile("s_waitcnt vmcnt(0)" ::: "memory"); volatile unsigned long long* ts = (volatile unsigned long long*)(args.ws + 32768);
        unsigned long long tb = ts[TS_B];
#ifdef TS_P1
        { volatile unsigned long long* tp = (volatile unsigned long long*)(args.ws + 36864); tb = tp[1] + ts[TS_A] - tp[0]; }
#endif
#ifdef TS_BLK_LO
        tb = 0; volatile unsigned long long* tsb = (volatile unsigned long long*)(args.ws + 36864);
        for (int i = TS_BLK_LO; i < TS_BLK_HI; ++i) { const unsigned long long v = tsb[i]; tb = v > tb ? v : tb; }
#endif
        { float v = (float)(long long)(tb - ts[TS_A]) * 0.01f; float step = 1.f; while (step * 8.f < v) step *= 2.f; v = floorf(v / step + 0.5f) * step;
          args.out[0] = v; } }
#endif
#undef RUN
#undef SEAM
}

#ifndef MK_MULTI
#define MK_MULTI 0
#endif
constexpr int N_PHASES = 1 + 2 * 8;
extern "C" void kernel_launch(void* const* d_in, const int* in_sizes, int n_in, void* d_out, int out_size, void* d_ws, size_t ws_size, hipStream_t stream) {
    static int grid = 0;
    if (grid == 0) {
        if (n_in != 15 || in_sizes[0] != MTOK * DM || out_size != MTOK * DM || ws_size < WS_END) { fprintf(stderr, "kernel_launch: unexpected shapes (n_in %d, in0 %d, out %d, ws %zu); nothing launched\n", n_in, n_in > 0 ? in_sizes[0] : -1, out_size, ws_size); grid = -1; return; }
        int dev = 0, cus = 0, per_cu = 0;
        if (hipGetDevice(&dev) != hipSuccess || hipDeviceGetAttribute(&cus, hipDeviceAttributeMultiprocessorCount, dev) != hipSuccess) { grid = -1; return; }
        if (hipFuncSetAttribute((const void*)fwd_kernel, hipFuncAttributeMaxDynamicSharedMemorySize, LDS_BYTES) != hipSuccess) { fprintf(stderr, "kernel_launch: hipFuncSetAttribute failed\n"); grid = -1; return; }
        if (hipOccupancyMaxActiveBlocksPerMultiprocessor(&per_cu, (const void*)fwd_kernel, NWAVES * 64, LDS_BYTES) != hipSuccess || per_cu < 1)
            fprintf(stderr, "kernel_launch: occupancy query reports %d workgroups per CU\n", per_cu);
        (void)hipGetLastError();
        grid = cus;
    }
    if (grid < 0) return;
    if (hipMemsetAsync((char*)d_ws + WS_CTL, 0, CTL_ZERO_BYTES, stream) != hipSuccess) return;
    Args a{};
    for (int i = 0; i < 15; ++i) a.in[i] = (const float*)d_in[i];
    a.out = (float*)d_out; a.ws = (unsigned char*)d_ws;
#if MK_MULTI
    for (int p = 0; p < N_PHASES; ++p) { a.ph_lo = p; a.ph_hi = p + 1; hipLaunchKernelGGL(fwd_kernel, dim3(grid), dim3(NWAVES * 64), LDS_BYTES, stream, a); }
#else
    a.ph_lo = 0; a.ph_hi = N_PHASES;
    hipLaunchKernelGGL(fwd_kernel, dim3(grid), dim3(NWAVES * 64), LDS_BYTES, stream, a);
#endif
}
```
